# Optimizing an MI355X kernel written in HIP

```python
import math
import jax, jax.numpy as jnp
from jax import lax
import numpy as np

D_MODEL = 1024
BATCH = 4
SEQ = 4096
DEPTH = 2

HEAD_DIM = 64
BRANCH_DIM = 512
CONV_CH = BRANCH_DIM
CONV_K = 3
ATT_HEADS = BRANCH_DIM // HEAD_DIM
ATT_DIM = ATT_HEADS * HEAD_DIM
RWKV_HEADS = BRANCH_DIM // HEAD_DIM
RWKV_DIM = RWKV_HEADS * HEAD_DIM
DECAY_LORA = 64
AAA_LORA = 64
GATE_LORA = 128
N_BRANCH = 3
MIX_DIM = CONV_CH + ATT_DIM + RWKV_DIM
MOBA_BLOCK = 256
MOBA_TOPK = 3
MOBA_Q_CHUNK = 32
ROPE_THETA = 10000.0
D_FF = 2816
N_EXPERTS = 8
EXPERT_TOPK = 2
MOE_ROWS = 256
LN_EPS = 1e-5
GN_EPS = 64e-5
DN_ALPHA = (2 * DEPTH) ** 0.25
DN_BETA = (8 * DEPTH) ** -0.25
N_DENSE = (DEPTH + 1) // 2
N_MOE = DEPTH // 2
IN_SPLITS = [CONV_CH] * 3 + [ATT_DIM] * 3 + [RWKV_DIM] * 3 + [DECAY_LORA, AAA_LORA, GATE_LORA] + [D_MODEL] * N_BRANCH
P_TOTAL = sum(IN_SPLITS)
SHIFT_DIM = 3 * RWKV_DIM + DECAY_LORA + AAA_LORA + GATE_LORA

kernel_name = "hybrid_conv_moba_rwkv7_deepnorm_moe"


def split_cols(a, sizes):
    idx = np.cumsum(sizes)[:-1].tolist()
    return jnp.split(a, idx, axis=-1)


def layer_norm(x, g, b):
    xf = x.astype(jnp.float32)
    mu = xf.mean(-1, keepdims=True)
    var = jnp.square(xf - mu).mean(-1, keepdims=True)
    return ((xf - mu) * lax.rsqrt(var + LN_EPS) * g + b).astype(x.dtype)


def token_shift(u):
    return jnp.pad(u, ((0, 0), (1, 0), (0, 0)))[:, :-1]


def rope(x, pos):
    half = HEAD_DIM // 2
    inv = ROPE_THETA ** (-jnp.arange(half, dtype=jnp.float32) / half)
    ang = pos.astype(jnp.float32)[:, None] * inv[None, :]
    cos = jnp.cos(ang)[None, :, None, :]
    sin = jnp.sin(ang)[None, :, None, :]
    x1 = x[..., :half].astype(jnp.float32)
    x2 = x[..., half:].astype(jnp.float32)
    return jnp.concatenate([x1 * cos - x2 * sin, x2 * cos + x1 * sin], -1).astype(x.dtype)


def short_conv(u, w):
    return lax.conv_general_dilated(
        u, w[:, None, :], window_strides=(1,), padding=((CONV_K - 1, 0),),
        dimension_numbers=('NWC', 'WIO', 'NWC'), feature_group_count=u.shape[-1])


def moba_attention(q, k, v):
    B, T, H, Dh = q.shape
    nb = -(-T // MOBA_BLOCK)
    tp = nb * MOBA_BLOCK
    pad = ((0, 0), (0, tp - T), (0, 0), (0, 0))
    q = jnp.pad(q, pad).transpose(0, 2, 1, 3)
    k = jnp.pad(k, pad).transpose(0, 2, 1, 3)
    v = jnp.pad(v, pad).transpose(0, 2, 1, 3)
    kb = k.reshape(B, H, nb, MOBA_BLOCK, Dh)
    vb = v.reshape(B, H, nb, MOBA_BLOCK, Dh)
    kmean = kb.astype(jnp.float32).mean(3)
    topk = min(MOBA_TOPK, nb)
    scale = Dh ** -0.5
    blk_ids = jnp.arange(nb)
    gather = jax.vmap(jax.vmap(lambda blocks, idx: blocks[idx]))

    def chunk(c):
        q0 = c * MOBA_Q_CHUNK
        qc = lax.dynamic_slice_in_dim(q, q0, MOBA_Q_CHUNK, axis=2)
        own = q0 // MOBA_BLOCK
        qpos = q0 + jnp.arange(MOBA_Q_CHUNK)
        gate = jnp.einsum('bhqd,bhnd->bhqn', qc.astype(jnp.float32), kmean)
        gate = jnp.where(blk_ids < own, gate, -jnp.inf)
        _, sel = lax.top_k(gate, topk)
        sel_ok = sel < own
        k_sel = gather(kb, sel)
        v_sel = gather(vb, sel)
        s_sel = jnp.einsum('bhqd,bhqnkd->bhqnk', qc, k_sel).astype(jnp.float32) * scale
        s_sel = jnp.where(sel_ok[..., None], s_sel, -jnp.inf)
        s_sel = s_sel.reshape(B, H, MOBA_Q_CHUNK, topk * MOBA_BLOCK)
        k_own = lax.dynamic_index_in_dim(kb, own, axis=2, keepdims=False)
        v_own = lax.dynamic_index_in_dim(vb, own, axis=2, keepdims=False)
        s_own = jnp.einsum('bhqd,bhkd->bhqk', qc, k_own).astype(jnp.float32) * scale
        kpos = own * MOBA_BLOCK + jnp.arange(MOBA_BLOCK)
        s_own = jnp.where(kpos[None, :] <= qpos[:, None], s_own, -jnp.inf)
        p = jax.nn.softmax(jnp.concatenate([s_sel, s_own], -1), axis=-1).astype(v.dtype)
        p_sel = p[..., :topk * MOBA_BLOCK].reshape(B, H, MOBA_Q_CHUNK, topk, MOBA_BLOCK)
        p_own = p[..., topk * MOBA_BLOCK:]
        return (jnp.einsum('bhqnk,bhqnkd->bhqd', p_sel, v_sel)
                + jnp.einsum('bhqk,bhkd->bhqd', p_own, v_own))

    o = lax.map(chunk, jnp.arange(tp // MOBA_Q_CHUNK))
    o = o.transpose(1, 0, 3, 2, 4).reshape(B, tp, H, Dh)
    return o[:, :T]


def delta_rule_scan(r, w, k, v, kk, a):
    B, T, H, N = r.shape
    xs = tuple(t.transpose(1, 0, 2, 3) for t in (r, w, k, v, kk, a))

    def step(S, inp):
        r_t, w_t, k_t, v_t, kk_t, a_t = inp
        sa = jnp.einsum('bhvk,bhk->bhv', S, -kk_t)
        S = S * w_t[:, :, None, :] + sa[..., None] * (kk_t * a_t)[:, :, None, :] + v_t[..., None] * k_t[:, :, None, :]
        return S, jnp.einsum('bhvk,bhk->bhv', S, r_t)

    S0 = jnp.zeros((B, H, N, N), r.dtype)
    _, y = lax.scan(step, S0, xs)
    return y.transpose(1, 0, 2, 3)


def rwkv7_time_mix(r, k, v, wl, al, gl, shift_mu, decay_w0, decay_w2, aaa_a0, aaa_w2, gate_w2,
                   k_k, k_a, r_k, gn_g, gn_b):
    B, T, _ = r.shape
    u = jnp.concatenate([r, k, v, wl, al, gl], -1).astype(jnp.float32)
    u = u + (token_shift(u) - u) * shift_mu
    r, k, v, wl, al, gl = split_cols(u, [RWKV_DIM] * 3 + [DECAY_LORA, AAA_LORA, GATE_LORA])
    w = -jax.nn.softplus(-(decay_w0 + jnp.tanh(wl) @ decay_w2)) - 0.5
    decay = jnp.exp(-jnp.exp(w))
    a = jax.nn.sigmoid(aaa_a0 + al @ aaa_w2)
    g = jax.nn.sigmoid(gl) @ gate_w2
    heads = lambda t: t.reshape(B, T, RWKV_HEADS, HEAD_DIM)
    kk = heads(k * k_k)
    kk = kk / jnp.maximum(jnp.linalg.norm(kk, axis=-1, keepdims=True), 1e-12)
    k = k * (1.0 + (a - 1.0) * k_a)
    rh, kh, vh, ah = heads(r), heads(k), heads(v), heads(a)
    y = delta_rule_scan(rh, heads(decay), kh, vh, kk, ah)
    mu = y.mean(-1, keepdims=True)
    var = jnp.square(y - mu).mean(-1, keepdims=True)
    y = ((y - mu) * lax.rsqrt(var + GN_EPS)).reshape(B, T, RWKV_DIM) * gn_g + gn_b
    y = y + ((rh * kh * r_k).sum(-1, keepdims=True) * vh).reshape(B, T, RWKV_DIM)
    return y * g


def hybrid_mixer(x, w_in, conv_w, shift_mu, decay_w0, decay_w2, aaa_a0, aaa_w2, gate_w2,
                 k_k, k_a, r_k, gn_g, gn_b, w_branch, w_out):
    B, T, _ = x.shape
    proj = x @ w_in
    (c_h, c_b, c_c, q, k, v, rr, rk, rv, wl, al, gl,
     g_conv, g_att, g_rwkv) = split_cols(proj, IN_SPLITS)
    o_conv = c_b * short_conv(c_c * c_h, conv_w)
    pos = jnp.arange(T)
    qh = rope(q.reshape(B, T, ATT_HEADS, HEAD_DIM), pos)
    kh = rope(k.reshape(B, T, ATT_HEADS, HEAD_DIM), pos)
    o_att = moba_attention(qh, kh, v.reshape(B, T, ATT_HEADS, HEAD_DIM)).reshape(B, T, ATT_DIM)
    o_rwkv = rwkv7_time_mix(rr, rk, rv, wl, al, gl, shift_mu, decay_w0, decay_w2, aaa_a0, aaa_w2,
                            gate_w2, k_k, k_a, r_k, gn_g, gn_b).astype(x.dtype)
    p_conv, p_att, p_rwkv = jnp.split(w_branch, [CONV_CH, CONV_CH + ATT_DIM], axis=0)
    merged = (jax.nn.sigmoid(g_conv) * (o_conv @ p_conv)
              + jax.nn.sigmoid(g_att) * (o_att @ p_att)
              + jax.nn.sigmoid(g_rwkv) * (o_rwkv @ p_rwkv))
    return merged @ w_out


def swiglu(x, w_gate, w_up, w_down):
    return (jax.nn.silu(x @ w_gate) * (x @ w_up)) @ w_down


def moe_swiglu(x, router_w, w_gate, w_up, w_down):
    B, T, D = x.shape
    xt = x.reshape(-1, D)
    N = xt.shape[0]
    NK = N * EXPERT_TOPK
    logits = (xt @ router_w).astype(jnp.float32)
    top_logit, top_e = lax.top_k(logits, EXPERT_TOPK)
    gate = jax.nn.softmax(top_logit, axis=-1).astype(x.dtype)
    flat_e = top_e.reshape(-1)
    flat_tok = jnp.arange(NK, dtype=jnp.int32) // EXPERT_TOPK
    flat_gate = gate.reshape(-1)
    order = jnp.argsort(flat_e)
    se = flat_e[order]
    counts = jnp.zeros((N_EXPERTS,), jnp.int32).at[flat_e].add(1)
    padded = (counts + MOE_ROWS - 1) // MOE_ROWS * MOE_ROWS
    pad_end = jnp.cumsum(padded)
    pad_start = pad_end - padded
    start = jnp.cumsum(counts) - counts
    dest = pad_start[se] + jnp.arange(NK, dtype=jnp.int32) - start[se]
    n_blocks = -(-NK // MOE_ROWS) + N_EXPERTS
    n_rows = n_blocks * MOE_ROWS
    buf_tok = jnp.zeros((n_rows,), jnp.int32).at[dest].set(flat_tok[order])
    buf_gate = jnp.zeros((n_rows,), x.dtype).at[dest].set(flat_gate[order])
    blk_start = jnp.arange(n_blocks, dtype=jnp.int32) * MOE_ROWS
    blk_e = jnp.minimum(jnp.searchsorted(pad_end, blk_start, side='right'), N_EXPERTS - 1)
    xb = xt[buf_tok].reshape(n_blocks, MOE_ROWS, D)

    def expert_block(args):
        xr, e = args
        return swiglu(xr, w_gate[e], w_up[e], w_down[e])

    yb = lax.map(expert_block, (xb, blk_e)).reshape(n_rows, D)
    out = jnp.zeros_like(xt).at[buf_tok].add(yb * buf_gate[:, None])
    return out.reshape(B, T, D)


def setup_inputs(seed: int = 0) -> dict:
    key = jax.random.key(seed)
    ks = jax.random.split(key, 32)
    n = lambda i, shape, s: jax.random.normal(ks[i], shape, jnp.float32) * s
    L = DEPTH
    return {
        "x": n(0, (BATCH, SEQ, D_MODEL), 1.0),
        "w_in": n(1, (L, D_MODEL, P_TOTAL), D_MODEL ** -0.5),
        "conv_w": n(2, (L, CONV_K, CONV_CH), CONV_K ** -0.5),
        "shift_mu": jax.random.uniform(ks[3], (L, SHIFT_DIM), jnp.float32),
        "decay_w0": jax.random.uniform(ks[4], (L, RWKV_DIM), jnp.float32, -4.0, 0.5),
        "decay_w2": n(5, (L, DECAY_LORA, RWKV_DIM), 0.1 * DECAY_LORA ** -0.5),
        "aaa_a0": n(6, (L, RWKV_DIM), 0.1),
        "aaa_w2": n(7, (L, AAA_LORA, RWKV_DIM), AAA_LORA ** -0.5),
        "gate_w2": n(8, (L, GATE_LORA, RWKV_DIM), GATE_LORA ** -0.5),
        "k_k": 1.0 + n(9, (L, RWKV_DIM), 0.1),
        "k_a": 1.0 + n(10, (L, RWKV_DIM), 0.1),
        "r_k": n(11, (L, RWKV_HEADS, HEAD_DIM), 0.1),
        "gn_g": 1.0 + n(12, (L, RWKV_DIM), 0.1),
        "gn_b": n(13, (L, RWKV_DIM), 0.02),
        "w_branch": n(14, (L, MIX_DIM, D_MODEL), BRANCH_DIM ** -0.5),
        "w_out": n(15, (L, D_MODEL, D_MODEL), D_MODEL ** -0.5 * DN_BETA),
        "ln1_g": 1.0 + n(16, (L, D_MODEL), 0.1),
        "ln1_b": n(17, (L, D_MODEL), 0.02),
        "ln2_g": 1.0 + n(18, (L, D_MODEL), 0.1),
        "ln2_b": n(19, (L, D_MODEL), 0.02),
        "ffn_w_gate": n(20, (N_DENSE, D_MODEL, D_FF), D_MODEL ** -0.5),
        "ffn_w_up": n(21, (N_DENSE, D_MODEL, D_FF), D_MODEL ** -0.5),
        "ffn_w_down": n(22, (N_DENSE, D_FF, D_MODEL), D_FF ** -0.5 * DN_BETA),
        "router_w": n(23, (N_MOE, D_MODEL, N_EXPERTS), D_MODEL ** -0.5),
        "moe_w_gate": n(24, (N_MOE, N_EXPERTS, D_MODEL, D_FF), D_MODEL ** -0.5),
        "moe_w_up": n(25, (N_MOE, N_EXPERTS, D_MODEL, D_FF), D_MODEL ** -0.5),
        "moe_w_down": n(26, (N_MOE, N_EXPERTS, D_FF, D_MODEL), D_FF ** -0.5 * DN_BETA),
    }


def reference(x, w_in, conv_w, shift_mu, decay_w0, decay_w2, aaa_a0, aaa_w2, gate_w2, k_k, k_a, r_k,
              gn_g, gn_b, w_branch, w_out, ln1_g, ln1_b, ln2_g, ln2_b, ffn_w_gate, ffn_w_up, ffn_w_down,
              router_w, moe_w_gate, moe_w_up, moe_w_down):
    for l in range(DEPTH):
        h = hybrid_mixer(x, w_in[l], conv_w[l], shift_mu[l], decay_w0[l], decay_w2[l], aaa_a0[l],
                         aaa_w2[l], gate_w2[l], k_k[l], k_a[l], r_k[l], gn_g[l], gn_b[l],
                         w_branch[l], w_out[l])
        x = layer_norm(DN_ALPHA * x + h, ln1_g[l], ln1_b[l])
        if l % 2 == 0:
            j = l // 2
            f = swiglu(x, ffn_w_gate[j], ffn_w_up[j], ffn_w_down[j])
        else:
            j = l // 2
            f = moe_swiglu(x, router_w[j], moe_w_gate[j], moe_w_up[j], moe_w_down[j])
        x = layer_norm(DN_ALPHA * x + f, ln2_g[l], ln2_b[l])
    return x
```

```cpp
#include <hip/hip_runtime.h>
#include <cstdio>
#include <cstdint>
#include <cmath>

namespace {
constexpr int D = 1024, NB = 4, T = 4096, M = NB * T, HD = 64, BR = 512, NH = 8, PT = 7936, DFF = 2816, NE = 8;
constexpr int SHIFT = 1792;
constexpr float LN_EPS = 1e-5f, GN_EPS = 64e-5f;
constexpr float ALPHA = 1.41421356237309515f;

constexpr int TM = 128, TN = 128, TK = 8;
__global__ __launch_bounds__(256) void k_gemm(const float* __restrict__ A, int lda, const int* __restrict__ a_idx,
                                              const float* __restrict__ Bm, int ldb, float* C, int ldc,
                                              int Mmax, const int* __restrict__ m_cnt, const int* __restrict__ m_off,
                                              int N, int K, int epi, const int* __restrict__ c_idx, const float* __restrict__ c_scale) {
    __shared__ float As[TK][TM + 4];
    __shared__ float Bs[TK][TN + 4];
    const int Mv = m_cnt ? *m_cnt : Mmax;
    const int base = m_off ? *m_off : 0;
    const int m0 = blockIdx.y * TM, n0 = blockIdx.x * TN;
    if (m0 >= Mv) return;
    const int tid = threadIdx.x, tx = tid & 15, ty = tid >> 4;
    const int ar = tid >> 1, ak = (tid & 1) * 4;
    const int am = m0 + ar; const bool aval = am < Mv;
    const size_t arow = aval ? (a_idx ? (size_t)a_idx[base + am] : (size_t)am) : 0;
    const float* Ap = A + arow * (size_t)lda + ak;
    const int bk = tid >> 5, bn = (tid & 31) * 4;
    const float* Bp = Bm + (size_t)bk * ldb + n0 + bn;
    float acc[8][8];
#pragma unroll
    for (int i = 0; i < 8; ++i)
#pragma unroll
        for (int j = 0; j < 8; ++j) acc[i][j] = 0.f;
    for (int k0 = 0; k0 < K; k0 += TK) {
        float4 av = aval ? *(const float4*)(Ap + k0) : make_float4(0.f, 0.f, 0.f, 0.f);
        float4 bv = *(const float4*)(Bp + (size_t)k0 * ldb);
        As[ak + 0][ar] = av.x; As[ak + 1][ar] = av.y; As[ak + 2][ar] = av.z; As[ak + 3][ar] = av.w;
        *(float4*)&Bs[bk][bn] = bv;
        __syncthreads();
#pragma unroll
        for (int k = 0; k < TK; ++k) {
            const float4 a0 = *(const float4*)&As[k][ty * 8], a1 = *(const float4*)&As[k][ty * 8 + 4];
            const float4 b0 = *(const float4*)&Bs[k][tx * 8], b1 = *(const float4*)&Bs[k][tx * 8 + 4];
            const float a[8] = {a0.x, a0.y, a0.z, a0.w, a1.x, a1.y, a1.z, a1.w};
            const float b[8] = {b0.x, b0.y, b0.z, b0.w, b1.x, b1.y, b1.z, b1.w};
#pragma unroll
            for (int i = 0; i < 8; ++i)
#pragma unroll
                for (int j = 0; j < 8; ++j) acc[i][j] = fmaf(a[i], b[j], acc[i][j]);
        }
        __syncthreads();
    }
#pragma unroll
    for (int i = 0; i < 8; ++i) {
        const int m = m0 + ty * 8 + i;
        if (m < Mv) {
            if (epi == 2) {
                const size_t crow = (size_t)c_idx[base + m]; const float sc = c_scale[base + m];
#pragma unroll
                for (int j = 0; j < 8; ++j) atomicAdd(&C[crow * ldc + n0 + tx * 8 + j], sc * acc[i][j]);
            } else {
                float* cp = C + (size_t)m * ldc + n0 + tx * 8;
#pragma unroll
                for (int j = 0; j < 8; ++j) {
                    float v = acc[i][j];
                    if (epi == 1) { const float g = cp[j]; v = (g / (1.f + expf(-g))) * v; }
                    cp[j] = v;
                }
            }
        }
    }
}

__device__ __forceinline__ float wave_sum(float v) {
#pragma unroll
    for (int o = 1; o < 64; o <<= 1) v += __shfl_xor(v, o);
    return v;
}
__device__ __forceinline__ float sigmoidf_(float x) { return 1.f / (1.f + expf(-x)); }

__global__ void k_conv(const float* __restrict__ P1, const float* __restrict__ cw, float* __restrict__ o) {
    const int idx = blockIdx.x * blockDim.x + threadIdx.x; if (idx >= M * BR) return;
    const int m = idx / BR, c = idx % BR, t = m % T;
    const float* r0 = P1 + (size_t)m * 1536;
    const float u0 = r0[1024 + c] * r0[c];
    const float u1 = t >= 1 ? (r0 - 1536)[1024 + c] * (r0 - 1536)[c] : 0.f;
    const float u2 = t >= 2 ? (r0 - 3072)[1024 + c] * (r0 - 3072)[c] : 0.f;
    o[idx] = r0[512 + c] * (cw[c] * u2 + cw[BR + c] * u1 + cw[2 * BR + c] * u0);
}

__global__ void k_rope(float* P2) {
    const int idx = blockIdx.x * blockDim.x + threadIdx.x; if (idx >= M * 2 * NH * 32) return;
    const int i = idx & 31, h = (idx >> 5) & 7, qk = (idx >> 8) & 1, m = idx >> 9, t = m % T;
    const float inv = powf(10000.0f, -(float)i / 32.0f);
    const float ang = (float)t * inv;
    float s, c; sincosf(ang, &s, &c);
    float* p = P2 + (size_t)m * 1536 + qk * 512 + h * 64 + i;
    const float x1 = p[0], x2 = p[32];
    p[0] = x1 * c - x2 * s; p[32] = x2 * c + x1 * s;
}
__global__ void k_kmean(const float* __restrict__ P2, float* __restrict__ kmean) {
    const int idx = blockIdx.x * blockDim.x + threadIdx.x; if (idx >= NB * NH * 16 * 64) return;
    const int d = idx & 63, n = (idx >> 6) & 15, h = (idx >> 10) & 7, b = idx >> 13;
    const float* kp = P2 + ((size_t)(b * T + n * 256)) * 1536 + 512 + h * 64 + d;
    float s = 0.f;
    for (int r = 0; r < 256; ++r) s += kp[(size_t)r * 1536];
    kmean[idx] = s * (1.f / 256.f);
}
__global__ void k_moba_sel(const float* __restrict__ P2, const float* __restrict__ kmean, int* __restrict__ sel) {
    const int idx = blockIdx.x * blockDim.x + threadIdx.x; if (idx >= M * NH) return;
    const int h = idx & 7, m = idx >> 3, b = m / T, t = m % T, own = t >> 8;
    int mask = 0;
    if (own <= 3) mask = (1 << own) - 1;
    else {
        const float* qp = P2 + (size_t)m * 1536 + h * 64;
        float g[16];
#pragma unroll
        for (int n = 0; n < 16; ++n) g[n] = -INFINITY;
#pragma unroll
        for (int n = 0; n < 15; ++n) {
            if (n < own) { const float* km = kmean + ((size_t)((b * NH + h) * 16 + n)) * 64; float s = 0.f;
                for (int d = 0; d < 64; ++d) s = fmaf(qp[d], km[d], s);
                g[n] = s; }
        }
#pragma unroll
        for (int r = 0; r < 3; ++r) {
            float best = -INFINITY; int bi = -1;
#pragma unroll
            for (int n = 0; n < 15; ++n) { const bool tk = ((mask >> n) & 1) != 0; if (!tk && n < own && (bi < 0 || g[n] > best)) { best = g[n]; bi = n; } }
            mask |= (1 << bi);
        }
    }
    sel[idx] = mask;
}
__global__ __launch_bounds__(64) void k_moba_attn(const float* __restrict__ P2, const int* __restrict__ sel, float* __restrict__ o) {
    const int idx = blockIdx.x * 64 + threadIdx.x;
    const int t = idx % T, h = (idx / T) % NH, b = idx / (T * NH), m = b * T + t, own = t >> 8;
    const int mask = sel[m * NH + h];
    float q[64], acc[64];
    const float* qp = P2 + (size_t)m * 1536 + h * 64;
#pragma unroll
    for (int d = 0; d < 64; ++d) { q[d] = qp[d] * 0.125f; acc[d] = 0.f; }
    float mx = -INFINITY, l = 0.f;
    for (int n = 0; n <= own; ++n) {
        const bool isown = (n == own);
        if (!isown && !((mask >> n) & 1)) continue;
        const int kend = isown ? (t & 255) : 255;
        const float* kb = P2 + ((size_t)(b * T + n * 256)) * 1536 + 512 + h * 64;
        for (int kk = 0; kk <= kend; ++kk) {
            const float* kr = kb + (size_t)kk * 1536; const float* vr = kr + 512;
            float s = 0.f;
#pragma unroll
            for (int d = 0; d < 64; ++d) s = fmaf(q[d], kr[d], s);
            if (s > mx) { const float f = expf(mx - s); l *= f;
#pragma unroll
                for (int d = 0; d < 64; ++d) acc[d] *= f;
                mx = s; }
            const float p = expf(s - mx); l += p;
#pragma unroll
            for (int d = 0; d < 64; ++d) acc[d] = fmaf(p, vr[d], acc[d]);
        }
    }
    const float il = 1.f / l;
    float* op = o + (size_t)m * BR + h * 64;
#pragma unroll
    for (int d = 0; d < 64; ++d) op[d] = acc[d] * il;
}

__global__ void k_shiftmix(const float* __restrict__ P3, const float* __restrict__ mu, float* __restrict__ Um) {
    const size_t idx = (size_t)blockIdx.x * blockDim.x + threadIdx.x; if (idx >= (size_t)M * SHIFT) return;
    const int c = (int)(idx % SHIFT), m = (int)(idx / SHIFT), t = m % T;
    const float u = P3[idx], up = t >= 1 ? P3[idx - SHIFT] : 0.f;
    float v = u + (up - u) * mu[c];
    if (c >= 1536 && c < 1600) v = tanhf(v); else if (c >= 1664) v = sigmoidf_(v);
    Um[idx] = v;
}
__global__ __launch_bounds__(256) void k_rwkv_prep(float* Um, float* Wl, float* Al, float* __restrict__ KK,
                                                   const float* __restrict__ w0, const float* __restrict__ a0,
                                                   const float* __restrict__ k_k, const float* __restrict__ k_a) {
    const int wv = (blockIdx.x * 256 + threadIdx.x) >> 6, lane = threadIdx.x & 63; if (wv >= M * NH) return;
    const int h = wv & 7, m = wv >> 3, c = h * 64 + lane;
    const size_t i5 = (size_t)m * BR + c;
    const float wpre = w0[c] + Wl[i5];
    const float z = -wpre;
    const float sp = fmaxf(z, 0.f) + log1pf(expf(-fabsf(z)));
    const float w = -sp - 0.5f;
    Wl[i5] = expf(-expf(w));
    const float a = sigmoidf_(a0[c] + Al[i5]);
    Al[i5] = a;
    float* kp = Um + (size_t)m * SHIFT + 512 + c;
    const float k = *kp;
    const float kkr = k * k_k[c];
    const float nrm = sqrtf(wave_sum(kkr * kkr));
    KK[i5] = kkr / fmaxf(nrm, 1e-12f);
    *kp = k * (1.f + (a - 1.f) * k_a[c]);
}
__global__ __launch_bounds__(256) void k_rwkv_scan(const float* __restrict__ Um, const float* __restrict__ DEC, const float* __restrict__ Aa,
                                                   const float* __restrict__ KK, float* __restrict__ Y) {
    const int wv = (blockIdx.x * 256 + threadIdx.x) >> 6, lane = threadIdx.x & 63;
    const int i = wv & 63, h = (wv >> 6) & 7, b = wv >> 9;
    float S = 0.f;
    const int c = h * 64 + lane;
    for (int t = 0; t < T; ++t) {
        const size_t m = (size_t)b * T + t;
        const float r = Um[m * SHIFT + c], k2 = Um[m * SHIFT + 512 + c], vi = Um[m * SHIFT + 1024 + h * 64 + i];
        const float dec = DEC[m * BR + c], a = Aa[m * BR + c], kk = KK[m * BR + c];
        const float sa = -wave_sum(S * kk);
        S = S * dec + sa * (kk * a) + vi * k2;
        const float y = wave_sum(S * r);
        if (lane == 0) Y[m * BR + h * 64 + i] = y;
    }
}
__global__ __launch_bounds__(256) void k_rwkv_post(const float* __restrict__ Um, const float* __restrict__ Y, const float* __restrict__ G,
                                                   const float* __restrict__ r_k, const float* __restrict__ gn_g, const float* __restrict__ gn_b,
                                                   float* __restrict__ o) {
    const int wv = (blockIdx.x * 256 + threadIdx.x) >> 6, lane = threadIdx.x & 63; if (wv >= M * NH) return;
    const int h = wv & 7, m = wv >> 3, c = h * 64 + lane;
    const size_t i5 = (size_t)m * BR + c;
    const float y = Y[i5];
    const float mu = wave_sum(y) * (1.f / 64.f);
    const float d = y - mu;
    const float var = wave_sum(d * d) * (1.f / 64.f);
    float yn = d * rsqrtf(var + GN_EPS) * gn_g[c] + gn_b[c];
    const float r = Um[(size_t)m * SHIFT + c], k2 = Um[(size_t)m * SHIFT + 512 + c], v = Um[(size_t)m * SHIFT + 1024 + c];
    const float bonus = wave_sum(r * k2 * r_k[c]);
    yn += bonus * v;
    o[i5] = yn * G[i5];
}

__global__ void k_merge(float* __restrict__ merged, const float* __restrict__ Yb, const float* __restrict__ gates, int goff, int first) {
    const size_t idx = (size_t)blockIdx.x * blockDim.x + threadIdx.x; if (idx >= (size_t)M * D) return;
    const int n = (int)(idx % D), m = (int)(idx / D);
    const float v = sigmoidf_(gates[(size_t)m * 3072 + goff + n]) * Yb[idx];
    merged[idx] = first ? v : merged[idx] + v;
}
__global__ __launch_bounds__(256) void k_ln(const float* xres, const float* __restrict__ h, const float* __restrict__ g, const float* __restrict__ bta, float* out) {
    const int row = (blockIdx.x * 256 + threadIdx.x) >> 6, lane = threadIdx.x & 63; if (row >= M) return;
    float v[16]; float s = 0.f;
#pragma unroll
    for (int j = 0; j < 16; ++j) { const size_t i = (size_t)row * D + j * 64 + lane; v[j] = ALPHA * xres[i] + h[i]; s += v[j]; }
    const float mean = wave_sum(s) * (1.f / D);
    float q = 0.f;
#pragma unroll
    for (int j = 0; j < 16; ++j) { v[j] -= mean; q += v[j] * v[j]; }
    const float rstd = rsqrtf(wave_sum(q) * (1.f / D) + LN_EPS);
#pragma unroll
    for (int j = 0; j < 16; ++j) { const int c = j * 64 + lane; out[(size_t)row * D + c] = v[j] * rstd * g[c] + bta[c]; }
}

__global__ __launch_bounds__(256) void k_router(const float* __restrict__ x, const float* __restrict__ rw, int* __restrict__ cnt,
                                                int* __restrict__ asg_e, int* __restrict__ asg_rank, float* __restrict__ asg_gate) {
    const int m = (blockIdx.x * 256 + threadIdx.x) >> 6, lane = threadIdx.x & 63; if (m >= M) return;
    float lg[8];
#pragma unroll
    for (int e = 0; e < 8; ++e) lg[e] = 0.f;
    for (int j = 0; j < 16; ++j) { const int d = j * 64 + lane; const float xv = x[(size_t)m * D + d];
#pragma unroll
        for (int e = 0; e < 8; ++e) lg[e] = fmaf(xv, rw[d * NE + e], lg[e]); }
#pragma unroll
    for (int e = 0; e < 8; ++e) lg[e] = wave_sum(lg[e]);
    if (lane == 0) {
        int e1 = 0; float l1 = lg[0];
#pragma unroll
        for (int e = 1; e < 8; ++e) if (lg[e] > l1) { l1 = lg[e]; e1 = e; }
        int e2 = -1; float l2 = -INFINITY;
#pragma unroll
        for (int e = 0; e < 8; ++e) if (e != e1 && (e2 < 0 || lg[e] > l2)) { l2 = lg[e]; e2 = e; }
        const float p2 = expf(l2 - l1); const float g1 = 1.f / (1.f + p2), g2 = p2 / (1.f + p2);
        asg_e[2 * m] = e1; asg_e[2 * m + 1] = e2;
        asg_gate[2 * m] = g1; asg_gate[2 * m + 1] = g2;
        asg_rank[2 * m] = atomicAdd(&cnt[e1], 1); asg_rank[2 * m + 1] = atomicAdd(&cnt[e2], 1);
    }
}
__global__ void k_offsets(const int* __restrict__ cnt, int* __restrict__ off) { if (threadIdx.x == 0 && blockIdx.x == 0) { int s = 0; for (int e = 0; e < NE; ++e) { off[e] = s; s += cnt[e]; } off[NE] = s; } }
__global__ void k_perm(const int* __restrict__ asg_e, const int* __restrict__ asg_rank, const float* __restrict__ asg_gate, const int* __restrict__ off,
                       int* __restrict__ perm_tok, float* __restrict__ perm_gate) {
    const int a = blockIdx.x * blockDim.x + threadIdx.x; if (a >= 2 * M) return;
    const int pos = off[asg_e[a]] + asg_rank[a];
    perm_tok[pos] = a >> 1; perm_gate[pos] = asg_gate[a];
}

inline void gemm(hipStream_t s, const float* A, int lda, const int* a_idx, const float* Bm, int ldb, float* C, int ldc, int Mmax,
                 const int* m_cnt, const int* m_off, int N, int K, int epi, const int* c_idx, const float* c_scale) {
    dim3 grid(N / TN, (Mmax + TM - 1) / TM);
    hipLaunchKernelGGL(k_gemm, grid, dim3(256), 0, s, A, lda, a_idx, Bm, ldb, C, ldc, Mmax, m_cnt, m_off, N, K, epi, c_idx, c_scale);
}
}

extern "C" void kernel_launch(void* const* d_in, const int* in_sizes, int n_in, void* d_out, int out_size, void* d_ws, size_t ws_size, hipStream_t stream) {
    const float* x_in = (const float*)d_in[0];
    const float* w_in = (const float*)d_in[1];
    const float* conv_w = (const float*)d_in[2];
    const float* shift_mu = (const float*)d_in[3];
    const float* decay_w0 = (const float*)d_in[4];
    const float* decay_w2 = (const float*)d_in[5];
    const float* aaa_a0 = (const float*)d_in[6];
    const float* aaa_w2 = (const float*)d_in[7];
    const float* gate_w2 = (const float*)d_in[8];
    const float* k_k = (const float*)d_in[9];
    const float* k_a = (const float*)d_in[10];
    const float* r_k = (const float*)d_in[11];
    const float* gn_g = (const float*)d_in[12];
    const float* gn_b = (const float*)d_in[13];
    const float* w_branch = (const float*)d_in[14];
    const float* w_out = (const float*)d_in[15];
    const float* ln1_g = (const float*)d_in[16];
    const float* ln1_b = (const float*)d_in[17];
    const float* ln2_g = (const float*)d_in[18];
    const float* ln2_b = (const float*)d_in[19];
    const float* ffn_wg = (const float*)d_in[20];
    const float* ffn_wu = (const float*)d_in[21];
    const float* ffn_wd = (const float*)d_in[22];
    const float* router_w = (const float*)d_in[23];
    const float* moe_wg = (const float*)d_in[24];
    const float* moe_wu = (const float*)d_in[25];
    const float* moe_wd = (const float*)d_in[26];
    float* out = (float*)d_out;
    unsigned char* ws = (unsigned char*)d_ws;
    const size_t MiB = 1u << 20;
    int* cnt = (int*)(ws + 0);
    int* off = cnt + 16;
    float* kmean = (float*)(ws + 1 * MiB);
    int* sel = (int*)(ws + 2 * MiB);
    int* asg_e = (int*)(ws + 3 * MiB);
    int* asg_rank = asg_e + 2 * M;
    float* asg_gate = (float*)(asg_rank + 2 * M);
    int* perm_tok = (int*)(asg_gate + 2 * M);
    float* perm_gate = (float*)(perm_tok + 2 * M);
    float* X = (float*)(ws + 4 * MiB);
    float* Yr = (float*)(ws + 196 * MiB);
    const size_t SZ5 = (size_t)M * BR;
    const size_t SZD = (size_t)M * D;
    float* o_rwkv = Yr;
    float* o_conv = Yr + SZ5;
    float* o_att = Yr + 2 * SZ5;
    float* Um = Yr + 3 * SZ5;
    float* Ysc = X + 4 * SZ5;
    float* tmpY = Yr + 3 * SZ5;
    float* merged = tmpY + SZD;
    if (ws_size < (196 + 224) * MiB) return;

    for (int l = 0; l < 2; ++l) {
        const float* xres = (l == 0) ? x_in : out;
        const float* Wl_in = w_in + (size_t)l * D * PT;
        gemm(stream, xres, D, nullptr, Wl_in + 3072, PT, X, SHIFT, M, nullptr, nullptr, SHIFT, D, 0, nullptr, nullptr);
        hipLaunchKernelGGL(k_shiftmix, dim3((unsigned)(((size_t)M * SHIFT + 255) / 256)), dim3(256), 0, stream, X, shift_mu + l * SHIFT, Um);
        float* Wl = X; float* Al = X + SZ5; float* Gl = X + 2 * SZ5; float* KK = X + 3 * SZ5;
        gemm(stream, Um + 1536, SHIFT, nullptr, decay_w2 + (size_t)l * 64 * BR, BR, Wl, BR, M, nullptr, nullptr, BR, 64, 0, nullptr, nullptr);
        gemm(stream, Um + 1600, SHIFT, nullptr, aaa_w2 + (size_t)l * 64 * BR, BR, Al, BR, M, nullptr, nullptr, BR, 64, 0, nullptr, nullptr);
        gemm(stream, Um + 1664, SHIFT, nullptr, gate_w2 + (size_t)l * 128 * BR, BR, Gl, BR, M, nullptr, nullptr, BR, 128, 0, nullptr, nullptr);
        hipLaunchKernelGGL(k_rwkv_prep, dim3(M * NH / 4), dim3(256), 0, stream, Um, Wl, Al, KK, decay_w0 + l * BR, aaa_a0 + l * BR, k_k + l * BR, k_a + l * BR);
        hipLaunchKernelGGL(k_rwkv_scan, dim3(NB * NH * 64 / 4), dim3(256), 0, stream, Um, Wl, Al, KK, Ysc);
        hipLaunchKernelGGL(k_rwkv_post, dim3(M * NH / 4), dim3(256), 0, stream, Um, Ysc, Gl, r_k + l * BR, gn_g + l * BR, gn_b + l * BR, o_rwkv);
        gemm(stream, xres, D, nullptr, Wl_in + 0, PT, X, 1536, M, nullptr, nullptr, 1536, D, 0, nullptr, nullptr);
        hipLaunchKernelGGL(k_conv, dim3(M * BR / 256), dim3(256), 0, stream, X, conv_w + l * 3 * BR, o_conv);
        gemm(stream, xres, D, nullptr, Wl_in + 1536, PT, X, 1536, M, nullptr, nullptr, 1536, D, 0, nullptr, nullptr);
        hipLaunchKernelGGL(k_rope, dim3(M * 2 * NH * 32 / 256), dim3(256), 0, stream, X);
        hipLaunchKernelGGL(k_kmean, dim3(NB * NH * 16 * 64 / 256), dim3(256), 0, stream, X, kmean);
        hipLaunchKernelGGL(k_moba_sel, dim3(M * NH / 256), dim3(256), 0, stream, X, kmean, sel);
        hipLaunchKernelGGL(k_moba_attn, dim3(M * NH / 64), dim3(64), 0, stream, X, sel, o_att);
        gemm(stream, xres, D, nullptr, Wl_in + 4864, PT, X, 3072, M, nullptr, nullptr, 3072, D, 0, nullptr, nullptr);
        const float* wb = w_branch + (size_t)l * 1536 * D;
        const float* ob[3] = {o_conv, o_att, o_rwkv};
        for (int br = 0; br < 3; ++br) {
            gemm(stream, ob[br], BR, nullptr, wb + (size_t)br * BR * D, D, tmpY, D, M, nullptr, nullptr, D, BR, 0, nullptr, nullptr);
            hipLaunchKernelGGL(k_merge, dim3(M * D / 256), dim3(256), 0, stream, merged, tmpY, X, br * D, br == 0 ? 1 : 0);
        }
        gemm(stream, merged, D, nullptr, w_out + (size_t)l * D * D, D, tmpY, D, M, nullptr, nullptr, D, D, 0, nullptr, nullptr);
        hipLaunchKernelGGL(k_ln, dim3(M / 4), dim3(256), 0, stream, xres, tmpY, ln1_g + l * D, ln1_b + l * D, out);
        float* fbuf = tmpY;
        if (l == 0) {
            gemm(stream, out, D, nullptr, ffn_wg, DFF, X, DFF, M, nullptr, nullptr, DFF, D, 0, nullptr, nullptr);
            gemm(stream, out, D, nullptr, ffn_wu, DFF, X, DFF, M, nullptr, nullptr, DFF, D, 1, nullptr, nullptr);
            gemm(stream, X, DFF, nullptr, ffn_wd, D, fbuf, D, M, nullptr, nullptr, D, DFF, 0, nullptr, nullptr);
        } else {
            hipMemsetAsync(cnt, 0, 64, stream);
            hipMemsetAsync(fbuf, 0, SZD * sizeof(float), stream);
            hipLaunchKernelGGL(k_router, dim3(M / 4), dim3(256), 0, stream, out, router_w, cnt, asg_e, asg_rank, asg_gate);
            hipLaunchKernelGGL(k_offsets, dim3(1), dim3(64), 0, stream, cnt, off);
            hipLaunchKernelGGL(k_perm, dim3(2 * M / 256), dim3(256), 0, stream, asg_e, asg_rank, asg_gate, off, perm_tok, perm_gate);
            for (int e = 0; e < NE; ++e) {
                const float* wg = moe_wg + (size_t)e * D * DFF; const float* wu = moe_wu + (size_t)e * D * DFF; const float* wd = moe_wd + (size_t)e * DFF * D;
                gemm(stream, out, D, perm_tok, wg, DFF, X, DFF, M, cnt + e, off + e, DFF, D, 0, nullptr, nullptr);
                gemm(stream, out, D, perm_tok, wu, DFF, X, DFF, M, cnt + e, off + e, DFF, D, 1, nullptr, nullptr);
                gemm(stream, X, DFF, nullptr, wd, D, fbuf, D, M, cnt + e, off + e, D, DFF, 2, perm_tok, perm_gate);
            }
        }
        hipLaunchKernelGGL(k_ln, dim3(M / 4), dim3(256), 0, stream, out, fbuf, ln2_g + l * D, ln2_b + l * D, out);
    }
}
```

```cpp
#include <hip/hip_runtime.h>
#include <cstdio>
#include <cstdint>
#include <cmath>
namespace pg8 {
#define PG8_LAS __attribute__((address_space(3)))
typedef unsigned short bf16_t;
typedef short bf16x8 __attribute__((ext_vector_type(8)));
typedef float f32x4 __attribute__((ext_vector_type(4)));
typedef unsigned u32x4 __attribute__((ext_vector_type(4)));
constexpr int BM = 256, BK = 64, HALF = 128, HTB = HALF * BK * 2  , STAGE_BYTES = 8 * HTB, NXCD = 8, WGM = 8;

__host__ __device__ __forceinline__ int lds_byte(int r, int c) { const int st = (r >> 4) * 2 + (c >> 5), rr = r & 15, cc = c & 31, ob = rr * 64 + cc * 2; return st * 1024 + (ob ^ (((ob >> 9) & 1) << 5)); }
__host__ __device__ __forceinline__ void stage_rc(int b, int& R, int& C) { const int st = b / 1024, sb = b % 1024, swz = sb ^ (((sb >> 9) & 1) << 5); R = (st >> 1) * 16 + swz / 64; C = (st & 1) * 32 + (swz % 64) / 2; }
__host__ __device__ __forceinline__ int perm32(int rho) { const int n = rho >> 4, i = rho & 15; return 8 * (i >> 2) + 4 * n + (i & 3); }

struct Unit { int pm, pn; };
struct Gemm { const bf16_t* A; const bf16_t* Bt; int M, N, K; };

struct StaticOrder {
    int nM, nN, nwg, G, c;
    __host__ __device__ void init(int M, int N, int G_, int c_) { nM = M / BM; nN = N / BM; nwg = nM * nN; G = G_; c = c_; }
    __host__ __device__ bool next(int i, Unit& u) const {
        const long L = (long)i * G + c; if (L >= nwg) return false;
        int wgid = (int)L; { const int q = nwg / NXCD, r = nwg % NXCD, xcd = wgid % NXCD, off = wgid / NXCD; wgid = (xcd < r ? xcd * (q + 1) : r * (q + 1) + (xcd - r) * q) + off; }
        const int nig = WGM * nN, gid = wgid / nig, fm = gid * WGM, gsz = (nM - fm) < WGM ? (nM - fm) : WGM;
        u.pm = fm + ((wgid % nig) % gsz); u.pn = (wgid % nig) / gsz; return true;
    }
    __device__ __forceinline__ void a_ready(const Unit&) const {}
    __device__ __forceinline__ void done(const Unit&) const {}
    __device__ __forceinline__ size_t boff(const Unit&) const { return 0; }
};

__device__ __forceinline__ unsigned cvt_pk_bf16(float lo, float hi) { unsigned r; asm volatile("v_cvt_pk_bf16_f32 %0, %1, %2" : "=v"(r) : "v"(lo), "v"(hi)); return r; }
__device__ __forceinline__ float bf_lo(unsigned w) { return __uint_as_float(w << 16); }
__device__ __forceinline__ float bf_hi(unsigned w) { return __uint_as_float(w & 0xffff0000u); }
__device__ __forceinline__ float fast_exp(float x) { return __builtin_amdgcn_exp2f(x * 1.4426950408889634f); }
__device__ __forceinline__ float fast_sigmoid(float x) { return __builtin_amdgcn_rcpf(1.0f + fast_exp(-x)); }

struct EpiStoreBf16 {
    static constexpr bool PERM = true, AFTER_DRAIN = false, KHOOK = false;
    bf16_t* O; int ldc;
    __device__ __forceinline__ void khook(f32x4 (&)[2][2][4][2], const Unit&, int, int, int, int, int) const {}
    __device__ __forceinline__ void operator()(const f32x4 (&acc)[2][2][4][2], const Unit& u, int wr, int wc, int fr, int fq) const {
        const int row0 = u.pm * BM + wr * 64 + fr, col0 = u.pn * BM + wc * 32 + 8 * fq;
#pragma unroll
        for (int ai = 0; ai < 2; ++ai)
#pragma unroll
            for (int m = 0; m < 4; ++m) { bf16_t* rowp = O + (size_t)(row0 + ai * HALF + m * 16) * ldc + col0;
#pragma unroll
                for (int bj = 0; bj < 2; ++bj) { const f32x4 v0 = acc[ai][bj][m][0], v1 = acc[ai][bj][m][1];
                    u32x4 w; w.x = cvt_pk_bf16(v0[0], v0[1]); w.y = cvt_pk_bf16(v0[2], v0[3]); w.z = cvt_pk_bf16(v1[0], v1[1]); w.w = cvt_pk_bf16(v1[2], v1[3]);
                    *(u32x4*)(rowp + bj * HALF) = w; } }
    }
};

struct EpiMerge {
    static constexpr bool PERM = true, AFTER_DRAIN = false, KHOOK = true;
    bf16_t* O; int ldc; const bf16_t* gates; int ldg;
    __device__ __forceinline__ void khook(f32x4 (&acc)[2][2][4][2], const Unit& u, int t, int wr, int wc, int fr, int fq) const {
        const int b = (t >> 3) - 1;
        int fr_ = fr, fq_ = fq; asm volatile("" : "+v"(fr_), "+v"(fq_));
        const int row0 = u.pm * BM + wr * 64 + fr_, col0 = u.pn * BM + wc * 32 + 8 * fq_;
#pragma unroll
        for (int ai = 0; ai < 2; ++ai)
#pragma unroll
            for (int m = 0; m < 4; ++m) { const bf16_t* gp = gates + (size_t)(row0 + ai * HALF + m * 16) * ldg + b * 1024 + col0;
#pragma unroll
                for (int bj = 0; bj < 2; ++bj) { const u32x4 ga = *(const u32x4*)(gp + bj * HALF), gb = *(const u32x4*)(gp + bj * HALF + 1024);
                    const unsigned aw[4] = {ga.x, ga.y, ga.z, ga.w}, bw[4] = {gb.x, gb.y, gb.z, gb.w};
#pragma unroll
                    for (int q = 0; q < 4; ++q) {
                        const float r0 = (1.0f + fast_exp(-bf_lo(bw[q]))) * __builtin_amdgcn_rcpf(1.0f + fast_exp(-bf_lo(aw[q])));
                        const float r1 = (1.0f + fast_exp(-bf_hi(bw[q]))) * __builtin_amdgcn_rcpf(1.0f + fast_exp(-bf_hi(aw[q])));
                        acc[ai][bj][m][q >> 1][(q & 1) * 2 + 0] *= r0; acc[ai][bj][m][q >> 1][(q & 1) * 2 + 1] *= r1; }
                    asm volatile("" ::: "memory"); } }
    }
    __device__ __forceinline__ void operator()(const f32x4 (&acc)[2][2][4][2], const Unit& u, int wr, int wc, int fr, int fq) const {
        const int row0 = u.pm * BM + wr * 64 + fr, col0 = u.pn * BM + wc * 32 + 8 * fq;
#pragma unroll
        for (int ai = 0; ai < 2; ++ai)
#pragma unroll
            for (int m = 0; m < 4; ++m) { const size_t r = (size_t)(row0 + ai * HALF + m * 16); const bf16_t* gp = gates + r * ldg + 2 * 1024 + col0; bf16_t* rowp = O + r * ldc + col0;
#pragma unroll
                for (int bj = 0; bj < 2; ++bj) { const u32x4 gc = *(const u32x4*)(gp + bj * HALF); const f32x4 v0 = acc[ai][bj][m][0], v1 = acc[ai][bj][m][1];
                    u32x4 w;
                    w.x = cvt_pk_bf16(v0[0] * fast_sigmoid(bf_lo(gc.x)), v0[1] * fast_sigmoid(bf_hi(gc.x)));
                    w.y = cvt_pk_bf16(v0[2] * fast_sigmoid(bf_lo(gc.y)), v0[3] * fast_sigmoid(bf_hi(gc.y)));
                    w.z = cvt_pk_bf16(v1[0] * fast_sigmoid(bf_lo(gc.z)), v1[1] * fast_sigmoid(bf_hi(gc.z)));
                    w.w = cvt_pk_bf16(v1[2] * fast_sigmoid(bf_lo(gc.w)), v1[3] * fast_sigmoid(bf_hi(gc.w)));
                    *(u32x4*)(rowp + bj * HALF) = w; asm volatile("" ::: "memory"); } }
    }
};

struct EpiSwiGLU {
    static constexpr bool PERM = true, AFTER_DRAIN = false, KHOOK = false;
    bf16_t* O; int ldc;
    __device__ __forceinline__ void khook(f32x4 (&)[2][2][4][2], const Unit&, int, int, int, int, int) const {}
    __device__ __forceinline__ void operator()(const f32x4 (&acc)[2][2][4][2], const Unit& u, int wr, int wc, int fr, int fq) const {
        const int row0 = u.pm * BM + wr * 64 + fr, col0 = u.pn * HALF + wc * 32 + 8 * fq;
#pragma unroll
        for (int ai = 0; ai < 2; ++ai)
#pragma unroll
            for (int m = 0; m < 4; ++m) { bf16_t* rowp = O + (size_t)(row0 + ai * HALF + m * 16) * ldc + col0;
                float h[8];
#pragma unroll
                for (int n = 0; n < 2; ++n)
#pragma unroll
                    for (int i = 0; i < 4; ++i) { const float g = acc[ai][0][m][n][i], up = acc[ai][1][m][n][i]; h[n * 4 + i] = g * fast_sigmoid(g) * up; }
                u32x4 w; w.x = cvt_pk_bf16(h[0], h[1]); w.y = cvt_pk_bf16(h[2], h[3]); w.z = cvt_pk_bf16(h[4], h[5]); w.w = cvt_pk_bf16(h[6], h[7]);
                *(u32x4*)rowp = w; }
    }
};

struct EpiResF32 {
    static constexpr bool PERM = false, AFTER_DRAIN = false, KHOOK = false;
    const float* base; float* out; int ldc; float alpha;
    __device__ __forceinline__ void khook(f32x4 (&)[2][2][4][2], const Unit&, int, int, int, int, int) const {}
    __device__ __forceinline__ void operator()(const f32x4 (&acc)[2][2][4][2], const Unit& u, int wr, int wc, int fr, int fq) const {
        const int row0 = u.pm * BM + wr * 64 + fr, col0 = u.pn * BM + wc * 32 + 4 * fq;
#pragma unroll
        for (int ai = 0; ai < 2; ++ai)
#pragma unroll
            for (int m = 0; m < 4; ++m) { const size_t off = (size_t)(row0 + ai * HALF + m * 16) * ldc + col0;
#pragma unroll
                for (int bj = 0; bj < 2; ++bj)
#pragma unroll
                    for (int n = 0; n < 2; ++n) { const f32x4 bs = *(const f32x4*)(base + off + bj * HALF + n * 16); *(f32x4*)(out + off + bj * HALF + n * 16) = bs * alpha + acc[ai][bj][m][n]; } }
    }
};

struct MoeOrder : StaticOrder {
    const int* tile_e; size_t estride;
    __device__ __forceinline__ size_t boff(const Unit& u) const { return (size_t)__builtin_amdgcn_readfirstlane(tile_e[u.pm]) * estride; }
};

template <class Epi, class Sched, bool ALIGN_EPI = false, bool SP2 = false>
__device__ __forceinline__ void gemm_phase(PG8_LAS unsigned char* lds, const Gemm g, const Sched& S, const Epi& E, const int wave_s) {
    int lane_; asm volatile("v_mbcnt_lo_u32_b32 %0, -1, 0\n\tv_mbcnt_hi_u32_b32 %0, -1, %0" : "=v"(lane_));
    const int tid = wave_s * 64 + lane_, wid = wave_s, lane = tid & 63, wr = wid >> 2, wc = wid & 3, fr = lane & 15, fq = lane >> 4;
    const int K = g.K, nt = K / BK;
    unsigned voffA[2], voffB[2];
#pragma unroll
    for (int i = 0; i < 2; ++i) { int R, C; stage_rc(tid * 16 + i * 8192, R, C); const int Rb = Epi::PERM ? ((R & ~31) + perm32(R & 31)) : R;
        voffA[i] = (unsigned)(R * K + C) * 2u; voffB[i] = (unsigned)(Rb * K + C) * 2u; }
    const size_t kstep = (size_t)(BK * 2);
    const size_t hstep = (size_t)HALF * K * 2;
    const size_t tstep = 2 * hstep;
    const unsigned ldsw = (unsigned)wid * 1024u;
    const int aoff = lds_byte(wr * 64 + fr, fq * 8), boff = lds_byte(wc * 32 + fr, fq * 8);
#define PG8_SA(b, h) (((b) * 2 + (h)) * HTB)
#define PG8_SB(b, h) ((4 + (b) * 2 + (h)) * HTB)
#define PG8_STAGE(bufoff, gbase, voff) do { _Pragma("unroll") for (int _i = 0; _i < 2; ++_i) \
        __builtin_amdgcn_global_load_lds((const unsigned*)((const char*)(gbase) + (voff)[_i]), (PG8_LAS unsigned*)(lds + (bufoff) + ldsw + _i * 8192), 16, 0, 0); } while (0)
#define PG8_LDA(dst, b, h) do { _Pragma("unroll") for (int m = 0; m < 4; ++m) _Pragma("unroll") for (int k = 0; k < 2; ++k) dst[m][k] = *(const PG8_LAS bf16x8*)(lds + PG8_SA(b, h) + aoff + m * 2048 + k * 1024); } while (0)
#define PG8_LDB(dst, b, h) do { _Pragma("unroll") for (int n = 0; n < 2; ++n) _Pragma("unroll") for (int k = 0; k < 2; ++k) dst[n][k] = *(const PG8_LAS bf16x8*)(lds + PG8_SB(b, h) + boff + n * 2048 + k * 1024); } while (0)
#define PG8_MMA(ai, bj, At, Bt) do { __builtin_amdgcn_s_setprio(1); _Pragma("unroll") for (int m = 0; m < 4; ++m) _Pragma("unroll") for (int n = 0; n < 2; ++n) _Pragma("unroll") for (int k = 0; k < 2; ++k) \
        acc[ai][bj][m][n] = __builtin_amdgcn_mfma_f32_16x16x32_bf16(Bt[n][k], At[m][k], acc[ai][bj][m][n], 0, 0, 0); __builtin_amdgcn_s_setprio(0); } while (0)
#define PG8_WAIT_V(n) asm volatile("s_waitcnt vmcnt(" #n ")" ::: "memory")
#define PG8_WAIT_L(n) asm volatile("s_waitcnt lgkmcnt(" #n ")" ::: "memory")
#define PG8_BAR __builtin_amdgcn_s_barrier()
#define PG8_SCHED __builtin_amdgcn_sched_barrier(0)
    Unit cur, nxt; int ui = 0;
    if (!S.next(0, cur)) return;
    f32x4 acc[2][2][4][2];
#pragma unroll
    for (int a = 0; a < 2; ++a)
#pragma unroll
        for (int b = 0; b < 2; ++b)
#pragma unroll
            for (int m = 0; m < 4; ++m)
#pragma unroll
                for (int n = 0; n < 2; ++n) acc[a][b][m][n] = (f32x4){0.f, 0.f, 0.f, 0.f};
    bf16x8 At[4][2], B0[2][2], B1[2][2];
    const char* cA = (const char*)g.A + (size_t)cur.pm * tstep; const char* cB = (const char*)g.Bt + (size_t)cur.pn * tstep + S.boff(cur);
    S.a_ready(cur);
    if constexpr (SP2) {
        PG8_STAGE(PG8_SB(0, 0), cB, voffB); PG8_STAGE(PG8_SB(0, 1), cB + hstep, voffB); PG8_STAGE(PG8_SA(0, 0), cA, voffA); PG8_STAGE(PG8_SA(0, 1), cA + hstep, voffA);
        if (wr == 1) PG8_BAR;
        PG8_WAIT_V(2); PG8_BAR;
        PG8_STAGE(PG8_SB(1, 0), cB + kstep, voffB); PG8_STAGE(PG8_SA(1, 0), cA + kstep, voffA); PG8_STAGE(PG8_SB(1, 1), cB + hstep + kstep, voffB);
        PG8_WAIT_V(6); PG8_BAR;
    } else {
        PG8_STAGE(PG8_SB(0, 0), cB, voffB); PG8_STAGE(PG8_SA(0, 0), cA, voffA); PG8_STAGE(PG8_SB(0, 1), cB + hstep, voffB); PG8_STAGE(PG8_SA(0, 1), cA + hstep, voffA);
        if (wr == 1) PG8_BAR;
        PG8_WAIT_V(4); PG8_BAR;
        PG8_STAGE(PG8_SB(1, 0), cB + kstep, voffB); PG8_STAGE(PG8_SA(1, 0), cA + kstep, voffA); PG8_STAGE(PG8_SB(1, 1), cB + hstep + kstep, voffB);
        PG8_WAIT_V(6); PG8_BAR;
    }
    for (;;) {
        const bool has_next = S.next(ui + 1, nxt);
        const char* nA = has_next ? (const char*)g.A + (size_t)nxt.pm * tstep : cA; const char* nB = has_next ? (const char*)g.Bt + (size_t)nxt.pn * tstep + S.boff(nxt) : cB;
        for (int t = 0; t < nt; t += 2) {
            if constexpr (Epi::KHOOK) { if (t == 8 || t == 16) E.khook(acc, cur, t, wr, wc, fr, fq); }
            const bool last = (t == nt - 2);
            const char* a1 = cA + (size_t)(t + 1) * kstep;
            const char* a2 = last ? nA : cA + (size_t)(t + 2) * kstep; const char* b2 = last ? nB : cB + (size_t)(t + 2) * kstep;
            const char* a3 = a2 + kstep; const char* b3 = b2 + kstep;
            if (last && has_next) S.a_ready(nxt);
            if constexpr (SP2) {
            PG8_LDB(B0, 0, 0); PG8_LDB(B1, 0, 1); PG8_SCHED; PG8_LDA(At, 0, 0); PG8_STAGE(PG8_SA(1, 1), a1 + hstep, voffA);
            PG8_WAIT_V(8); PG8_WAIT_L(0); PG8_BAR; PG8_MMA(0, 0, At, B0); PG8_MMA(0, 1, At, B1); PG8_BAR; PG8_SCHED;
            PG8_LDA(At, 0, 1); PG8_STAGE(PG8_SB(0, 0), b2, voffB); PG8_STAGE(PG8_SB(0, 1), b2 + hstep, voffB); PG8_STAGE(PG8_SA(0, 0), a2, voffA);
            PG8_WAIT_V(8); PG8_WAIT_L(0); PG8_BAR; PG8_MMA(1, 0, At, B0); PG8_MMA(1, 1, At, B1); PG8_BAR; PG8_SCHED;
            PG8_LDB(B0, 1, 0); PG8_LDB(B1, 1, 1); PG8_SCHED; PG8_LDA(At, 1, 0); PG8_STAGE(PG8_SA(0, 1), a2 + hstep, voffA);
            PG8_WAIT_V(8); PG8_WAIT_L(0); PG8_BAR; PG8_MMA(0, 0, At, B0); PG8_MMA(0, 1, At, B1); PG8_BAR; PG8_SCHED;
            PG8_LDA(At, 1, 1); PG8_STAGE(PG8_SB(1, 0), b3, voffB); PG8_STAGE(PG8_SB(1, 1), b3 + hstep, voffB); PG8_STAGE(PG8_SA(1, 0), a3, voffA);
            PG8_WAIT_V(8); PG8_WAIT_L(0); PG8_BAR; PG8_MMA(1, 0, At, B0); PG8_MMA(1, 1, At, B1); PG8_BAR; PG8_SCHED;
            } else {
            PG8_LDB(B0, 0, 0); PG8_SCHED; PG8_LDA(At, 0, 0); PG8_STAGE(PG8_SA(1, 1), a1 + hstep, voffA);
            PG8_WAIT_L(8); PG8_BAR; PG8_WAIT_L(0); PG8_MMA(0, 0, At, B0); PG8_BAR; PG8_SCHED;
            PG8_LDB(B1, 0, 1); PG8_STAGE(PG8_SB(0, 0), b2, voffB);
            PG8_BAR; PG8_WAIT_L(0); PG8_MMA(0, 1, At, B1); PG8_BAR;
            PG8_LDA(At, 0, 1); PG8_STAGE(PG8_SA(0, 0), a2, voffA);
            PG8_BAR; PG8_WAIT_L(0); PG8_MMA(1, 0, At, B0); PG8_BAR; PG8_SCHED;
            PG8_STAGE(PG8_SB(0, 1), b2 + hstep, voffB);
            PG8_WAIT_V(6); PG8_BAR; PG8_MMA(1, 1, At, B1); PG8_BAR;
            PG8_LDB(B0, 1, 0); PG8_SCHED; PG8_LDA(At, 1, 0); PG8_STAGE(PG8_SA(0, 1), a2 + hstep, voffA);
            PG8_WAIT_L(8); PG8_BAR; PG8_WAIT_L(0); PG8_MMA(0, 0, At, B0); PG8_BAR; PG8_SCHED;
            PG8_LDB(B1, 1, 1); PG8_STAGE(PG8_SB(1, 0), b3, voffB);
            PG8_BAR; PG8_WAIT_L(0); PG8_MMA(0, 1, At, B1); PG8_BAR;
            PG8_LDA(At, 1, 1); PG8_STAGE(PG8_SA(1, 0), a3, voffA);
            PG8_BAR; PG8_WAIT_L(0); PG8_MMA(1, 0, At, B0); PG8_BAR; PG8_SCHED;
            PG8_STAGE(PG8_SB(1, 1), b3 + hstep, voffB);
            PG8_WAIT_V(6); PG8_BAR; PG8_MMA(1, 1, At, B1); PG8_BAR;
            }
        }
        if constexpr (ALIGN_EPI) { if (wr == 0) PG8_BAR; }
        if constexpr (!Epi::AFTER_DRAIN) { E(acc, cur, wr, wc, fr, fq); S.done(cur); }
        if (!has_next) break;
#pragma unroll
        for (int a = 0; a < 2; ++a)
#pragma unroll
            for (int b = 0; b < 2; ++b)
#pragma unroll
                for (int m = 0; m < 4; ++m)
#pragma unroll
                    for (int n = 0; n < 2; ++n) acc[a][b][m][n] = (f32x4){0.f, 0.f, 0.f, 0.f};
        cur = nxt; cA = nA; cB = nB; ++ui;
        if constexpr (ALIGN_EPI) { if (wr == 1) PG8_BAR; }
    }
    PG8_WAIT_V(0);
    if constexpr (!ALIGN_EPI) { if (wr == 0) PG8_BAR; }
    PG8_BAR;
    if constexpr (Epi::AFTER_DRAIN) { E.fused(acc, cur, wr, wc, fr, fq, lds, wid, lane); S.done(cur); }
#undef PG8_SA
#undef PG8_SB
#undef PG8_STAGE
#undef PG8_LDA
#undef PG8_LDB
#undef PG8_MMA
#undef PG8_WAIT_V
#undef PG8_WAIT_L
#undef PG8_BAR
#undef PG8_SCHED
}

}

constexpr int NWAVES = 8;
constexpr int D = 1024, NB = 4, T = 4096, M = NB * T, BR = 512, NH = 8, PT = 7936, DFF = 2816, NE = 8, SHIFT = 1792;
constexpr float LN_EPS = 1e-5f, GN_EPS = 64e-5f;
constexpr float ALPHA = 1.41421356237309515f;
constexpr float C2 = 0.125f * 1.4426950408889634f;
constexpr int PC_CH = 0, PC_CB = 512, PC_CC = 1024, PC_Q = 1536, PC_K = 2048, PC_V = 2560, PC_R = 3072, PC_RK = 3584, PC_RV = 4096, PC_WL = 4608, PC_AL = 4672, PC_GL = 4736, PC_GATE = 4864;
constexpr int MOE_MAXT = 136, MOE_ROWS_MAX = MOE_MAXT * 256;

constexpr size_t MiB = 1u << 20;
constexpr size_t WS_CTL = 0, CTL_ZERO_BYTES = 1 * MiB;
constexpr size_t WS_MISC = 1 * MiB;
constexpr size_t WS_XB = 2 * MiB;
constexpr size_t WS_MERGED = 34 * MiB;
constexpr size_t WS_RWX = 2 * MiB;
constexpr size_t WS_W = 66 * MiB;
constexpr size_t WS_PROJ = 124 * MiB;
constexpr size_t WS_OCAT = 372 * MiB;
constexpr size_t WS_YSC = 420 * MiB;
constexpr size_t WS_MISC2 = 436 * MiB;
constexpr size_t WS_HBUF = WS_PROJ;
constexpr size_t WS_MOEW = 124 * MiB;
constexpr size_t WS_HMOE = 256 * MiB;
constexpr size_t WS_XS = 34 * MiB;
constexpr size_t WS_YBUF = 2 * MiB;
constexpr size_t WS_END = 444 * MiB;
constexpr size_t W_IN_SZ = (size_t)PT * D, W_BR_SZ = (size_t)D * 1536, W_O_SZ = (size_t)D * D, W_GU_SZ = (size_t)2 * DFF * D, W_D_SZ = (size_t)D * DFF;
constexpr size_t WO_IN = 0, WO_BR = WO_IN + 2 * W_IN_SZ, WO_O = WO_BR + 2 * W_BR_SZ, WO_GU = WO_O + 2 * W_O_SZ, WO_D = WO_GU + W_GU_SZ, WO_END = WO_D + W_D_SZ;
static_assert(WO_END * 2 <= 58 * MiB, "weights fit");
constexpr size_t MOE_E_SZ = W_GU_SZ + W_D_SZ;
static_assert(WS_MOEW + NE * MOE_E_SZ * 2 <= WS_HMOE, "moe weights fit");
static_assert(WS_HMOE + (size_t)MOE_ROWS_MAX * DFF * 2 <= WS_END, "hmoe fits");
constexpr size_t M2_ROPE = 0;
constexpr size_t M2_KSUM = 1 * MiB;
constexpr size_t M1_ASG = 0;
constexpr size_t M1_TILE = 768 * 1024;
constexpr int CW_BAR = 4096;
constexpr int CW_CNT = 64;

constexpr int RING_OFF = 0, RING_BYTES = 131072;
constexpr int LDSCTL_OFF = RING_BYTES, MISC_OFF = LDSCTL_OFF + 320;
constexpr int LDS_BYTES = 147456;

#define GAS __attribute__((address_space(1)))
#define LAS __attribute__((address_space(3)))
typedef unsigned short bf16;
typedef unsigned v4u __attribute__((ext_vector_type(4)));
typedef unsigned v2u __attribute__((ext_vector_type(2)));
typedef float f32x4 __attribute__((ext_vector_type(4)));
typedef GAS unsigned gu32;
#define RLX_AGENT __ATOMIC_RELAXED, __HIP_MEMORY_SCOPE_AGENT
#define LDS_WAIT() asm volatile("s_waitcnt lgkmcnt(0)" ::: "memory")
__device__ __forceinline__ unsigned f2bf(float f) { unsigned u = __builtin_bit_cast(unsigned, f); return (u + 0x7fffu + ((u >> 16) & 1u)) >> 16; }
__device__ __forceinline__ unsigned pk2(float lo, float hi) { return f2bf(lo) | (f2bf(hi) << 16); }
__device__ __forceinline__ float bflo(unsigned w) { return __uint_as_float(w << 16); }
__device__ __forceinline__ float bfhi(unsigned w) { return __uint_as_float(w & 0xffff0000u); }
__device__ __forceinline__ float bf1(bf16 h) { return __uint_as_float((unsigned)h << 16); }
__device__ __forceinline__ void unpack8(const v4u w, float (&f)[8]) { f[0] = bflo(w.x); f[1] = bfhi(w.x); f[2] = bflo(w.y); f[3] = bfhi(w.y); f[4] = bflo(w.z); f[5] = bfhi(w.z); f[6] = bflo(w.w); f[7] = bfhi(w.w); }
__device__ __forceinline__ v4u pack8(const float (&f)[8]) { v4u w; w.x = pk2(f[0], f[1]); w.y = pk2(f[2], f[3]); w.z = pk2(f[4], f[5]); w.w = pk2(f[6], f[7]); return w; }
__device__ __forceinline__ float wave_sum(float v) {
#pragma unroll
    for (int o = 1; o < 64; o <<= 1) v += __shfl_xor(v, o);
    return v;
}
__device__ __forceinline__ float sum8lanes(float v) { v += __shfl_xor(v, 1); v += __shfl_xor(v, 2); v += __shfl_xor(v, 4); return v; }
__device__ __forceinline__ float sigmoidf_(float x) { return 1.f / (1.f + expf(-x)); }

__device__ __forceinline__ int lane_id() { int r; asm volatile("v_mbcnt_lo_u32_b32 %0, -1, 0\n\tv_mbcnt_hi_u32_b32 %0, -1, %0" : "=v"(r)); return r; }
#define XB_TMO      128
#define XB_XCNT(j)  (256  + 64 * (j))
#define XB_XSUB(j)  (1280 + 64 * (j))
#define XB_XGEN(j)  (2304 + 64 * (j))
#define XB_TOP      3328
#define XB_TOPGEN   3392
#define XCD_BAR_WORDS 3456
#define XB_SPIN_CAP (1u << 18)
__device__ __forceinline__ unsigned xb_ld(unsigned* p)              { return __hip_atomic_load(p, __ATOMIC_RELAXED, __HIP_MEMORY_SCOPE_AGENT); }
__device__ __forceinline__ unsigned xb_add(unsigned* p, unsigned v) { return __hip_atomic_fetch_add(p, v, __ATOMIC_RELAXED, __HIP_MEMORY_SCOPE_AGENT); }
__device__ __forceinline__ unsigned xb_xcc_id() { return (unsigned)__builtin_amdgcn_s_getreg((3 << 11) | 20) & 0xFu; }
#define XB_SPIN(cond, bar) do { unsigned _sp = 0; while (cond) { __builtin_amdgcn_s_sleep(1); \
    if ((++_sp & 255u) == 0u) { if (xb_ld(&(bar)[XB_TMO])) break; if (_sp > XB_SPIN_CAP) { atomicAdd(&(bar)[XB_TMO], 1u); break; } } } } while (0)
struct XcdBarrier { unsigned* bar; unsigned x; volatile LAS unsigned* st; };
__device__ __forceinline__ XcdBarrier xcd_barrier_post(unsigned* bar, volatile LAS unsigned* st, const bool leader) {
    XcdBarrier b; b.bar = bar; b.x = xb_xcc_id(); b.st = st;
    if (leader) (void)xb_add(&bar[XB_XCNT(b.x)], 1u);
    return b;
}
__device__ __forceinline__ void xcd_barrier_complete(unsigned* bar, unsigned x, unsigned& nloc, unsigned& nx) {
    const unsigned G = gridDim.x * gridDim.y * gridDim.z;
    unsigned sum, cnt, mine, sp = 0u;
    for (;;) {
        sum = 0u; cnt = 0u; mine = 0u;
#pragma unroll
        for (unsigned j = 0; j < 16; ++j) { const unsigned c = xb_ld(&bar[XB_XCNT(j)]); sum += c; cnt += (c > 0u) ? 1u : 0u; mine = (j == x) ? c : mine; }
        if (sum == G) break;
        __builtin_amdgcn_s_sleep(1);
        if ((++sp & 255u) == 0u) { if (xb_ld(&bar[XB_TMO])) break; if (sp > XB_SPIN_CAP) { atomicAdd(&bar[XB_TMO], 1u); break; } }
    }
    nloc = mine > 0u ? mine : 1u; nx = cnt > 0u ? cnt : 1u;
}
__device__ __forceinline__ void xcd_barrier(const XcdBarrier& b, const bool leader) {
    asm volatile("s_waitcnt vmcnt(0)" ::: "memory");
    __syncthreads();
    if (leader) {
        unsigned* bar = b.bar;
        __builtin_amdgcn_s_waitcnt(0);
        unsigned nloc = b.st[0], nx = b.st[1];
        if (nloc == 0u) { xcd_barrier_complete(bar, b.x, nloc, nx); b.st[0] = nloc; b.st[1] = nx; }
        const unsigned old = xb_add(&bar[XB_XSUB(b.x)], 1u);
        const unsigned gen = old / nloc;
        if (old + 1u == (gen + 1u) * nloc) {
            __builtin_amdgcn_fence(__ATOMIC_RELEASE, "agent");
            asm volatile("s_waitcnt vmcnt(0)" ::: "memory");
            const unsigned og = xb_add(&bar[XB_TOP], 1u);
            const unsigned tg = og / nx;
            if (og + 1u == (tg + 1u) * nx) xb_add(&bar[XB_TOPGEN], 1u);
            else XB_SPIN(xb_ld(&bar[XB_TOPGEN]) == tg, bar);
            __builtin_amdgcn_fence(__ATOMIC_ACQUIRE, "agent");
            xb_add(&bar[XB_XGEN(b.x)], 1u);
            asm volatile("s_waitcnt vmcnt(0)" ::: "memory");
        } else {
            XB_SPIN(xb_ld(&bar[XB_XGEN(b.x)]) == gen, bar);
            __builtin_amdgcn_fence(__ATOMIC_ACQUIRE, "agent");
            asm volatile("s_waitcnt vmcnt(0)" ::: "memory");
        }
    }
    __syncthreads();
}

struct Frame {
    LAS unsigned char* lds;
    int tid, lane, wave;
    int vcu, G;
};
__device__ __forceinline__ Frame make_frame(LAS unsigned char* lds, const int wave_s) {
    Frame F; F.lds = lds;
    const int t = lane_id(); F.lane = t; F.wave = wave_s; F.tid = wave_s * 64 + t;
    int bx = blockIdx.x, G = gridDim.x; asm volatile("" : "+s"(bx), "+s"(G));
    F.G = G; F.vcu = (G % 8 == 0) ? (bx % 8) * (G / 8) + bx / 8 : bx;
    return F;
}

__device__ __forceinline__ int opq(int x) { asm volatile("" : "+v"(x)); return x; }
__device__ __forceinline__ void p0_transpose_item(const float* W, int ldw, int K, int N, bf16* WT, int row_off, int mode, LAS float* scr, int item, int lane) {
    const int nblk = N / 32, kb = item / nblk, nb = item % nblk, k0 = 64 * kb, n0 = 32 * nb;
#pragma unroll 8
    for (int i = 0; i < 32; ++i) { const int kk = 2 * i + (lane >> 5); scr[kk * 33 + (lane & 31)] = W[(size_t)(k0 + kk) * ldw + n0 + (lane & 31)]; }
    LDS_WAIT(); asm volatile("" ::: "memory");
    const int c = lane & 7;
    const int obase = mode ? (256 * (n0 >> 7) + (n0 & 127) + row_off) : (row_off + n0);
#pragma unroll
    for (int j = 0; j < 4; ++j) { const int n = (lane >> 3) + 8 * j; const LAS float* s = scr + (8 * c) * 33 + n;
        v4u o; o.x = pk2(s[0 * 33], s[1 * 33]); o.y = pk2(s[2 * 33], s[3 * 33]); o.z = pk2(s[4 * 33], s[5 * 33]); o.w = pk2(s[6 * 33], s[7 * 33]);
        *(GAS v4u*)(WT + (size_t)(obase + n) * K + k0 + 8 * c) = o; }
    LDS_WAIT(); asm volatile("" ::: "memory");
}

typedef __attribute__((address_space(4))) const unsigned long long* kargp_t;
__device__ __forceinline__ unsigned long long karg_u64(int idx) { kargp_t kp = (kargp_t)__builtin_amdgcn_kernarg_segment_ptr(); asm volatile("" : "+s"(kp)); return kp[idx]; }
#define INP(k) ((const float*)karg_u64(k))
#define OUTP() ((float*)karg_u64(27))
#define WSP() ((unsigned char*)karg_u64(28))
enum { I_X = 0, I_WIN, I_CONVW, I_MU, I_DW0, I_DW2, I_AA0, I_AW2, I_GW2, I_KK, I_KA, I_RK, I_GNG, I_GNB, I_WBR, I_WOUT, I_LN1G, I_LN1B, I_LN2G, I_LN2B, I_FWG, I_FWU, I_FWD, I_RW, I_MWG, I_MWU, I_MWD };

__device__ __forceinline__ void p0_prologue(LAS unsigned char* lds_, const int wave_s) {
    const Frame F = make_frame(lds_, wave_s);
    LAS float* scr = (LAS float*)(F.lds + RING_OFF + F.wave * 16384);
    const int gw = F.vcu * NWAVES + F.wave, NGW = F.G * NWAVES;
    bf16* Wb = (bf16*)(WSP() + WS_W);
    constexpr int I_IN = 16 * 248, I_BR = 24 * 32, I_O = 16 * 32, I_G = 16 * 88, I_D = 44 * 32;
    constexpr int I_LAYER = I_IN + I_BR + I_O;
    constexpr int NITEMS = 2 * I_LAYER + 2 * I_G + I_D;
    for (int it = gw; it < NITEMS; it += NGW) {
        int r = it;
        if (r < 2 * I_LAYER) { const int l = r / I_LAYER; r -= l * I_LAYER;
            if (r < I_IN) { p0_transpose_item(INP(I_WIN) + (size_t)l * D * PT, PT, D, PT, Wb + WO_IN + l * W_IN_SZ, 0, 0, scr, r, F.lane); continue; } r -= I_IN;
            if (r < I_BR) { p0_transpose_item(INP(I_WBR) + (size_t)l * 1536 * D, D, 1536, D, Wb + WO_BR + l * W_BR_SZ, 0, 0, scr, r, F.lane); continue; } r -= I_BR;
            p0_transpose_item(INP(I_WOUT) + (size_t)l * D * D, D, D, D, Wb + WO_O + l * W_O_SZ, 0, 0, scr, r, F.lane); continue; }
        r -= 2 * I_LAYER;
        if (r < I_G) { p0_transpose_item(INP(I_FWG), DFF, D, DFF, Wb + WO_GU, 0, 1, scr, r, F.lane); continue; } r -= I_G;
        if (r < I_G) { p0_transpose_item(INP(I_FWU), DFF, D, DFF, Wb + WO_GU, 128, 1, scr, r, F.lane); continue; } r -= I_G;
        p0_transpose_item(INP(I_FWD), D, DFF, D, Wb + WO_D, 0, 0, scr, r, F.lane);
    }
    bf16* XB = (bf16*)(WSP() + WS_XB);
    for (int m = gw; m < M; m += NGW) {
        const GAS f32x4* xr = (const GAS f32x4*)(INP(I_X) + (size_t)m * D) + F.lane;
        GAS unsigned long long* o8 = (GAS unsigned long long*)(XB + (size_t)m * D) + F.lane;
#pragma unroll
        for (int j = 0; j < 4; ++j) { const f32x4 v = xr[64 * j]; o8[64 * j] = (unsigned long long)pk2(v.x, v.y) | ((unsigned long long)pk2(v.z, v.w) << 32); }
    }
    float* rc = (float*)(WSP() + WS_MISC2 + M2_ROPE); float* rs = rc + T * 32;
    for (int i = F.vcu * 512 + F.tid; i < T * 32; i += F.G * 512) {
        const int t = i >> 5, d = i & 31;
        const float inv = powf(10000.0f, -(float)d / 32.0f); const float ang = (float)t * inv;
        float s, c; sincosf(ang, &s, &c); rc[i] = c; rs[i] = s;
    }
}
__device__ __forceinline__ void moe_weight_prologue(LAS unsigned char* lds_, const int wave_s) {
    const Frame F = make_frame(lds_, wave_s);
    LAS float* scr = (LAS float*)(F.lds + RING_OFF + F.wave * 16384);
    const int gw = F.vcu * NWAVES + F.wave, NGW = F.G * NWAVES;
    bf16* Wm = (bf16*)(WSP() + WS_MOEW);
    constexpr int I_G = 16 * 88, I_D = 44 * 32, I_E = 2 * I_G + I_D;
    for (int it = gw; it < NE * I_E; it += NGW) {
        const int e = it / I_E; int r = it - e * I_E;
        bf16* We = Wm + (size_t)e * MOE_E_SZ;
        if (r < I_G) { p0_transpose_item(INP(I_MWG) + (size_t)e * D * DFF, DFF, D, DFF, We, 0, 1, scr, r, F.lane); continue; } r -= I_G;
        if (r < I_G) { p0_transpose_item(INP(I_MWU) + (size_t)e * D * DFF, DFF, D, DFF, We, 128, 1, scr, r, F.lane); continue; } r -= I_G;
        p0_transpose_item(INP(I_MWD) + (size_t)e * DFF * D, D, DFF, D, We + W_GU_SZ, 0, 0, scr, r, F.lane);
    }
}

__device__ __forceinline__ void m2a_rope(LAS unsigned char* lds_, const int wave_s, bf16* proj) {
    const Frame F = make_frame(lds_, wave_s);
    const float* rc = (const float*)(WSP() + WS_MISC2 + M2_ROPE); const float* rs = rc + T * 32;
    float* ksum = (float*)(WSP() + WS_MISC2 + M2_KSUM);
    LAS float* ksl = (LAS float*)(F.lds);
    const int combo = F.lane >> 2, qk = combo >> 3, h = combo & 7, c = F.lane & 3;
    for (int u = F.vcu; u < M / 64; u += F.G) {
        float ks1[8], ks2[8];
#pragma unroll
        for (int j = 0; j < 8; ++j) { ks1[j] = 0.f; ks2[j] = 0.f; }
        for (int rr = 0; rr < 8; ++rr) {
            const int row = 64 * u + 8 * F.wave + rr, t = row % T;
            bf16* p = proj + (size_t)row * PT + (qk ? PC_K : PC_Q) + h * 64 + 8 * c;
            float x1[8], x2[8], cs[8], sn[8];
            unpack8(*(const v4u*)p, x1); unpack8(*(const v4u*)(p + 32), x2);
            const f32x4 c0 = *(const f32x4*)(rc + t * 32 + 8 * c), c1 = *(const f32x4*)(rc + t * 32 + 8 * c + 4);
            const f32x4 s0 = *(const f32x4*)(rs + t * 32 + 8 * c), s1 = *(const f32x4*)(rs + t * 32 + 8 * c + 4);
#pragma unroll
            for (int j = 0; j < 4; ++j) { cs[j] = c0[j]; cs[4 + j] = c1[j]; sn[j] = s0[j]; sn[4 + j] = s1[j]; }
            float o1[8], o2[8];
#pragma unroll
            for (int j = 0; j < 8; ++j) { o1[j] = x1[j] * cs[j] - x2[j] * sn[j]; o2[j] = x2[j] * cs[j] + x1[j] * sn[j]; }
            if (qk) {
#pragma unroll
                for (int j = 0; j < 8; ++j) { ks1[j] += o1[j]; ks2[j] += o2[j]; }
            } else {
#pragma unroll
                for (int j = 0; j < 8; ++j) { o1[j] *= C2; o2[j] *= C2; }
            }
            *(v4u*)p = pack8(o1); *(v4u*)(p + 32) = pack8(o2);
        }
        if (qk) {
#pragma unroll
            for (int j = 0; j < 8; ++j) { ksl[(F.wave * 8 + h) * 64 + 8 * c + j] = ks1[j]; ksl[(F.wave * 8 + h) * 64 + 32 + 8 * c + j] = ks2[j]; }
        }
        __syncthreads();
        { const int hh = F.tid >> 6, d = F.tid & 63; float s = 0.f;
#pragma unroll
          for (int w = 0; w < 8; ++w) s += ksl[(w * 8 + hh) * 64 + d];
          const int b = u / 64, n = (u % 64) >> 2, part = u & 3;
          ksum[((((size_t)b * NH + hh) * 16 + n) * 4 + part) * 64 + d] = s; }
        __syncthreads();
    }
}
__device__ __forceinline__ void m2a_conv(LAS unsigned char* lds_, const int wave_s, const bf16* proj, const float* cw  , bf16* ocat) {
    const Frame F = make_frame(lds_, wave_s);
    const int gw = F.vcu * NWAVES + F.wave, NGW = F.G * NWAVES, c0 = 8 * F.lane;
    float w0[8], w1[8], w2[8];
#pragma unroll
    for (int j = 0; j < 8; ++j) { w0[j] = cw[c0 + j]; w1[j] = cw[BR + c0 + j]; w2[j] = cw[2 * BR + c0 + j]; }
    for (int m = gw; m < M; m += NGW) {
        const int t = m % T; const bf16* r0 = proj + (size_t)m * PT + c0;
        float ch[8], cc[8], cb[8], u0[8], u1[8], u2[8];
        unpack8(*(const v4u*)(r0 + PC_CH), ch); unpack8(*(const v4u*)(r0 + PC_CC), cc); unpack8(*(const v4u*)(r0 + PC_CB), cb);
#pragma unroll
        for (int j = 0; j < 8; ++j) { u0[j] = cc[j] * ch[j]; u1[j] = 0.f; u2[j] = 0.f; }
        if (t >= 1) { unpack8(*(const v4u*)(r0 - PT + PC_CH), ch); unpack8(*(const v4u*)(r0 - PT + PC_CC), cc);
#pragma unroll
            for (int j = 0; j < 8; ++j) u1[j] = cc[j] * ch[j]; }
        if (t >= 2) { unpack8(*(const v4u*)(r0 - 2 * PT + PC_CH), ch); unpack8(*(const v4u*)(r0 - 2 * PT + PC_CC), cc);
#pragma unroll
            for (int j = 0; j < 8; ++j) u2[j] = cc[j] * ch[j]; }
        float o[8];
#pragma unroll
        for (int j = 0; j < 8; ++j) o[j] = cb[j] * (w0[j] * u2[j] + w1[j] * u1[j] + w2[j] * u0[j]);
        *(v4u*)(ocat + (size_t)m * 1536 + c0) = pack8(o);
    }
}
__device__ __forceinline__ void m2a_rwkv_prep(LAS unsigned char* lds_, const int wave_s, int l, const bf16* proj, bf16* rwx, bf16* ocat) {
    const Frame F = make_frame(lds_, wave_s);
    const int gw = F.vcu * NWAVES + F.wave, NGW = F.G * NWAVES, lane = F.lane, c0 = 8 * lane;
    LAS float* lin = (LAS float*)(F.lds + 16384 + F.wave * 8192);
    const float* mu = INP(I_MU) + l * SHIFT;
    const f32x4 mul = *(const f32x4*)(mu + 1536 + 4 * lane);
    for (int ru = gw; ru < M / 8; ru += NGW) {
        const int r0 = 8 * ru;
#pragma unroll
        for (int rr = 0; rr < 8; ++rr) {
            const int row = r0 + rr, t = row % T;
            const v2u cur = *(const v2u*)(proj + (size_t)row * PT + PC_WL + 4 * lane);
            v2u prv; prv.x = 0u; prv.y = 0u; if (t >= 1) prv = *(const v2u*)(proj + (size_t)(row - 1) * PT + PC_WL + 4 * lane);
            float u[4] = {bflo(cur.x), bfhi(cur.x), bflo(cur.y), bfhi(cur.y)}, up[4] = {bflo(prv.x), bfhi(prv.x), bflo(prv.y), bfhi(prv.y)};
            f32x4 v;
#pragma unroll
            for (int j = 0; j < 4; ++j) { float x = u[j] + (up[j] - u[j]) * mul[j]; if (lane < 16) x = tanhf(x); else if (lane >= 32) x = sigmoidf_(x); v[j] = x; }
            *(LAS f32x4*)(lin + rr * 256 + 4 * lane) = v;
        }
        LDS_WAIT(); asm volatile("" ::: "memory");
        float acc[8][8];
#define LORA_PASS(WPTR, KOFF, KLEN) do { \
        _Pragma("unroll") for (int rr = 0; rr < 8; ++rr) _Pragma("unroll") for (int j = 0; j < 8; ++j) acc[rr][j] = 0.f; \
        for (int k = 0; k < (KLEN); k += 4) { \
            f32x4 wa[4], wb[4]; \
            _Pragma("unroll") for (int q = 0; q < 4; ++q) { wa[q] = *(const f32x4*)((WPTR) + (size_t)(k + q) * BR + c0); wb[q] = *(const f32x4*)((WPTR) + (size_t)(k + q) * BR + c0 + 4); } \
            _Pragma("unroll") for (int rr = 0; rr < 8; ++rr) { const f32x4 in = *(const LAS f32x4*)(lin + rr * 256 + (KOFF) + k); \
                _Pragma("unroll") for (int q = 0; q < 4; ++q) _Pragma("unroll") for (int j = 0; j < 4; ++j) { acc[rr][j] = fmaf(in[q], wa[q][j], acc[rr][j]); acc[rr][4 + j] = fmaf(in[q], wb[q][j], acc[rr][4 + j]); } } \
        } } while (0)
        LORA_PASS(INP(I_DW2) + (size_t)l * 64 * BR, 0, 64);
        {
            float w0v[8];
#pragma unroll
            for (int j = 0; j < 8; ++j) w0v[j] = INP(I_DW0)[l * BR + c0 + j];
#pragma unroll
            for (int rr = 0; rr < 8; ++rr) { float o[8];
#pragma unroll
                for (int j = 0; j < 8; ++j) { const float z = -(w0v[j] + acc[rr][j]); const float sp = fmaxf(z, 0.f) + log1pf(expf(-fabsf(z))); o[j] = -expf(-sp - 0.5f); }
                *(v4u*)(rwx + (size_t)(r0 + rr) * 2048 + 1024 + c0) = pack8(o); }
        }
        LORA_PASS(INP(I_AW2) + (size_t)l * 64 * BR, 64, 64);
        {
            float a0v[8], kkv[8], kav[8], muk[8];
#pragma unroll
            for (int j = 0; j < 8; ++j) { a0v[j] = INP(I_AA0)[l * BR + c0 + j]; kkv[j] = INP(I_KK)[l * BR + c0 + j]; kav[j] = INP(I_KA)[l * BR + c0 + j]; muk[j] = mu[512 + c0 + j]; }
#pragma unroll
            for (int rr = 0; rr < 8; ++rr) {
                const int row = r0 + rr, t = row % T;
                float kc[8], kp[8];
                unpack8(*(const v4u*)(proj + (size_t)row * PT + PC_RK + c0), kc);
                if (t >= 1) unpack8(*(const v4u*)(proj + (size_t)(row - 1) * PT + PC_RK + c0), kp);
                else {
#pragma unroll
                    for (int j = 0; j < 8; ++j) kp[j] = 0.f; }
                float k2[8], kk[8], bb[8]; float ss = 0.f;
#pragma unroll
                for (int j = 0; j < 8; ++j) { const float km = kc[j] + (kp[j] - kc[j]) * muk[j]; const float a = sigmoidf_(a0v[j] + acc[rr][j]);
                    kk[j] = km * kkv[j]; ss += kk[j] * kk[j]; k2[j] = km * (1.f + (a - 1.f) * kav[j]); bb[j] = a; }
                ss = sum8lanes(ss);
                const float inv = 1.f / fmaxf(sqrtf(ss), 1e-12f);
#pragma unroll
                for (int j = 0; j < 8; ++j) { kk[j] *= inv; bb[j] *= kk[j]; }
                bf16* o = rwx + (size_t)row * 2048 + c0;
                *(v4u*)(o) = pack8(k2); *(v4u*)(o + 512) = pack8(kk); *(v4u*)(o + 1536) = pack8(bb);
            }
        }
        LORA_PASS(INP(I_GW2) + (size_t)l * 128 * BR, 128, 128);
#pragma unroll
        for (int rr = 0; rr < 8; ++rr) { float o[8];
#pragma unroll
            for (int j = 0; j < 8; ++j) o[j] = acc[rr][j];
            *(v4u*)(ocat + (size_t)(r0 + rr) * 1536 + 1024 + c0) = pack8(o); }
#undef LORA_PASS
        LDS_WAIT(); asm volatile("" ::: "memory");
    }
}

__device__ __forceinline__ void m2b_attn_naive(LAS unsigned char* lds_, const int wave_s, const bf16* proj, bf16* ocat) {
    const Frame F = make_frame(lds_, wave_s);
    const float* ksum = (const float*)(WSP() + WS_MISC2 + M2_KSUM);
    LAS float* kml = (LAS float*)(F.lds);
    LAS float* gl = (LAS float*)(F.lds + 4096);
    for (int base = F.vcu * 512; base < M * NH; base += F.G * 512) {
        const int idx = base + F.tid;
        const int t = idx % T, h = (idx / T) % NH, b = idx / (T * NH), m = b * T + t, own = t >> 8;
        __syncthreads();
        for (int i = F.tid; i < 16 * 64; i += 512) { const float* km = ksum + ((((size_t)b * NH + h) * 16 + (i >> 6)) * 4) * 64 + (i & 63); kml[i] = (km[0] + km[64]) + (km[128] + km[192]); }
        __syncthreads();
        unsigned qw[32]; float acc[64];
        const bf16* qp = proj + (size_t)m * PT + PC_Q + h * 64;
#pragma unroll
        for (int d8 = 0; d8 < 8; ++d8) { const v4u w = *(const v4u*)(qp + 8 * d8); qw[4 * d8] = w.x; qw[4 * d8 + 1] = w.y; qw[4 * d8 + 2] = w.z; qw[4 * d8 + 3] = w.w;
#pragma unroll
            for (int j = 0; j < 8; ++j) acc[8 * d8 + j] = 0.f; }
#define QF(d) (((d) & 1) ? bfhi(qw[(d) >> 1]) : bflo(qw[(d) >> 1]))
        int mask = 0;
        if (own <= 3) mask = (1 << own) - 1;
        else {
            for (int n = 0; n < own; ++n) { float s = 0.f;
#pragma unroll
                for (int d = 0; d < 64; ++d) s = fmaf(QF(d), kml[n * 64 + d], s);
                gl[F.tid * 17 + n] = s; }
            for (int r = 0; r < 3; ++r) {
                float best = -INFINITY; int bi = -1;
                for (int n = 0; n < own; ++n) { const float g = gl[F.tid * 17 + n]; if (!((mask >> n) & 1) && (bi < 0 || g > best)) { best = g; bi = n; } }
                mask |= (1 << bi);
            }
        }
        float mx = -INFINITY, lsum = 0.f;
        for (int n = 0; n <= own; ++n) {
            const bool isown = (n == own);
            if (!isown && !((mask >> n) & 1)) continue;
            const int kend = isown ? (t & 255) : 255;
            const bf16* kb = proj + ((size_t)(b * T + n * 256)) * PT + PC_K + h * 64;
            for (int kk = 0; kk <= kend; ++kk) {
                const bf16* kr = kb + (size_t)kk * PT; const bf16* vr = kr + (PC_V - PC_K);
                float s = 0.f;
#pragma unroll
                for (int d8 = 0; d8 < 8; ++d8) { float f[8]; unpack8(*(const v4u*)(kr + 8 * d8), f);
#pragma unroll
                    for (int j = 0; j < 8; ++j) s = fmaf(QF(8 * d8 + j), f[j], s); }
                if (s > mx) { const float f = exp2f(mx - s); lsum *= f;
#pragma unroll
                    for (int d = 0; d < 64; ++d) acc[d] *= f;
                    mx = s; }
                const float p = exp2f(s - mx); lsum += p;
#pragma unroll
                for (int d8 = 0; d8 < 8; ++d8) { float f[8]; unpack8(*(const v4u*)(vr + 8 * d8), f);
#pragma unroll
                    for (int j = 0; j < 8; ++j) acc[8 * d8 + j] = fmaf(p, f[j], acc[8 * d8 + j]); }
            }
        }
        const float il = 1.f / lsum;
        bf16* op = ocat + (size_t)m * 1536 + 512 + h * 64;
#pragma unroll
        for (int d8 = 0; d8 < 8; ++d8) { float f[8];
#pragma unroll
            for (int j = 0; j < 8; ++j) f[j] = acc[8 * d8 + j] * il;
            *(v4u*)(op + 8 * d8) = pack8(f); }
#undef QF
    }
}
__device__ __forceinline__ void m2b_scan_naive(LAS unsigned char* lds_, const int wave_s, int l, const bf16* proj, const bf16* rwx, bf16* ysc) {
    const Frame F = make_frame(lds_, wave_s);
    const int NGW = F.G * NWAVES, lane = F.lane;
    const float* mu = INP(I_MU) + l * SHIFT;
    for (int gw = F.vcu * NWAVES + F.wave; gw < NB * NH * 64; gw += NGW) {
        const int i = gw & 63, h = (gw >> 6) & 7, b = gw >> 9, c = h * 64 + lane;
        const float mur = mu[c], muv = mu[1024 + h * 64 + i];
        float S = 0.f, rprev = 0.f, vprev = 0.f;
        for (int t = 0; t < T; ++t) {
            const size_t row = (size_t)b * T + t;
            const float rraw = bf1(proj[row * PT + PC_R + c]), vraw = bf1(proj[row * PT + PC_RV + h * 64 + i]);
            const float r = rraw + (rprev - rraw) * mur, vi = vraw + (vprev - vraw) * muv;
            rprev = rraw; vprev = vraw;
            const bf16* x = rwx + row * 2048 + c;
            const float k2 = bf1(x[0]), kk = bf1(x[512]), lw = bf1(x[1024]), bb = bf1(x[1536]);
            const float sa = -wave_sum(S * kk);
            S = S * expf(lw) + sa * bb + vi * k2;
            const float y = wave_sum(S * r);
            if (lane == 0) ysc[row * BR + h * 64 + i] = (bf16)f2bf(y);
        }
    }
}
__device__ __forceinline__ void m2c_rwkv_post(LAS unsigned char* lds_, const int wave_s, int l, const bf16* proj, const bf16* rwx, const bf16* ysc, bf16* ocat) {
    const Frame F = make_frame(lds_, wave_s);
    const int gw = F.vcu * NWAVES + F.wave, NGW = F.G * NWAVES, c0 = 8 * F.lane;
    const float* mu = INP(I_MU) + l * SHIFT;
    float mur[8], muv[8], rk[8], gg[8], gb[8];
#pragma unroll
    for (int j = 0; j < 8; ++j) { mur[j] = mu[c0 + j]; muv[j] = mu[1024 + c0 + j]; rk[j] = INP(I_RK)[l * BR + c0 + j]; gg[j] = INP(I_GNG)[l * BR + c0 + j]; gb[j] = INP(I_GNB)[l * BR + c0 + j]; }
    for (int m = gw; m < M; m += NGW) {
        const int t = m % T;
        float y[8], rc[8], rp[8], vc[8], vp[8], k2[8], g[8];
        unpack8(*(const v4u*)(ysc + (size_t)m * BR + c0), y);
        unpack8(*(const v4u*)(proj + (size_t)m * PT + PC_R + c0), rc); unpack8(*(const v4u*)(proj + (size_t)m * PT + PC_RV + c0), vc);
        if (t >= 1) { unpack8(*(const v4u*)(proj + (size_t)(m - 1) * PT + PC_R + c0), rp); unpack8(*(const v4u*)(proj + (size_t)(m - 1) * PT + PC_RV + c0), vp); }
        else {
#pragma unroll
            for (int j = 0; j < 8; ++j) { rp[j] = 0.f; vp[j] = 0.f; } }
        unpack8(*(const v4u*)(rwx + (size_t)m * 2048 + c0), k2);
        unpack8(*(const v4u*)(ocat + (size_t)m * 1536 + 1024 + c0), g);
        float s = 0.f;
#pragma unroll
        for (int j = 0; j < 8; ++j) s += y[j];
        const float mean = sum8lanes(s) * (1.f / 64.f);
        float q = 0.f, bn = 0.f;
#pragma unroll
        for (int j = 0; j < 8; ++j) { y[j] -= mean; q += y[j] * y[j]; const float r = rc[j] + (rp[j] - rc[j]) * mur[j]; bn += r * k2[j] * rk[j]; }
        const float rstd = rsqrtf(sum8lanes(q) * (1.f / 64.f) + GN_EPS);
        bn = sum8lanes(bn);
        float o[8];
#pragma unroll
        for (int j = 0; j < 8; ++j) { const float v = vc[j] + (vp[j] - vc[j]) * muv[j]; o[j] = (y[j] * rstd * gg[j] + gb[j] + bn * v) * g[j]; }
        *(v4u*)(ocat + (size_t)m * 1536 + 1024 + c0) = pack8(o);
    }
}

template <bool ROUTE, bool WRITE_XB>
__device__ __forceinline__ void ln_pass(LAS unsigned char* lds_, const int wave_s, const float* g, const float* bta, float* xio, bf16* xb, const float* rw, int* cnt, int* asg_e, int* asg_rank, float* asg_gate) {
    const Frame F = make_frame(lds_, wave_s);
    const int gw = F.vcu * NWAVES + F.wave, NGW = F.G * NWAVES, lane = F.lane;
    for (int m = gw; m < M; m += NGW) {
        GAS f32x4* xr = (GAS f32x4*)(xio + (size_t)m * D) + lane;
        f32x4 v[4]; float s = 0.f;
#pragma unroll
        for (int j = 0; j < 4; ++j) { v[j] = xr[64 * j]; s += (v[j].x + v[j].y) + (v[j].z + v[j].w); }
        const float mean = wave_sum(s) * (1.f / D); float s2 = 0.f;
#pragma unroll
        for (int j = 0; j < 4; ++j) { v[j] = v[j] - mean; s2 += (v[j].x * v[j].x + v[j].y * v[j].y) + (v[j].z * v[j].z + v[j].w * v[j].w); }
        const float rstd = 1.f / sqrtf(wave_sum(s2) * (1.f / D) + LN_EPS);
#pragma unroll
        for (int j = 0; j < 4; ++j) { const f32x4 gv = *(const f32x4*)(g + 4 * lane + 256 * j), bv = *(const f32x4*)(bta + 4 * lane + 256 * j); v[j] = v[j] * rstd * gv + bv; xr[64 * j] = v[j]; }
        if (WRITE_XB) { GAS unsigned long long* o8 = (GAS unsigned long long*)(xb + (size_t)m * D) + lane;
#pragma unroll
            for (int j = 0; j < 4; ++j) o8[64 * j] = (unsigned long long)pk2(v[j].x, v[j].y) | ((unsigned long long)pk2(v[j].z, v[j].w) << 32); }
        if (ROUTE) {
            float lg[8];
#pragma unroll
            for (int e = 0; e < 8; ++e) lg[e] = 0.f;
#pragma unroll
            for (int j = 0; j < 4; ++j)
#pragma unroll
                for (int i = 0; i < 4; ++i) { const int d = 4 * lane + 256 * j + i; const f32x4 r0 = *(const f32x4*)(rw + d * NE), r1 = *(const f32x4*)(rw + d * NE + 4); const float xv = v[j][i];
#pragma unroll
                    for (int e = 0; e < 4; ++e) { lg[e] = fmaf(xv, r0[e], lg[e]); lg[4 + e] = fmaf(xv, r1[e], lg[4 + e]); } }
#pragma unroll
            for (int e = 0; e < 8; ++e) lg[e] = wave_sum(lg[e]);
            if (lane == 0) {
                int e1 = 0; float l1 = lg[0];
#pragma unroll
                for (int e = 1; e < 8; ++e) if (lg[e] > l1) { l1 = lg[e]; e1 = e; }
                int e2 = -1; float l2 = -INFINITY;
#pragma unroll
                for (int e = 0; e < 8; ++e) if (e != e1 && (e2 < 0 || lg[e] > l2)) { l2 = lg[e]; e2 = e; }
                const float p2 = expf(l2 - l1); const float g1 = 1.f / (1.f + p2), g2 = p2 / (1.f + p2);
                asg_e[2 * m] = e1; asg_e[2 * m + 1] = e2; asg_gate[2 * m] = g1; asg_gate[2 * m + 1] = g2;
                asg_rank[2 * m] = atomicAdd(&cnt[e1], 1); asg_rank[2 * m + 1] = atomicAdd(&cnt[e2], 1);
            }
        }
    }
}

__device__ __forceinline__ void moe_scatter(LAS unsigned char* lds_, const int wave_s, const int* cnt, const int* asg_e, const int* asg_rank, int* asg_pos, const bf16* xb, bf16* xs, int* tile_e) {
    const Frame F = make_frame(lds_, wave_s);
    const int gw = F.vcu * NWAVES + F.wave, NGW = F.G * NWAVES, lane = F.lane;
    int pstart[NE + 1]; int c[NE];
    { int s = 0;
#pragma unroll
      for (int e = 0; e < NE; ++e) { c[e] = cnt[e]; pstart[e] = s; s += ((c[e] + 255) >> 8) << 8; }
      pstart[NE] = s; }
    if (F.vcu == 0 && F.tid == 0) {
        const int ntiles = pstart[NE] >> 8;
        for (int ti = 0; ti < ntiles; ++ti) { int e = 0;
#pragma unroll
            for (int q = 1; q < NE; ++q) if ((ti << 8) >= pstart[q]) e = q;
            tile_e[ti] = e; }
        tile_e[MOE_MAXT] = ntiles;
    }
    for (int a = gw; a < 2 * M; a += NGW) {
        const int e = asg_e[a]; int ps = 0;
#pragma unroll
        for (int q = 0; q < NE; ++q) if (q == e) ps = pstart[q];
        const int pos = ps + asg_rank[a];
        if (lane == 0) asg_pos[a] = pos;
        const v4u* src = (const v4u*)(xb + (size_t)(a >> 1) * D); v4u* dst = (v4u*)(xs + (size_t)pos * D);
        dst[lane] = src[lane]; dst[64 + lane] = src[64 + lane];
    }
#pragma unroll
    for (int e = 0; e < NE; ++e) {
        const int p0 = pstart[e] + c[e], p1 = pstart[e + 1];
        for (int p = p0 + gw; p < p1; p += NGW) { v4u* dst = (v4u*)(xs + (size_t)p * D); const v4u z = {0u, 0u, 0u, 0u}; dst[lane] = z; dst[64 + lane] = z; }
    }
}
__device__ __forceinline__ void moe_final_ln(LAS unsigned char* lds_, const int wave_s, const float* g, const float* bta, float* xio, const bf16* ybuf, const int* asg_pos, const float* asg_gate) {
    const Frame F = make_frame(lds_, wave_s);
    const int gw = F.vcu * NWAVES + F.wave, NGW = F.G * NWAVES, lane = F.lane;
    for (int m = gw; m < M; m += NGW) {
        GAS f32x4* xr = (GAS f32x4*)(xio + (size_t)m * D) + lane;
        const int p0 = asg_pos[2 * m], p1 = asg_pos[2 * m + 1]; const float g0 = asg_gate[2 * m], g1 = asg_gate[2 * m + 1];
        const v2u* y0 = (const v2u*)(ybuf + (size_t)p0 * D) + lane; const v2u* y1 = (const v2u*)(ybuf + (size_t)p1 * D) + lane;
        f32x4 v[4]; float s = 0.f;
#pragma unroll
        for (int j = 0; j < 4; ++j) { const v2u a = y0[64 * j], b = y1[64 * j]; const f32x4 x = xr[64 * j];
            v[j].x = ALPHA * x.x + g0 * bflo(a.x) + g1 * bflo(b.x); v[j].y = ALPHA * x.y + g0 * bfhi(a.x) + g1 * bfhi(b.x);
            v[j].z = ALPHA * x.z + g0 * bflo(a.y) + g1 * bflo(b.y); v[j].w = ALPHA * x.w + g0 * bfhi(a.y) + g1 * bfhi(b.y);
            s += (v[j].x + v[j].y) + (v[j].z + v[j].w); }
        const float mean = wave_sum(s) * (1.f / D); float s2 = 0.f;
#pragma unroll
        for (int j = 0; j < 4; ++j) { v[j] = v[j] - mean; s2 += (v[j].x * v[j].x + v[j].y * v[j].y) + (v[j].z * v[j].z + v[j].w * v[j].w); }
        const float rstd = 1.f / sqrtf(wave_sum(s2) * (1.f / D) + LN_EPS);
#pragma unroll
        for (int j = 0; j < 4; ++j) { const f32x4 gv = *(const f32x4*)(g + 4 * lane + 256 * j), bv = *(const f32x4*)(bta + 4 * lane + 256 * j); xr[64 * j] = v[j] * rstd * gv + bv; }
    }
}

struct Args { const float* in[27]; float* out; unsigned char* ws; };
__global__ void __launch_bounds__(NWAVES * 64, 2) mega_fwd(Args args) {
    extern __shared__ __attribute__((aligned(16))) unsigned char lds[];
    LAS unsigned char* const L = (LAS unsigned char*)lds;
    const int wave_s = __builtin_amdgcn_readfirstlane((int)threadIdx.x >> 6);
    for (int u = wave_s * 64 + lane_id(); u < (LDS_BYTES - LDSCTL_OFF) / 4; u += NWAVES * 64) ((LAS unsigned*)(L + LDSCTL_OFF))[u] = 0u;
    __syncthreads();
    (void)xcd_barrier_post((unsigned*)(WSP() + WS_CTL) + CW_BAR, (volatile LAS unsigned*)(L + MISC_OFF) + 8, wave_s == 0 && lane_id() == 0);
#define GRID_BAR() do { XcdBarrier b_; b_.bar = (unsigned*)(WSP() + WS_CTL) + CW_BAR; b_.x = xb_xcc_id(); b_.st = (volatile LAS unsigned*)(L + MISC_OFF) + 8; xcd_barrier(b_, wave_s == 0 && lane_id() == 0); } while (0)
#define GRIDSZ() ((int)gridDim.x)
#define XB ((bf16*)(WSP() + WS_XB))
#define MERGED ((bf16*)(WSP() + WS_MERGED))
#define RWX ((bf16*)(WSP() + WS_RWX))
#define Wb ((bf16*)(WSP() + WS_W))
#define PROJ ((bf16*)(WSP() + WS_PROJ))
#define OCAT ((bf16*)(WSP() + WS_OCAT))
#define YSC ((bf16*)(WSP() + WS_YSC))
#define HBUF ((bf16*)(WSP() + WS_HBUF))
#define MOEW ((bf16*)(WSP() + WS_MOEW))
#define HMOE ((bf16*)(WSP() + WS_HMOE))
#define XS ((bf16*)(WSP() + WS_XS))
#define YBUF ((bf16*)(WSP() + WS_YBUF))
#define CNT ((int*)(WSP() + WS_CTL) + CW_CNT)
#define ASG_E ((int*)(WSP() + WS_MISC + M1_ASG))
#define ASG_RANK (ASG_E + 2 * M)
#define ASG_GATE ((float*)(ASG_E + 4 * M))
#define ASG_POS (ASG_E + 6 * M)
#define TILE_E ((int*)(WSP() + WS_MISC + M1_TILE))
#define out OUTP()

#ifndef NO_P0
    p0_prologue(L, wave_s);
#endif
    GRID_BAR();
#pragma unroll 1
    for (int l = 0; l < 2; ++l) {
#ifndef NO_G1
        { pg8::Gemm g{XB, Wb + WO_IN + (size_t)l * W_IN_SZ, M, PT, D}; pg8::StaticOrder S; { int bx_ = blockIdx.x, G_ = gridDim.x; asm volatile("" : "+s"(bx_), "+s"(G_)); S.init(M, PT, G_, bx_); }
          pg8::EpiStoreBf16 E{PROJ, PT};
          pg8::gemm_phase<pg8::EpiStoreBf16, pg8::StaticOrder, true, true>(L + RING_OFF, g, S, E, wave_s); }
#endif
        GRID_BAR();
#ifndef NO_ROPE
        m2a_rope(L, wave_s, PROJ);
#endif
#ifndef NO_CONV
        m2a_conv(L, wave_s, PROJ, INP(I_CONVW) + l * 3 * BR, OCAT);
#endif
#ifndef NO_PREP
        m2a_rwkv_prep(L, wave_s, l, PROJ, RWX, OCAT);
#endif
        GRID_BAR();
#ifndef NO_ATTN
        m2b_attn_naive(L, wave_s, PROJ, OCAT);
#endif
#ifndef NO_SCAN
        m2b_scan_naive(L, wave_s, l, PROJ, RWX, YSC);
#endif
        GRID_BAR();
#ifndef NO_POST
        m2c_rwkv_post(L, wave_s, l, PROJ, RWX, YSC, OCAT);
#endif
        GRID_BAR();
#ifndef NO_G2
        { pg8::Gemm g{OCAT, Wb + WO_BR + (size_t)l * W_BR_SZ, M, D, 1536}; pg8::StaticOrder S; { int bx_ = blockIdx.x, G_ = gridDim.x; asm volatile("" : "+s"(bx_), "+s"(G_)); S.init(M, D, G_, bx_); }
          pg8::EpiMerge E{MERGED, D, PROJ + PC_GATE, PT};
          pg8::gemm_phase<pg8::EpiMerge, pg8::StaticOrder, true, true>(L + RING_OFF, g, S, E, wave_s); }
#endif
        GRID_BAR();
#ifndef NO_G3
        { pg8::Gemm g{MERGED, Wb + WO_O + (size_t)l * W_O_SZ, M, D, D}; pg8::StaticOrder S; { int bx_ = blockIdx.x, G_ = gridDim.x; asm volatile("" : "+s"(bx_), "+s"(G_)); S.init(M, D, G_, bx_); }
          pg8::EpiResF32 E{l == 0 ? INP(I_X) : out, out, D, ALPHA};
          pg8::gemm_phase<pg8::EpiResF32, pg8::StaticOrder, true, true>(L + RING_OFF, g, S, E, wave_s); }
#endif
#ifndef NO_MOEW
        if (l == 1) moe_weight_prologue(L, wave_s);
#endif
        GRID_BAR();
        if (l == 0) {
            ln_pass<false, true>(L, wave_s, INP(I_LN1G), INP(I_LN1B), out, XB, nullptr, nullptr, nullptr, nullptr, nullptr);
            GRID_BAR();
#ifndef NO_G4
            { pg8::Gemm g{XB, Wb + WO_GU, M, 2 * DFF, D}; pg8::StaticOrder S; { int bx_ = blockIdx.x, G_ = gridDim.x; asm volatile("" : "+s"(bx_), "+s"(G_)); S.init(M, 2 * DFF, G_, bx_); }
              pg8::EpiSwiGLU E{HBUF, DFF};
              pg8::gemm_phase<pg8::EpiSwiGLU, pg8::StaticOrder, true, true>(L + RING_OFF, g, S, E, wave_s); }
#endif
            GRID_BAR();
#ifndef NO_G5
            { pg8::Gemm g{HBUF, Wb + WO_D, M, D, DFF}; pg8::StaticOrder S; { int bx_ = blockIdx.x, G_ = gridDim.x; asm volatile("" : "+s"(bx_), "+s"(G_)); S.init(M, D, G_, bx_); }
              pg8::EpiResF32 E{out, out, D, ALPHA};
              pg8::gemm_phase<pg8::EpiResF32, pg8::StaticOrder, true, true>(L + RING_OFF, g, S, E, wave_s); }
#endif
            GRID_BAR();
            ln_pass<false, true>(L, wave_s, INP(I_LN2G), INP(I_LN2B), out, XB, nullptr, nullptr, nullptr, nullptr, nullptr);
            GRID_BAR();
        } else {
            ln_pass<true, true>(L, wave_s, INP(I_LN1G) + D, INP(I_LN1B) + D, out, XB, INP(I_RW), CNT, ASG_E, ASG_RANK, ASG_GATE);
            GRID_BAR();
#ifndef NO_SCAT
            moe_scatter(L, wave_s, CNT, ASG_E, ASG_RANK, ASG_POS, XB, XS, TILE_E);
#endif
            GRID_BAR();
            const int ntiles = __builtin_amdgcn_readfirstlane(TILE_E[MOE_MAXT]);
#ifndef NO_G6
            { pg8::Gemm g{XS, MOEW, ntiles * 256, 2 * DFF, D}; pg8::MoeOrder S; { int bx_ = blockIdx.x, G_ = gridDim.x; asm volatile("" : "+s"(bx_), "+s"(G_)); S.init(ntiles * 256, 2 * DFF, G_, bx_); } S.tile_e = TILE_E; S.estride = MOE_E_SZ * 2;
              pg8::EpiSwiGLU E{HMOE, DFF};
              pg8::gemm_phase<pg8::EpiSwiGLU, pg8::MoeOrder, true, true>(L + RING_OFF, g, S, E, wave_s); }
#endif
            GRID_BAR();
#ifndef NO_G7
            { pg8::Gemm g{HMOE, MOEW + W_GU_SZ, ntiles * 256, D, DFF}; pg8::MoeOrder S; { int bx_ = blockIdx.x, G_ = gridDim.x; asm volatile("" : "+s"(bx_), "+s"(G_)); S.init(ntiles * 256, D, G_, bx_); } S.tile_e = TILE_E; S.estride = MOE_E_SZ * 2;
              pg8::EpiStoreBf16 E{YBUF, D};
              pg8::gemm_phase<pg8::EpiStoreBf16, pg8::MoeOrder, true, true>(L + RING_OFF, g, S, E, wave_s); }
#endif
            GRID_BAR();
            moe_final_ln(L, wave_s, INP(I_LN2G) + D, INP(I_LN2B) + D, out, YBUF, ASG_POS, ASG_GATE);
        }
    }
    if (xb_ld((unsigned*)(WSP() + WS_CTL) + CW_BAR + XB_TMO) != 0u) {
        __syncthreads();
        const float q = __builtin_nanf("");
        for (size_t i = (size_t)blockIdx.x * 512 + wave_s * 64 + lane_id(); i < (size_t)M * D; i += (size_t)GRIDSZ() * 512) out[i] = q;
    }
#undef GRID_BAR
#undef out
}

extern "C" void kernel_launch(void* const* d_in, const int* in_sizes, int n_in, void* d_out, int out_size, void* d_ws, size_t ws_size, hipStream_t stream) {
    static int grid = 0;
    if (grid == 0) {
        int dev = 0, cus = 0;
        if (n_in != 27 || out_size != M * D || ws_size < WS_END) { fprintf(stderr, "kernel_launch: unexpected problem geometry (n_in %d out %d ws %zu)\n", n_in, out_size, ws_size); grid = -1; return; }
        if (hipGetDevice(&dev) != hipSuccess || hipDeviceGetAttribute(&cus, hipDeviceAttributeMultiprocessorCount, dev) != hipSuccess) { grid = -1; return; }
        if (hipFuncSetAttribute((const void*)mega_fwd, hipFuncAttributeMaxDynamicSharedMemorySize, LDS_BYTES) != hipSuccess) { grid = -1; return; }
        grid = cus;
    }
    if (grid < 0) return;
    if (hipMemsetAsync((char*)d_ws + WS_CTL, 0, CTL_ZERO_BYTES, stream) != hipSuccess) return;
    Args a{};
    for (int i = 0; i < 27; ++i) a.in[i] = (const float*)d_in[i];
    a.out = (float*)d_out; a.ws = (unsigned char*)d_ws;
    hipLaunchKernelGGL(mega_fwd, dim3(grid), dim3(NWAVES * 64), LDS_BYTES, stream, a);
}
```

```cpp
#include <hip/hip_runtime.h>
#include <cstdio>
#include <cstdint>
#include <cmath>
namespace pg8 {
#define PG8_LAS __attribute__((address_space(3)))
typedef unsigned short bf16_t;
typedef short bf16x8 __attribute__((ext_vector_type(8)));
typedef float f32x4 __attribute__((ext_vector_type(4)));
typedef unsigned u32x4 __attribute__((ext_vector_type(4)));
constexpr int BM = 256, BK = 64, HALF = 128, HTB = HALF * BK * 2  , STAGE_BYTES = 8 * HTB, NXCD = 8, WGM = 8;

__host__ __device__ __forceinline__ int lds_byte(int r, int c) { const int st = (r >> 4) * 2 + (c >> 5), rr = r & 15, cc = c & 31, ob = rr * 64 + cc * 2; return st * 1024 + (ob ^ (((ob >> 9) & 1) << 5)); }
__host__ __device__ __forceinline__ void stage_rc(int b, int& R, int& C) { const int st = b / 1024, sb = b % 1024, swz = sb ^ (((sb >> 9) & 1) << 5); R = (st >> 1) * 16 + swz / 64; C = (st & 1) * 32 + (swz % 64) / 2; }
__host__ __device__ __forceinline__ int perm32(int rho) { const int n = rho >> 4, i = rho & 15; return 8 * (i >> 2) + 4 * n + (i & 3); }

struct Unit { int pm, pn; };
struct Gemm { const bf16_t* A; const bf16_t* Bt; int M, N, K; };

struct StaticOrder {
    int nM, nN, nwg, G, c;
    __host__ __device__ void init(int M, int N, int G_, int c_) { nM = M / BM; nN = N / BM; nwg = nM * nN; G = G_; c = c_; }
    __host__ __device__ bool next(int i, Unit& u) const {
        const long L = (long)i * G + c; if (L >= nwg) return false;
        int wgid = (int)L; { const int q = nwg / NXCD, r = nwg % NXCD, xcd = wgid % NXCD, off = wgid / NXCD; wgid = (xcd < r ? xcd * (q + 1) : r * (q + 1) + (xcd - r) * q) + off; }
        const int nig = WGM * nN, gid = wgid / nig, fm = gid * WGM, gsz = (nM - fm) < WGM ? (nM - fm) : WGM;
        u.pm = fm + ((wgid % nig) % gsz); u.pn = (wgid % nig) / gsz; return true;
    }
    __device__ __forceinline__ void a_ready(const Unit&) const {}
    __device__ __forceinline__ void done(const Unit&) const {}
    __device__ __forceinline__ size_t boff(const Unit&) const { return 0; }
};

__device__ __forceinline__ unsigned cvt_pk_bf16(float lo, float hi) { unsigned r; asm volatile("v_cvt_pk_bf16_f32 %0, %1, %2" : "=v"(r) : "v"(lo), "v"(hi)); return r; }
__device__ __forceinline__ float bf_lo(unsigned w) { return __uint_as_float(w << 16); }
__device__ __forceinline__ float bf_hi(unsigned w) { return __uint_as_float(w & 0xffff0000u); }
__device__ __forceinline__ float fast_exp(float x) { return __builtin_amdgcn_exp2f(x * 1.4426950408889634f); }
__device__ __forceinline__ float fast_sigmoid(float x) { return __builtin_amdgcn_rcpf(1.0f + fast_exp(-x)); }

struct EpiStoreBf16 {
    static constexpr bool PERM = true, AFTER_DRAIN = false, KHOOK = false;
    bf16_t* O; int ldc;
    __device__ __forceinline__ void khook(f32x4 (&)[2][2][4][2], const Unit&, int, int, int, int, int) const {}
    __device__ __forceinline__ void operator()(const f32x4 (&acc)[2][2][4][2], const Unit& u, int wr, int wc, int fr, int fq) const {
        const int row0 = u.pm * BM + wr * 64 + fr, col0 = u.pn * BM + wc * 32 + 8 * fq;
#pragma unroll
        for (int ai = 0; ai < 2; ++ai)
#pragma unroll
            for (int m = 0; m < 4; ++m) { bf16_t* rowp = O + (size_t)(row0 + ai * HALF + m * 16) * ldc + col0;
#pragma unroll
                for (int bj = 0; bj < 2; ++bj) { const f32x4 v0 = acc[ai][bj][m][0], v1 = acc[ai][bj][m][1];
                    u32x4 w; w.x = cvt_pk_bf16(v0[0], v0[1]); w.y = cvt_pk_bf16(v0[2], v0[3]); w.z = cvt_pk_bf16(v1[0], v1[1]); w.w = cvt_pk_bf16(v1[2], v1[3]);
                    *(u32x4*)(rowp + bj * HALF) = w; } }
    }
};

struct EpiMerge {
    static constexpr bool PERM = true, AFTER_DRAIN = false, KHOOK = true;
    bf16_t* O; int ldc; const bf16_t* gates; int ldg;
    __device__ __forceinline__ void khook(f32x4 (&acc)[2][2][4][2], const Unit& u, int t, int wr, int wc, int fr, int fq) const {
        const int b = (t >> 3) - 1;
        int fr_ = fr, fq_ = fq; asm volatile("" : "+v"(fr_), "+v"(fq_));
        const int row0 = u.pm * BM + wr * 64 + fr_, col0 = u.pn * BM + wc * 32 + 8 * fq_;
#pragma unroll
        for (int ai = 0; ai < 2; ++ai)
#pragma unroll
            for (int m = 0; m < 4; ++m) { const bf16_t* gp = gates + (size_t)(row0 + ai * HALF + m * 16) * ldg + b * 1024 + col0;
#pragma unroll
                for (int bj = 0; bj < 2; ++bj) { const u32x4 ga = *(const u32x4*)(gp + bj * HALF), gb = *(const u32x4*)(gp + bj * HALF + 1024);
                    const unsigned aw[4] = {ga.x, ga.y, ga.z, ga.w}, bw[4] = {gb.x, gb.y, gb.z, gb.w};
#pragma unroll
                    for (int q = 0; q < 4; ++q) {
                        const float r0 = (1.0f + fast_exp(-bf_lo(bw[q]))) * __builtin_amdgcn_rcpf(1.0f + fast_exp(-bf_lo(aw[q])));
                        const float r1 = (1.0f + fast_exp(-bf_hi(bw[q]))) * __builtin_amdgcn_rcpf(1.0f + fast_exp(-bf_hi(aw[q])));
                        acc[ai][bj][m][q >> 1][(q & 1) * 2 + 0] *= r0; acc[ai][bj][m][q >> 1][(q & 1) * 2 + 1] *= r1; }
                    asm volatile("" ::: "memory"); } }
    }
    __device__ __forceinline__ void operator()(const f32x4 (&acc)[2][2][4][2], const Unit& u, int wr, int wc, int fr, int fq) const {
        const int row0 = u.pm * BM + wr * 64 + fr, col0 = u.pn * BM + wc * 32 + 8 * fq;
#pragma unroll
        for (int ai = 0; ai < 2; ++ai)
#pragma unroll
            for (int m = 0; m < 4; ++m) { const size_t r = (size_t)(row0 + ai * HALF + m * 16); const bf16_t* gp = gates + r * ldg + 2 * 1024 + col0; bf16_t* rowp = O + r * ldc + col0;
#pragma unroll
                for (int bj = 0; bj < 2; ++bj) { const u32x4 gc = *(const u32x4*)(gp + bj * HALF); const f32x4 v0 = acc[ai][bj][m][0], v1 = acc[ai][bj][m][1];
                    u32x4 w;
                    w.x = cvt_pk_bf16(v0[0] * fast_sigmoid(bf_lo(gc.x)), v0[1] * fast_sigmoid(bf_hi(gc.x)));
                    w.y = cvt_pk_bf16(v0[2] * fast_sigmoid(bf_lo(gc.y)), v0[3] * fast_sigmoid(bf_hi(gc.y)));
                    w.z = cvt_pk_bf16(v1[0] * fast_sigmoid(bf_lo(gc.z)), v1[1] * fast_sigmoid(bf_hi(gc.z)));
                    w.w = cvt_pk_bf16(v1[2] * fast_sigmoid(bf_lo(gc.w)), v1[3] * fast_sigmoid(bf_hi(gc.w)));
                    *(u32x4*)(rowp + bj * HALF) = w; asm volatile("" ::: "memory"); } }
    }
};

struct EpiSwiGLU {
    static constexpr bool PERM = true, AFTER_DRAIN = false, KHOOK = false;
    bf16_t* O; int ldc;
    __device__ __forceinline__ void khook(f32x4 (&)[2][2][4][2], const Unit&, int, int, int, int, int) const {}
    __device__ __forceinline__ void operator()(const f32x4 (&acc)[2][2][4][2], const Unit& u, int wr, int wc, int fr, int fq) const {
        const int row0 = u.pm * BM + wr * 64 + fr, col0 = u.pn * HALF + wc * 32 + 8 * fq;
#pragma unroll
        for (int ai = 0; ai < 2; ++ai)
#pragma unroll
            for (int m = 0; m < 4; ++m) { bf16_t* rowp = O + (size_t)(row0 + ai * HALF + m * 16) * ldc + col0;
                float h[8];
#pragma unroll
                for (int n = 0; n < 2; ++n)
#pragma unroll
                    for (int i = 0; i < 4; ++i) { const float g = acc[ai][0][m][n][i], up = acc[ai][1][m][n][i]; h[n * 4 + i] = g * fast_sigmoid(g) * up; }
                u32x4 w; w.x = cvt_pk_bf16(h[0], h[1]); w.y = cvt_pk_bf16(h[2], h[3]); w.z = cvt_pk_bf16(h[4], h[5]); w.w = cvt_pk_bf16(h[6], h[7]);
                *(u32x4*)rowp = w; }
    }
};

struct EpiResF32 {
    static constexpr bool PERM = false, AFTER_DRAIN = false, KHOOK = false;
    const float* base; float* out; int ldc; float alpha;
    __device__ __forceinline__ void khook(f32x4 (&)[2][2][4][2], const Unit&, int, int, int, int, int) const {}
    __device__ __forceinline__ void operator()(const f32x4 (&acc)[2][2][4][2], const Unit& u, int wr, int wc, int fr, int fq) const {
        const int row0 = u.pm * BM + wr * 64 + fr, col0 = u.pn * BM + wc * 32 + 4 * fq;
#pragma unroll
        for (int ai = 0; ai < 2; ++ai)
#pragma unroll
            for (int m = 0; m < 4; ++m) { const size_t off = (size_t)(row0 + ai * HALF + m * 16) * ldc + col0;
#pragma unroll
                for (int bj = 0; bj < 2; ++bj)
#pragma unroll
                    for (int n = 0; n < 2; ++n) { const f32x4 bs = *(const f32x4*)(base + off + bj * HALF + n * 16); *(f32x4*)(out + off + bj * HALF + n * 16) = bs * alpha + acc[ai][bj][m][n]; } }
    }
};

struct MoeOrder : StaticOrder {
    const int* tile_e; size_t estride;
    __device__ __forceinline__ size_t boff(const Unit& u) const { return (size_t)__builtin_amdgcn_readfirstlane(tile_e[u.pm]) * estride; }
};

template <class Epi, class Sched, bool ALIGN_EPI = false, bool SP2 = false>
__device__ __forceinline__ void gemm_phase(PG8_LAS unsigned char* lds, const Gemm g, const Sched& S, const Epi& E, const int wave_s) {
    int lane_; asm volatile("v_mbcnt_lo_u32_b32 %0, -1, 0\n\tv_mbcnt_hi_u32_b32 %0, -1, %0" : "=v"(lane_));
    const int tid = wave_s * 64 + lane_, wid = wave_s, lane = tid & 63, wr = wid >> 2, wc = wid & 3, fr = lane & 15, fq = lane >> 4;
    const int K = g.K, nt = K / BK;
    unsigned voffA[2], voffB[2];
#pragma unroll
    for (int i = 0; i < 2; ++i) { int R, C; stage_rc(tid * 16 + i * 8192, R, C); const int Rb = Epi::PERM ? ((R & ~31) + perm32(R & 31)) : R;
        voffA[i] = (unsigned)(R * K + C) * 2u; voffB[i] = (unsigned)(Rb * K + C) * 2u; }
    const size_t kstep = (size_t)(BK * 2);
    const size_t hstep = (size_t)HALF * K * 2;
    const size_t tstep = 2 * hstep;
    const unsigned ldsw = (unsigned)wid * 1024u;
    const int aoff = lds_byte(wr * 64 + fr, fq * 8), boff = lds_byte(wc * 32 + fr, fq * 8);
#define PG8_SA(b, h) (((b) * 2 + (h)) * HTB)
#define PG8_SB(b, h) ((4 + (b) * 2 + (h)) * HTB)
#define PG8_STAGE(bufoff, gbase, voff) do { _Pragma("unroll") for (int _i = 0; _i < 2; ++_i) \
        __builtin_amdgcn_global_load_lds((const unsigned*)((const char*)(gbase) + (voff)[_i]), (PG8_LAS unsigned*)(lds + (bufoff) + ldsw + _i * 8192), 16, 0, 0); } while (0)
#define PG8_LDA(dst, b, h) do { _Pragma("unroll") for (int m = 0; m < 4; ++m) _Pragma("unroll") for (int k = 0; k < 2; ++k) dst[m][k] = *(const PG8_LAS bf16x8*)(lds + PG8_SA(b, h) + aoff + m * 2048 + k * 1024); } while (0)
#define PG8_LDB(dst, b, h) do { _Pragma("unroll") for (int n = 0; n < 2; ++n) _Pragma("unroll") for (int k = 0; k < 2; ++k) dst[n][k] = *(const PG8_LAS bf16x8*)(lds + PG8_SB(b, h) + boff + n * 2048 + k * 1024); } while (0)
#define PG8_MMA(ai, bj, At, Bt) do { __builtin_amdgcn_s_setprio(1); _Pragma("unroll") for (int m = 0; m < 4; ++m) _Pragma("unroll") for (int n = 0; n < 2; ++n) _Pragma("unroll") for (int k = 0; k < 2; ++k) \
        acc[ai][bj][m][n] = __builtin_amdgcn_mfma_f32_16x16x32_bf16(Bt[n][k], At[m][k], acc[ai][bj][m][n], 0, 0, 0); __builtin_amdgcn_s_setprio(0); } while (0)
#define PG8_WAIT_V(n) asm volatile("s_waitcnt vmcnt(" #n ")" ::: "memory")
#define PG8_WAIT_L(n) asm volatile("s_waitcnt lgkmcnt(" #n ")" ::: "memory")
#define PG8_BAR __builtin_amdgcn_s_barrier()
#define PG8_SCHED __builtin_amdgcn_sched_barrier(0)
    Unit cur, nxt; int ui = 0;
    if (!S.next(0, cur)) return;
    f32x4 acc[2][2][4][2];
#pragma unroll
    for (int a = 0; a < 2; ++a)
#pragma unroll
        for (int b = 0; b < 2; ++b)
#pragma unroll
            for (int m = 0; m < 4; ++m)
#pragma unroll
                for (int n = 0; n < 2; ++n) acc[a][b][m][n] = (f32x4){0.f, 0.f, 0.f, 0.f};
    bf16x8 At[4][2], B0[2][2], B1[2][2];
    const char* cA = (const char*)g.A + (size_t)cur.pm * tstep; const char* cB = (const char*)g.Bt + (size_t)cur.pn * tstep + S.boff(cur);
    S.a_ready(cur);
    if constexpr (SP2) {
        PG8_STAGE(PG8_SB(0, 0), cB, voffB); PG8_STAGE(PG8_SB(0, 1), cB + hstep, voffB); PG8_STAGE(PG8_SA(0, 0), cA, voffA); PG8_STAGE(PG8_SA(0, 1), cA + hstep, voffA);
        if (wr == 1) PG8_BAR;
        PG8_WAIT_V(2); PG8_BAR;
        PG8_STAGE(PG8_SB(1, 0), cB + kstep, voffB); PG8_STAGE(PG8_SA(1, 0), cA + kstep, voffA); PG8_STAGE(PG8_SB(1, 1), cB + hstep + kstep, voffB);
        PG8_WAIT_V(6); PG8_BAR;
    } else {
        PG8_STAGE(PG8_SB(0, 0), cB, voffB); PG8_STAGE(PG8_SA(0, 0), cA, voffA); PG8_STAGE(PG8_SB(0, 1), cB + hstep, voffB); PG8_STAGE(PG8_SA(0, 1), cA + hstep, voffA);
        if (wr == 1) PG8_BAR;
        PG8_WAIT_V(4); PG8_BAR;
        PG8_STAGE(PG8_SB(1, 0), cB + kstep, voffB); PG8_STAGE(PG8_SA(1, 0), cA + kstep, voffA); PG8_STAGE(PG8_SB(1, 1), cB + hstep + kstep, voffB);
        PG8_WAIT_V(6); PG8_BAR;
    }
    for (;;) {
        const bool has_next = S.next(ui + 1, nxt);
        const char* nA = has_next ? (const char*)g.A + (size_t)nxt.pm * tstep : cA; const char* nB = has_next ? (const char*)g.Bt + (size_t)nxt.pn * tstep + S.boff(nxt) : cB;
        for (int t = 0; t < nt; t += 2) {
            if constexpr (Epi::KHOOK) { if (t == 8 || t == 16) E.khook(acc, cur, t, wr, wc, fr, fq); }
            const bool last = (t == nt - 2);
            const char* a1 = cA + (size_t)(t + 1) * kstep;
            const char* a2 = last ? nA : cA + (size_t)(t + 2) * kstep; const char* b2 = last ? nB : cB + (size_t)(t + 2) * kstep;
            const char* a3 = a2 + kstep; const char* b3 = b2 + kstep;
            if (last && has_next) S.a_ready(nxt);
            if constexpr (SP2) {
            PG8_LDB(B0, 0, 0); PG8_LDB(B1, 0, 1); PG8_SCHED; PG8_LDA(At, 0, 0); PG8_STAGE(PG8_SA(1, 1), a1 + hstep, voffA);
            PG8_WAIT_V(8); PG8_WAIT_L(0); PG8_BAR; PG8_MMA(0, 0, At, B0); PG8_MMA(0, 1, At, B1); PG8_BAR; PG8_SCHED;
            PG8_LDA(At, 0, 1); PG8_STAGE(PG8_SB(0, 0), b2, voffB); PG8_STAGE(PG8_SB(0, 1), b2 + hstep, voffB); PG8_STAGE(PG8_SA(0, 0), a2, voffA);
            PG8_WAIT_V(8); PG8_WAIT_L(0); PG8_BAR; PG8_MMA(1, 0, At, B0); PG8_MMA(1, 1, At, B1); PG8_BAR; PG8_SCHED;
            PG8_LDB(B0, 1, 0); PG8_LDB(B1, 1, 1); PG8_SCHED; PG8_LDA(At, 1, 0); PG8_STAGE(PG8_SA(0, 1), a2 + hstep, voffA);
            PG8_WAIT_V(8); PG8_WAIT_L(0); PG8_BAR; PG8_MMA(0, 0, At, B0); PG8_MMA(0, 1, At, B1); PG8_BAR; PG8_SCHED;
            PG8_LDA(At, 1, 1); PG8_STAGE(PG8_SB(1, 0), b3, voffB); PG8_STAGE(PG8_SB(1, 1), b3 + hstep, voffB); PG8_STAGE(PG8_SA(1, 0), a3, voffA);
            PG8_WAIT_V(8); PG8_WAIT_L(0); PG8_BAR; PG8_MMA(1, 0, At, B0); PG8_MMA(1, 1, At, B1); PG8_BAR; PG8_SCHED;
            } else {
            PG8_LDB(B0, 0, 0); PG8_SCHED; PG8_LDA(At, 0, 0); PG8_STAGE(PG8_SA(1, 1), a1 + hstep, voffA);
            PG8_WAIT_L(8); PG8_BAR; PG8_WAIT_L(0); PG8_MMA(0, 0, At, B0); PG8_BAR; PG8_SCHED;
            PG8_LDB(B1, 0, 1); PG8_STAGE(PG8_SB(0, 0), b2, voffB);
            PG8_BAR; PG8_WAIT_L(0); PG8_MMA(0, 1, At, B1); PG8_BAR;
            PG8_LDA(At, 0, 1); PG8_STAGE(PG8_SA(0, 0), a2, voffA);
            PG8_BAR; PG8_WAIT_L(0); PG8_MMA(1, 0, At, B0); PG8_BAR; PG8_SCHED;
            PG8_STAGE(PG8_SB(0, 1), b2 + hstep, voffB);
            PG8_WAIT_V(6); PG8_BAR; PG8_MMA(1, 1, At, B1); PG8_BAR;
            PG8_LDB(B0, 1, 0); PG8_SCHED; PG8_LDA(At, 1, 0); PG8_STAGE(PG8_SA(0, 1), a2 + hstep, voffA);
            PG8_WAIT_L(8); PG8_BAR; PG8_WAIT_L(0); PG8_MMA(0, 0, At, B0); PG8_BAR; PG8_SCHED;
            PG8_LDB(B1, 1, 1); PG8_STAGE(PG8_SB(1, 0), b3, voffB);
            PG8_BAR; PG8_WAIT_L(0); PG8_MMA(0, 1, At, B1); PG8_BAR;
            PG8_LDA(At, 1, 1); PG8_STAGE(PG8_SA(1, 0), a3, voffA);
            PG8_BAR; PG8_WAIT_L(0); PG8_MMA(1, 0, At, B0); PG8_BAR; PG8_SCHED;
            PG8_STAGE(PG8_SB(1, 1), b3 + hstep, voffB);
            PG8_WAIT_V(6); PG8_BAR; PG8_MMA(1, 1, At, B1); PG8_BAR;
            }
        }
        if constexpr (ALIGN_EPI) { if (wr == 0) PG8_BAR; }
        if constexpr (!Epi::AFTER_DRAIN) { E(acc, cur, wr, wc, fr, fq); S.done(cur); }
        if (!has_next) break;
#pragma unroll
        for (int a = 0; a < 2; ++a)
#pragma unroll
            for (int b = 0; b < 2; ++b)
#pragma unroll
                for (int m = 0; m < 4; ++m)
#pragma unroll
                    for (int n = 0; n < 2; ++n) acc[a][b][m][n] = (f32x4){0.f, 0.f, 0.f, 0.f};
        cur = nxt; cA = nA; cB = nB; ++ui;
        if constexpr (ALIGN_EPI) { if (wr == 1) PG8_BAR; }
    }
    PG8_WAIT_V(0);
    if constexpr (!ALIGN_EPI) { if (wr == 0) PG8_BAR; }
    PG8_BAR;
    if constexpr (Epi::AFTER_DRAIN) { E.fused(acc, cur, wr, wc, fr, fq, lds, wid, lane); S.done(cur); }
#undef PG8_SA
#undef PG8_SB
#undef PG8_STAGE
#undef PG8_LDA
#undef PG8_LDB
#undef PG8_MMA
#undef PG8_WAIT_V
#undef PG8_WAIT_L
#undef PG8_BAR
#undef PG8_SCHED
}

}

constexpr int NWAVES = 8;
constexpr int D = 1024, NB = 4, T = 4096, M = NB * T, BR = 512, NH = 8, PT = 7936, DFF = 2816, NE = 8, SHIFT = 1792;
constexpr float LN_EPS = 1e-5f, GN_EPS = 64e-5f;
constexpr float ALPHA = 1.41421356237309515f;
constexpr float C2 = 0.125f * 1.4426950408889634f;
constexpr int PC_CH = 0, PC_CB = 512, PC_CC = 1024, PC_Q = 1536, PC_K = 2048, PC_V = 2560, PC_R = 3072, PC_RK = 3584, PC_RV = 4096, PC_WL = 4608, PC_AL = 4672, PC_GL = 4736, PC_GATE = 4864;
constexpr int MOE_MAXT = 136, MOE_ROWS_MAX = MOE_MAXT * 256;

constexpr size_t MiB = 1u << 20;
constexpr size_t WS_CTL = 0, CTL_ZERO_BYTES = 1 * MiB;
constexpr size_t WS_MISC = 1 * MiB;
constexpr size_t WS_XB = 2 * MiB;
constexpr size_t WS_MERGED = 34 * MiB;
constexpr size_t WS_RWX = 2 * MiB;
constexpr size_t WS_W = 66 * MiB;
constexpr size_t WS_PROJ = 124 * MiB;
constexpr size_t WS_OCAT = 372 * MiB;
constexpr size_t WS_YSC = 420 * MiB;
constexpr size_t WS_MISC2 = 436 * MiB;
constexpr size_t WS_HBUF = WS_PROJ;
constexpr size_t WS_MOEW = 124 * MiB;
constexpr size_t WS_HMOE = 256 * MiB;
constexpr size_t WS_XS = 34 * MiB;
constexpr size_t WS_YBUF = 2 * MiB;
constexpr size_t WS_END = 444 * MiB;
constexpr size_t W_IN_SZ = (size_t)PT * D, W_BR_SZ = (size_t)D * 1536, W_O_SZ = (size_t)D * D, W_GU_SZ = (size_t)2 * DFF * D, W_D_SZ = (size_t)D * DFF;
constexpr size_t WO_IN = 0, WO_BR = WO_IN + 2 * W_IN_SZ, WO_O = WO_BR + 2 * W_BR_SZ, WO_GU = WO_O + 2 * W_O_SZ, WO_D = WO_GU + W_GU_SZ, WO_END = WO_D + W_D_SZ;
static_assert(WO_END * 2 <= 58 * MiB, "weights fit");
constexpr size_t MOE_E_SZ = W_GU_SZ + W_D_SZ;
static_assert(WS_MOEW + NE * MOE_E_SZ * 2 <= WS_HMOE, "moe weights fit");
static_assert(WS_HMOE + (size_t)MOE_ROWS_MAX * DFF * 2 <= WS_END, "hmoe fits");
constexpr size_t M2_ROPE = 0;
constexpr size_t M2_KSUM = 1 * MiB;
constexpr size_t M1_ASG = 0;
constexpr size_t M1_TILE = 768 * 1024;
constexpr int CW_BAR = 4096;
constexpr int CW_CNT = 64;

constexpr int RING_OFF = 0, RING_BYTES = 131072;
constexpr int LDSCTL_OFF = RING_BYTES, MISC_OFF = LDSCTL_OFF + 320;
constexpr int LDS_BYTES = 147456;

#define GAS __attribute__((address_space(1)))
#define LAS __attribute__((address_space(3)))
typedef unsigned short bf16;
typedef unsigned v4u __attribute__((ext_vector_type(4)));
typedef unsigned v2u __attribute__((ext_vector_type(2)));
typedef float f32x4 __attribute__((ext_vector_type(4)));
typedef GAS unsigned gu32;
#define RLX_AGENT __ATOMIC_RELAXED, __HIP_MEMORY_SCOPE_AGENT
#define LDS_WAIT() asm volatile("s_waitcnt lgkmcnt(0)" ::: "memory")
__device__ __forceinline__ unsigned f2bf(float f) { unsigned u = __builtin_bit_cast(unsigned, f); return (u + 0x7fffu + ((u >> 16) & 1u)) >> 16; }
__device__ __forceinline__ unsigned pk2(float lo, float hi) { return f2bf(lo) | (f2bf(hi) << 16); }
__device__ __forceinline__ float bflo(unsigned w) { return __uint_as_float(w << 16); }
__device__ __forceinline__ float bfhi(unsigned w) { return __uint_as_float(w & 0xffff0000u); }
__device__ __forceinline__ float bf1(bf16 h) { return __uint_as_float((unsigned)h << 16); }
__device__ __forceinline__ void unpack8(const v4u w, float (&f)[8]) { f[0] = bflo(w.x); f[1] = bfhi(w.x); f[2] = bflo(w.y); f[3] = bfhi(w.y); f[4] = bflo(w.z); f[5] = bfhi(w.z); f[6] = bflo(w.w); f[7] = bfhi(w.w); }
__device__ __forceinline__ v4u pack8(const float (&f)[8]) { v4u w; w.x = pk2(f[0], f[1]); w.y = pk2(f[2], f[3]); w.z = pk2(f[4], f[5]); w.w = pk2(f[6], f[7]); return w; }
__device__ __forceinline__ float wave_sum(float v) {
#pragma unroll
    for (int o = 1; o < 64; o <<= 1) v += __shfl_xor(v, o);
    return v;
}
__device__ __forceinline__ float sum8lanes(float v) { v += __shfl_xor(v, 1); v += __shfl_xor(v, 2); v += __shfl_xor(v, 4); return v; }
__device__ __forceinline__ float sigmoidf_(float x) { return 1.f / (1.f + expf(-x)); }

__device__ __forceinline__ int lane_id() { int r; asm volatile("v_mbcnt_lo_u32_b32 %0, -1, 0\n\tv_mbcnt_hi_u32_b32 %0, -1, %0" : "=v"(r)); return r; }
#define XB_TMO      128
#define XB_XCNT(j)  (256  + 64 * (j))
#define XB_XSUB(j)  (1280 + 64 * (j))
#define XB_XGEN(j)  (2304 + 64 * (j))
#define XB_TOP      3328
#define XB_TOPGEN   3392
#define XCD_BAR_WORDS 3456
#define XB_SPIN_CAP (1u << 18)
__device__ __forceinline__ unsigned xb_ld(unsigned* p)              { return __hip_atomic_load(p, __ATOMIC_RELAXED, __HIP_MEMORY_SCOPE_AGENT); }
__device__ __forceinline__ unsigned xb_add(unsigned* p, unsigned v) { return __hip_atomic_fetch_add(p, v, __ATOMIC_RELAXED, __HIP_MEMORY_SCOPE_AGENT); }
__device__ __forceinline__ unsigned xb_xcc_id() { return (unsigned)__builtin_amdgcn_s_getreg((3 << 11) | 20) & 0xFu; }
#define XB_SPIN(cond, bar) do { unsigned _sp = 0; while (cond) { __builtin_amdgcn_s_sleep(1); \
    if ((++_sp & 255u) == 0u) { if (xb_ld(&(bar)[XB_TMO])) break; if (_sp > XB_SPIN_CAP) { atomicAdd(&(bar)[XB_TMO], 1u); break; } } } } while (0)
struct XcdBarrier { unsigned* bar; unsigned x; volatile LAS unsigned* st; };
__device__ __forceinline__ XcdBarrier xcd_barrier_post(unsigned* bar, volatile LAS unsigned* st, const bool leader) {
    XcdBarrier b; b.bar = bar; b.x = xb_xcc_id(); b.st = st;
    if (leader) (void)xb_add(&bar[XB_XCNT(b.x)], 1u);
    return b;
}
__device__ __forceinline__ void xcd_barrier_complete(unsigned* bar, unsigned x, unsigned& nloc, unsigned& nx) {
    const unsigned G = gridDim.x * gridDim.y * gridDim.z;
    unsigned sum, cnt, mine, sp = 0u;
    for (;;) {
        sum = 0u; cnt = 0u; mine = 0u;
#pragma unroll
        for (unsigned j = 0; j < 16; ++j) { const unsigned c = xb_ld(&bar[XB_XCNT(j)]); sum += c; cnt += (c > 0u) ? 1u : 0u; mine = (j == x) ? c : mine; }
        if (sum == G) break;
        __builtin_amdgcn_s_sleep(1);
        if ((++sp & 255u) == 0u) { if (xb_ld(&bar[XB_TMO])) break; if (sp > XB_SPIN_CAP) { atomicAdd(&bar[XB_TMO], 1u); break; } }
    }
    nloc = mine > 0u ? mine : 1u; nx = cnt > 0u ? cnt : 1u;
}
__device__ __forceinline__ void xcd_barrier(const XcdBarrier& b, const bool leader) {
    asm volatile("s_waitcnt vmcnt(0)" ::: "memory");
    __syncthreads();
    if (leader) {
        unsigned* bar = b.bar;
        __builtin_amdgcn_s_waitcnt(0);
        unsigned nloc = b.st[0], nx = b.st[1];
        if (nloc == 0u) { xcd_barrier_complete(bar, b.x, nloc, nx); b.st[0] = nloc; b.st[1] = nx; }
        const unsigned old = xb_add(&bar[XB_XSUB(b.x)], 1u);
        const unsigned gen = old / nloc;
        if (old + 1u == (gen + 1u) * nloc) {
            __builtin_amdgcn_fence(__ATOMIC_RELEASE, "agent");
            asm volatile("s_waitcnt vmcnt(0)" ::: "memory");
            const unsigned og = xb_add(&bar[XB_TOP], 1u);
            const unsigned tg = og / nx;
            if (og + 1u == (tg + 1u) * nx) xb_add(&bar[XB_TOPGEN], 1u);
            else XB_SPIN(xb_ld(&bar[XB_TOPGEN]) == tg, bar);
            __builtin_amdgcn_fence(__ATOMIC_ACQUIRE, "agent");
            xb_add(&bar[XB_XGEN(b.x)], 1u);
            asm volatile("s_waitcnt vmcnt(0)" ::: "memory");
        } else {
            XB_SPIN(xb_ld(&bar[XB_XGEN(b.x)]) == gen, bar);
            __builtin_amdgcn_fence(__ATOMIC_ACQUIRE, "agent");
            asm volatile("s_waitcnt vmcnt(0)" ::: "memory");
        }
    }
    __syncthreads();
}

struct Frame {
    LAS unsigned char* lds;
    int tid, lane, wave;
    int vcu, G;
};
__device__ __forceinline__ Frame make_frame(LAS unsigned char* lds, const int wave_s) {
    Frame F; F.lds = lds;
    const int t = lane_id(); F.lane = t; F.wave = wave_s; F.tid = wave_s * 64 + t;
    int bx = blockIdx.x, G = gridDim.x; asm volatile("" : "+s"(bx), "+s"(G));
    F.G = G; F.vcu = (G % 8 == 0) ? (bx % 8) * (G / 8) + bx / 8 : bx;
    return F;
}

namespace attn_body {
typedef unsigned short bf16;
using bf16x8=__attribute__((ext_vector_type(8)))short;
using s16x4=__attribute__((ext_vector_type(4)))short;
using f32x16=__attribute__((ext_vector_type(16)))float;
using u32x4=__attribute__((ext_vector_type(4)))unsigned;
constexpr int BATCH=4,NHEAD=8,SEQ=4096,D=64,PQ=7936,PO=1536;
constexpr int NW=8,QBLK=32,QB=QBLK*NW,KVBLK=64,NQB=SEQ/QB;
__device__ __forceinline__ int crow(int r,int hi){return (r&3)+8*(r>>2)+4*hi;}
#define SBAR() __builtin_amdgcn_sched_barrier(0)
__device__ __forceinline__ void cmask(f32x16&p0,f32x16&p1,int jb,int qrel,int hi){
  const float NEG=-INFINITY; int kb=64*jb+4*hi;
  #pragma unroll
  for(int r=0;r<16;++r){int kv=kb+(r&3)+8*(r>>2); if(kv>qrel)p0[r]=NEG; if(kv+32>qrel)p1[r]=NEG;}
}

constexpr int NSLOT=3, SLOTB=8192;
constexpr int LDS_K=0, LDS_V=NSLOT*SLOTB, LDS_WS=2*NSLOT*SLOTB, LDS_OST=LDS_WS+NW*64*4, LDS_KML=LDS_OST+NW*4096, LDS_BYTES=LDS_KML+4096;
constexpr float C2=0.125f*1.4426950408889634f;
__device__ __forceinline__ void glds16(const void*gbase,unsigned voff,unsigned lds_dst){unsigned keep;
  asm volatile("s_mov_b32 %0, m0\n\ts_mov_b32 m0, %2\n\ts_nop 4\n\tglobal_load_lds_dwordx4 %1, %3\n\ts_mov_b32 m0, %0":"=&s"(keep):"v"(voff),"s"(lds_dst),"s"(gbase):"memory");}
__device__ __forceinline__ float max3f(float a,float b,float c){float r;asm("v_max3_f32 %0, %1, %2, %3":"=v"(r):"v"(a),"v"(b),"v"(c));return r;}
__device__ __forceinline__ float max2f(float a,float b){float r;asm("v_max_f32_e32 %0, %1, %2":"=v"(r):"v"(a),"v"(b));return r;}
__device__ __forceinline__ float fadd_s(float a,float b){float r;asm("v_add_f32_e32 %0, %1, %2":"=v"(r):"v"(a),"v"(b));return r;}
__device__ __forceinline__ float fsub_s(float a,float b){float r;asm("v_sub_f32_e32 %0, %1, %2":"=v"(r):"v"(a),"v"(b));return r;}
typedef float f32x2_t __attribute__((ext_vector_type(2))); typedef __bf16 bf16x2_t __attribute__((ext_vector_type(2)));
__device__ __forceinline__ unsigned cvtpk_s(float lo,float hi){f32x2_t v={lo,hi};bf16x2_t b=__builtin_convertvector(v,bf16x2_t);return __builtin_bit_cast(unsigned,b);}
#define WAIT_BAR(N) asm volatile("s_waitcnt vmcnt(" #N ") lgkmcnt(0)\n\ts_barrier":::"memory")

__device__ __forceinline__ void qkt(f32x16&p0,f32x16&p1,const char*Kslot,const bf16x8*qr,int r32,int hi){ const f32x16 negm=f32x16{};
  const char*kb=Kslot+hi*1024+r32*16;
  #pragma unroll
  for(int d0=0;d0<4;++d0){
    const bf16x8 b0=*reinterpret_cast<const bf16x8*>(kb+d0*2048);
    const bf16x8 b1=*reinterpret_cast<const bf16x8*>(kb+d0*2048+512);
    if(d0==0){p0=__builtin_amdgcn_mfma_f32_32x32x16_bf16(b0,qr[0],negm,0,0,0);p1=__builtin_amdgcn_mfma_f32_32x32x16_bf16(b1,qr[0],negm,0,0,0);}
    else{p0=__builtin_amdgcn_mfma_f32_32x32x16_bf16(b0,qr[d0],p0,0,0,0);p1=__builtin_amdgcn_mfma_f32_32x32x16_bf16(b1,qr[d0],p1,0,0,0);}}
}
typedef __attribute__((address_space(3))) const char* lds_cptr;
typedef short v4i16_t __attribute__((ext_vector_type(4)));
__device__ __forceinline__ void kload8(bf16x8*kf,lds_cptr kp){
  kf[0]=*(const __attribute__((address_space(3))) bf16x8*)(kp);      kf[1]=*(const __attribute__((address_space(3))) bf16x8*)(kp+512);
  kf[2]=*(const __attribute__((address_space(3))) bf16x8*)(kp+2048); kf[3]=*(const __attribute__((address_space(3))) bf16x8*)(kp+2560);
  kf[4]=*(const __attribute__((address_space(3))) bf16x8*)(kp+4096); kf[5]=*(const __attribute__((address_space(3))) bf16x8*)(kp+4608);
  kf[6]=*(const __attribute__((address_space(3))) bf16x8*)(kp+6144); kf[7]=*(const __attribute__((address_space(3))) bf16x8*)(kp+6656);
}
__device__ __forceinline__ void kload2(bf16x8*kf,lds_cptr kp,int j){ kf[2*j]=*(const __attribute__((address_space(3))) bf16x8*)(kp+j*2048); kf[2*j+1]=*(const __attribute__((address_space(3))) bf16x8*)(kp+j*2048+512); }
__device__ __forceinline__ s16x4 vtr(lds_cptr p){ return __builtin_bit_cast(s16x4,__builtin_amdgcn_ds_read_tr16_b64_v4i16((__attribute__((address_space(3))) v4i16_t*)p)); }
__device__ __forceinline__ float rowmax(const f32x16&p0,const f32x16&p1){
  float a=max3f(p0[0],p0[1],p1[0]),b=max3f(p0[2],p0[3],p1[1]);a=max3f(a,p1[2],p1[3]);
  #pragma unroll
  for(int r=4;r<16;r+=4){a=max3f(a,p0[r],p0[r+1]);b=max3f(b,p0[r+2],p0[r+3]);a=max3f(a,p1[r],p1[r+1]);b=max3f(b,p1[r+2],p1[r+3]);}
  const float m=max2f(a,b);
  auto rr=__builtin_amdgcn_permlane32_swap(__float_as_uint(m),__float_as_uint(m),false,false);
  return max2f(__uint_as_float(rr[0]),__uint_as_float(rr[1]));
}
__device__ __forceinline__ void pv(f32x16*o,int vb,bf16x8 pa0,bf16x8 pa1,bf16x8 pa2,bf16x8 pa3){
  #pragma unroll
  for(int d0=0;d0<2;++d0){s16x4 lo[4],hi[4];
    #pragma unroll
    for(int ks=0;ks<4;++ks){
      asm volatile("ds_read_b64_tr_b16 %0,%1 offset:%c2":"=&v"(lo[ks]):"v"(vb),"i"(d0*4096+ks*1024):"memory");
      asm volatile("ds_read_b64_tr_b16 %0,%1 offset:%c2":"=&v"(hi[ks]):"v"(vb),"i"(d0*4096+ks*1024+512):"memory");}
    asm volatile("s_waitcnt lgkmcnt(0)":::"memory");SBAR();
    #define PK(k) (bf16x8){lo[k][0],lo[k][1],lo[k][2],lo[k][3],hi[k][0],hi[k][1],hi[k][2],hi[k][3]}
    o[d0]=__builtin_amdgcn_mfma_f32_32x32x16_bf16(pa0,PK(0),o[d0],0,0,0);
    o[d0]=__builtin_amdgcn_mfma_f32_32x32x16_bf16(pa1,PK(1),o[d0],0,0,0);
    o[d0]=__builtin_amdgcn_mfma_f32_32x32x16_bf16(pa2,PK(2),o[d0],0,0,0);
    o[d0]=__builtin_amdgcn_mfma_f32_32x32x16_bf16(pa3,PK(3),o[d0],0,0,0);
    #undef PK
  }
}

#ifndef ATTN_STORE16
#define ATTN_STORE16(p,v) (*(u32x4*)(p)=(v))
#endif
template<int THRL> __device__ __forceinline__ void attn_unit(int b,int h,int qb,const bf16*Q,const bf16*__restrict__ K,const bf16*__restrict__ V,bf16*O,const float*__restrict__ ksum,char*shm,const int wave_s){
  int lane; asm volatile("v_mbcnt_lo_u32_b32 %0, -1, 0\n\tv_mbcnt_hi_u32_b32 %0, -1, %0" : "=v"(lane)); const int wid=wave_s,tid=wid*64+lane,r32=lane&31,hi=lane>>5;
  const long rowbase=(long)b*SEQ; const int q0=qb*QB;
  const bf16*Qw=Q+(rowbase+q0+wid*QBLK)*PQ+h*D;
  const bf16*Kh=K+rowbase*PQ+h*D,*Vh=V+rowbase*PQ+h*D;
  const unsigned lds0=(unsigned)(uintptr_t)shm;
  float*wsf=(float*)(shm+LDS_WS)+wid*64;
  const unsigned kvo=(unsigned)(lane*PQ+wid*8)*2u;
  const unsigned vvo=(unsigned)((16*(wid&3)+(lane>>2))*PQ+(wid>>2)*32+(lane&3)*8)*2u;
  const unsigned kdst=lds0+LDS_K+wid*1024, vdst=lds0+LDS_V+wid*1024;
  #define DMA_K(t,slot) glds16(Kh+(long)(t)*KVBLK*PQ,kvo,(unsigned)__builtin_amdgcn_readfirstlane(kdst+(slot)))
  #define DMA_V(t,slot) glds16(Vh+(long)(t)*KVBLK*PQ,vvo,(unsigned)__builtin_amdgcn_readfirstlane(vdst+(slot)))
  const int vb0=(int)(lds0+LDS_V)+((lane>>4)&1)*32+(lane&3)*8+(4*hi+((lane&15)>>2))*64;
  const char*Kbase=shm+LDS_K; bf16x8 kf[8];
  const lds_cptr shm3=(lds_cptr)shm; const lds_cptr kp0=shm3+LDS_K+hi*1024+r32*16; const lds_cptr vp0=shm3+LDS_V+((lane>>4)&1)*32+(lane&3)*8+(4*hi+((lane&15)>>2))*64;
  const int NT=(q0+QB)/KVBLK;
  { float*kml=(float*)(shm+LDS_KML); const float*ks=ksum+(size_t)(b*NHEAD+h)*16*4*64;
    _Pragma("unroll") for(int i=0;i<2;++i){const int e=tid+512*i; const float*kp=ks+(size_t)(e>>6)*256+(e&63); kml[e]=((kp[0]+kp[64])+(kp[128]+kp[192]))*(1.0f/256.0f);} }
  DMA_K(0,0);DMA_V(0,0);DMA_K(1,SLOTB);
  bf16x8 qr[4];
  #pragma unroll
  for(int d0=0;d0<4;++d0)qr[d0]=*reinterpret_cast<const bf16x8*>(&Qw[(long)r32*PQ+d0*16+hi*8]);
  float mhat=0.f,l_reg=0.f;f32x16 o[2];o[0]=f32x16{};o[1]=f32x16{};
  const int qrel=wid*QBLK+r32;
  #define CMASK(P0,P1,t) do{int jb_=(t)-(NT-4); if(jb_>=0)cmask(P0,P1,jb_,qrel,hi);}while(0)
  bool resc=false;
  #define START(P0,P1) do{ const float rm=rowmax(P0,P1); resc=false; \
    { const float dl=(rm==-INFINITY)?0.f:rm; mhat=fadd_s(mhat,dl);     \
      _Pragma("unroll") for(int r=0;r<16;++r){P0[r]=fsub_s(P0[r],dl);P1[r]=fsub_s(P1[r],dl);} \
      } \
    _Pragma("unroll") for(int r=0;r<16;++r)P0[r]=__builtin_amdgcn_exp2f(P0[r]); }while(0)
  #define RESC() do{ if(resc){ asm volatile("s_waitcnt lgkmcnt(0)":::"memory"); \
      _Pragma("unroll") for(int d_=0;d_<2;++d_) _Pragma("unroll") for(int r=0;r<16;++r)o[d_][r]*=wsf[crow(r,hi)]; } }while(0)
  f32x16 pA0,pA1,pB0,pB1;
  int sl_prev=0,sl_cur=0,sl_next=SLOTB;
  #define ROT() do{sl_prev=sl_cur;sl_cur=sl_next;sl_next=(sl_next==(NSLOT-1)*SLOTB)?0:sl_next+SLOTB;}while(0)
  DMA_K(2,2*SLOTB);
  WAIT_BAR(3);
  unsigned selmask=(qb<=3)?((1u<<qb)-1u):0u;
  if(qb>3){ const float*kml=(const float*)(shm+LDS_KML); float v0=-INFINITY,v1=-INFINITY,v2=-INFINITY; int i0=0,i1=0,i2=0;
    for(int n=0;n<qb;++n){ float g=0.f;
      _Pragma("unroll") for(int d0=0;d0<4;++d0){ const float*kr=kml+n*64+d0*16+hi*8;
        _Pragma("unroll") for(int j=0;j<8;++j) g=__builtin_fmaf(__uint_as_float(((unsigned)(unsigned short)qr[d0][j])<<16),kr[j],g); }
      g+=__shfl_xor(g,32);
      if(g>v0){v2=v1;i2=i1;v1=v0;i1=i0;v0=g;i0=n;} else if(g>v1){v2=v1;i2=i1;v1=g;i1=n;} else if(g>v2){v2=g;i2=n;} }
    selmask=(1u<<i0)|(1u<<i1)|(1u<<i2); }
  #define SUBREF(t) ((((t)<NT-4)&&!((selmask>>((t)>>2))&1u))?INFINITY:mhat)
  #define BMASK(P0,P1,t) do{ if(!((selmask>>((t)>>2))&1u)){ _Pragma("unroll") for(int r=0;r<16;++r){P0[r]=-INFINITY;P1[r]=-INFINITY;} } }while(0)
  qkt(pA0,pA1,Kbase,qr,r32,hi);asm volatile("s_nop 15\n\ts_nop 7":"+v"(pA0),"+v"(pA1));CMASK(pA0,pA1,0); if(NT>4)BMASK(pA0,pA1,0);
  START(pA0,pA1);
  _Pragma("unroll") for(int r=0;r<16;++r)pA1[r]=__builtin_amdgcn_exp2f(pA1[r]);
  WAIT_BAR(0);
  DMA_K(3,0);DMA_V(1,SLOTB);
  ROT();
  kload8(kf,kp0+sl_cur);
  WAIT_BAR(2);
  s16x4 vlo[8],vhi[8]; u32x4 pw0,pw1,pw2,pw3;
  #define PKW(P,B) cvtpk_s(P[B],P[B+1])
  #define PAF(k) __builtin_bit_cast(bf16x8,pw##k)
  #define VFR(i) (bf16x8){vlo[i][0],vlo[i][1],vlo[i][2],vlo[i][3],vhi[i][0],vhi[i][1],vhi[i][2],vhi[i][3]}
  #define PIN(x) asm volatile("":"+v"(x))
  #define MX3(a,b,c) __builtin_fmaxf(__builtin_fmaxf((a),(b)),(c))
  #define GAPA(MF,A0,A1,A2,A3,W0,W1,PW) do{ MF; sacc+=A0; sacc+=A1; sacc+=A2; sacc+=A3; PIN(sacc); W0; W1; PIN(PW); SBAR(); }while(0)
  #define EX(v) __builtin_amdgcn_exp2f(v)
  #define GAPB(MF,X,B) do{ MF; X[B]=EX(X[B]); X[B+1]=EX(X[B+1]); X[B+2]=EX(X[B+2]); X[B+3]=EX(X[B+3]); PIN(X); SBAR(); }while(0)
  #define VRD(i) do{ vlo[i]=vtr(vp_+(((i)>>2)*4096+((i)&3)*1024)); vhi[i]=vtr(vp_+(((i)>>2)*4096+((i)&3)*1024+512)); }while(0)
  #define KRD(G,j) do{ if(G){ kload2(kf,kp0+sl_next,j); SBAR(); } }while(0)
  #define STEP(C0,C1,P0,P1,t,GK,GV,GL) do{ SBAR(); \
    const lds_cptr vp_=vp0+sl_prev; \
    VRD(0); SBAR(); float sacc=(P0[0]+P0[1]); \
    GAPA(C0=__builtin_amdgcn_mfma_f32_32x32x16_bf16(kf[0],qr[0],f32x16{},0,0,0), P0[2],P0[3],P0[4],P0[5],     pw0[0]=PKW(P0,0), pw0[1]=PKW(P0,2), pw0); \
    VRD(4); SBAR(); GAPA(C1=__builtin_amdgcn_mfma_f32_32x32x16_bf16(kf[1],qr[0],f32x16{},0,0,0), P0[6],P0[7],P0[8],P0[9],     pw0[2]=PKW(P0,4), pw0[3]=PKW(P0,6), pw0); \
    VRD(1); SBAR(); GAPA(C0=__builtin_amdgcn_mfma_f32_32x32x16_bf16(kf[2],qr[1],C0,0,0,0),   P0[10],P0[11],P0[12],P0[13], pw1[0]=PKW(P0,8), pw1[1]=PKW(P0,10), pw1); \
    VRD(5); SBAR(); GAPA(C1=__builtin_amdgcn_mfma_f32_32x32x16_bf16(kf[3],qr[1],C1,0,0,0),   P0[14],P0[15],P1[0],P1[1],   pw1[2]=PKW(P0,12),pw1[3]=PKW(P0,14), pw1); \
    VRD(2); SBAR(); GAPA(C0=__builtin_amdgcn_mfma_f32_32x32x16_bf16(kf[4],qr[2],C0,0,0,0),   P1[2],P1[3],P1[4],P1[5],     pw2[0]=PKW(P1,0), pw2[1]=PKW(P1,2), pw2); \
    VRD(6); SBAR(); GAPA(C1=__builtin_amdgcn_mfma_f32_32x32x16_bf16(kf[5],qr[2],C1,0,0,0),   P1[6],P1[7],P1[8],P1[9],     pw2[2]=PKW(P1,4), pw2[3]=PKW(P1,6), pw2); \
    VRD(3); SBAR(); GAPA(C0=__builtin_amdgcn_mfma_f32_32x32x16_bf16(kf[6],qr[3],C0,0,0,0),   P1[10],P1[11],P1[12],P1[13], pw3[0]=PKW(P1,8), pw3[1]=PKW(P1,10), pw3); \
    VRD(7); SBAR(); GAPA(C1=__builtin_amdgcn_mfma_f32_32x32x16_bf16(kf[7],qr[3],C1,0,0,0),   P1[14],P1[15],0.f,0.f,       pw3[2]=PKW(P1,12),pw3[3]=PKW(P1,14), pw3); \
    l_reg+=sacc; \
    if(GK){DMA_K((t)+3,sl_cur);} if(GV){DMA_V((t)+1,sl_next);} \
    { const float sub_=SUBREF(t); _Pragma("unroll") for(int r=0;r<16;++r){C0[r]-=sub_;C1[r]-=sub_;} } \
    CMASK(C0,C1,t); \
    { float a=MX3(C0[0],C0[1],C1[0]),b=MX3(C0[2],C0[3],C1[1]); a=MX3(a,C1[2],C1[3]); \
      _Pragma("unroll") for(int r=4;r<16;r+=4){a=MX3(a,C0[r],C0[r+1]);b=MX3(b,C0[r+2],C0[r+3]);a=MX3(a,C1[r],C1[r+1]);b=MX3(b,C1[r+2],C1[r+3]);} \
      float rm=__builtin_fmaxf(a,b); { auto rr=__builtin_amdgcn_permlane32_swap(__float_as_uint(rm),__float_as_uint(rm),false,false); rm=__builtin_fmaxf(__uint_as_float(rr[0]),__uint_as_float(rr[1])); } \
      resc=false; \
      if(__builtin_expect(__any(rm>(float)THRL),0)){ const float dl=__builtin_fmaxf(rm,0.f); mhat+=dl; \
        _Pragma("unroll") for(int r=0;r<16;++r){C0[r]-=dl;C1[r]-=dl;} \
        const float f=__builtin_amdgcn_exp2f(-dl); l_reg*=f; if(hi==0)wsf[r32]=f; resc=true; } } \
    SBAR(); \
    GAPB(o[0]=__builtin_amdgcn_mfma_f32_32x32x16_bf16(PAF(0),VFR(0),o[0],0,0,0), C0,0); \
    GAPB(o[1]=__builtin_amdgcn_mfma_f32_32x32x16_bf16(PAF(0),VFR(4),o[1],0,0,0), C0,4); \
    KRD(GL,0); GAPB(o[0]=__builtin_amdgcn_mfma_f32_32x32x16_bf16(PAF(1),VFR(1),o[0],0,0,0), C0,8); \
    KRD(GL,1); GAPB(o[1]=__builtin_amdgcn_mfma_f32_32x32x16_bf16(PAF(1),VFR(5),o[1],0,0,0), C0,12); \
    KRD(GL,2); GAPB(o[0]=__builtin_amdgcn_mfma_f32_32x32x16_bf16(PAF(2),VFR(2),o[0],0,0,0), C1,0); \
    KRD(GL,3); GAPB(o[1]=__builtin_amdgcn_mfma_f32_32x32x16_bf16(PAF(2),VFR(6),o[1],0,0,0), C1,4); \
    GAPB(o[0]=__builtin_amdgcn_mfma_f32_32x32x16_bf16(PAF(3),VFR(3),o[0],0,0,0), C1,8); \
    GAPB(o[1]=__builtin_amdgcn_mfma_f32_32x32x16_bf16(PAF(3),VFR(7),o[1],0,0,0), C1,12); \
    }while(0)
  int t=1;
  #undef CMASK
  #define CMASK(P0,P1,t) do{}while(0)
  for(;t+5<NT;t+=2){
    STEP(pB0,pB1,pA0,pA1,t,true,true,true);     WAIT_BAR(2); RESC(); ROT();
    STEP(pA0,pA1,pB0,pB1,t+1,true,true,true);   WAIT_BAR(2); RESC(); ROT();
  }
  #undef CMASK
  #define CMASK(P0,P1,t) do{int jb_=(t)-(NT-4); if(jb_>=0)cmask(P0,P1,jb_,qrel,hi);}while(0)
  #define ENDW(tt) do{ if((tt)+3<NT){WAIT_BAR(2);} else if((tt)+2<NT){WAIT_BAR(1);} else {WAIT_BAR(0);} }while(0)
  for(;t+1<NT;t+=2){
    STEP(pB0,pB1,pA0,pA1,t,(t+3<NT),(t+1<NT),(t+1<NT));       ENDW(t);   RESC(); ROT();
    STEP(pA0,pA1,pB0,pB1,t+1,(t+4<NT),(t+2<NT),(t+2<NT));     ENDW(t+1); RESC(); ROT();
  }
  STEP(pB0,pB1,pA0,pA1,NT-1,false,false,false); RESC();
  { float sacc=pB0[0]+pB0[1]; _Pragma("unroll") for(int r=2;r<16;++r)sacc+=pB0[r]; _Pragma("unroll") for(int r=0;r<16;++r)sacc+=pB1[r]; l_reg+=sacc;
    pw0=(u32x4){PKW(pB0,0),PKW(pB0,2),PKW(pB0,4),PKW(pB0,6)};pw1=(u32x4){PKW(pB0,8),PKW(pB0,10),PKW(pB0,12),PKW(pB0,14)};pw2=(u32x4){PKW(pB1,0),PKW(pB1,2),PKW(pB1,4),PKW(pB1,6)};pw3=(u32x4){PKW(pB1,8),PKW(pB1,10),PKW(pB1,12),PKW(pB1,14)};
    SBAR(); pv(o,vb0+sl_cur,PAF(0),PAF(1),PAF(2),PAF(3)); }
  #undef PKW
  #undef PAF
  #undef VFR
  #undef PIN
  #undef MX3
  #undef GAPA
  #undef GAPB
  #undef EX
  #undef VRD
  #undef KRD
  #undef STEP
  #undef ENDW
  {auto rr=__builtin_amdgcn_permlane32_swap(__float_as_uint(l_reg),__float_as_uint(l_reg),false,false);l_reg=__uint_as_float(rr[0])+__uint_as_float(rr[1]);}
  if(hi==0)wsf[32+r32]=l_reg;asm volatile("s_waitcnt lgkmcnt(0)":::"memory");
  float rli[16];
  #pragma unroll
  for(int r=0;r<16;++r)rli[r]=__builtin_amdgcn_rcpf(wsf[32+crow(r,hi)]);
  bf16*Ow=O+(rowbase+q0+wid*QBLK)*PO+h*D;
  { bf16*stg=(bf16*)(shm+LDS_OST)+wid*2048;
    #pragma unroll
    for(int r=0;r<16;++r){const int orow=crow(r,hi);
      #pragma unroll
      for(int d0=0;d0<2;++d0)stg[orow*64+d0*32+r32]=(bf16)(cvtpk_s(o[d0][r]*rli[r],0.f)&0xffffu);}
    asm volatile("s_waitcnt lgkmcnt(0)":::"memory");
    #pragma unroll
    for(int i=0;i<4;++i){const int row=i*8+(lane>>3),ch=lane&7; const u32x4 v=*(const u32x4*)(stg+row*64+ch*8); ATTN_STORE16(Ow+(long)row*PO+ch*8,v);} }
  asm volatile("s_waitcnt lgkmcnt(0)\n\ts_barrier":::"memory");
  #undef DMA_K
  #undef DMA_V
  #undef BMASK
  #undef SUBREF
  #undef CMASK
  #undef START
  #undef RESC
  #undef ROT
}
constexpr int ATTN_LDS_BYTES=LDS_BYTES;
template<int THRL=8> __device__ __forceinline__ void attn_phase(char*lds,const bf16*Q,const bf16*K,const bf16*V,bf16*O,const float*ksum,int vcu,int G,const int wave_s){
  for(int p=vcu;p<BATCH*NHEAD*8;p+=G){ const int bh=p>>3,sq=p&7;
    attn_unit<THRL>(bh/NHEAD,bh%NHEAD,sq,Q,K,V,O,ksum,lds,wave_s);
    attn_unit<THRL>(bh/NHEAD,bh%NHEAD,15-sq,Q,K,V,O,ksum,lds,wave_s); }
}
#undef SBAR
#undef WAIT_BAR
}

__device__ __forceinline__ int opq(int x) { asm volatile("" : "+v"(x)); return x; }
__device__ __forceinline__ void p0_transpose_item(const float* W, int ldw, int K, int N, bf16* WT, int row_off, int mode, LAS float* scr_, int item, int lane) {
    LAS unsigned* scr = (LAS unsigned*)scr_;
    const int nblk = N / 64, kb = item / nblk, nb = item % nblk, k0 = 64 * kb, n0 = 64 * nb;
    const int n4 = (lane & 15) * 4, kq = lane >> 4;
#pragma unroll
    for (int i = 0; i < 8; ++i) { const int kk = 8 * i + 2 * kq;
        const f32x4 a = *(const f32x4*)(W + (size_t)(k0 + kk) * ldw + n0 + n4), b = *(const f32x4*)(W + (size_t)(k0 + kk + 1) * ldw + n0 + n4);
        scr[(n4 + 0) * 36 + (kk >> 1)] = pk2(a.x, b.x); scr[(n4 + 1) * 36 + (kk >> 1)] = pk2(a.y, b.y); scr[(n4 + 2) * 36 + (kk >> 1)] = pk2(a.z, b.z); scr[(n4 + 3) * 36 + (kk >> 1)] = pk2(a.w, b.w); }
    LDS_WAIT(); asm volatile("" ::: "memory");
    const int c = lane & 7;
    const int obase = mode ? (256 * (n0 >> 7) + (n0 & 127) + row_off) : (row_off + n0);
#pragma unroll
    for (int j = 0; j < 8; ++j) { const int n = (lane >> 3) + 8 * j;
        const v4u o = *(const LAS v4u*)(scr + n * 36 + 4 * c);
        *(GAS v4u*)(WT + (size_t)(obase + n) * K + k0 + 8 * c) = o; }
    LDS_WAIT(); asm volatile("" ::: "memory");
}

typedef __attribute__((address_space(4))) const unsigned long long* kargp_t;
__device__ __forceinline__ unsigned long long karg_u64(int idx) { kargp_t kp = (kargp_t)__builtin_amdgcn_kernarg_segment_ptr(); asm volatile("" : "+s"(kp)); return kp[idx]; }
#define INP(k) ((const float*)karg_u64(k))
#define OUTP() ((float*)karg_u64(27))
#define WSP() ((unsigned char*)karg_u64(28))
enum { I_X = 0, I_WIN, I_CONVW, I_MU, I_DW0, I_DW2, I_AA0, I_AW2, I_GW2, I_KK, I_KA, I_RK, I_GNG, I_GNB, I_WBR, I_WOUT, I_LN1G, I_LN1B, I_LN2G, I_LN2B, I_FWG, I_FWU, I_FWD, I_RW, I_MWG, I_MWU, I_MWD };

__device__ __forceinline__ void p0_prologue(LAS unsigned char* lds_, const int wave_s) {
    const Frame F = make_frame(lds_, wave_s);
    LAS float* scr = (LAS float*)(F.lds + RING_OFF + F.wave * 16384);
    const int gw = F.vcu * NWAVES + F.wave, NGW = F.G * NWAVES;
    bf16* Wb = (bf16*)(WSP() + WS_W);
    constexpr int I_IN = 16 * 124, I_BR = 24 * 16, I_O = 16 * 16, I_G = 16 * 44, I_D = 44 * 16;
    constexpr int I_LAYER = I_IN + I_BR + I_O;
    constexpr int NITEMS = 2 * I_LAYER + 2 * I_G + I_D;
    for (int it = gw; it < NITEMS; it += NGW) {
        int r = it;
        if (r < 2 * I_LAYER) { const int l = r / I_LAYER; r -= l * I_LAYER;
            if (r < I_IN) { p0_transpose_item(INP(I_WIN) + (size_t)l * D * PT, PT, D, PT, Wb + WO_IN + l * W_IN_SZ, 0, 0, scr, r, F.lane); continue; } r -= I_IN;
            if (r < I_BR) { p0_transpose_item(INP(I_WBR) + (size_t)l * 1536 * D, D, 1536, D, Wb + WO_BR + l * W_BR_SZ, 0, 0, scr, r, F.lane); continue; } r -= I_BR;
            p0_transpose_item(INP(I_WOUT) + (size_t)l * D * D, D, D, D, Wb + WO_O + l * W_O_SZ, 0, 0, scr, r, F.lane); continue; }
        r -= 2 * I_LAYER;
        if (r < I_G) { p0_transpose_item(INP(I_FWG), DFF, D, DFF, Wb + WO_GU, 0, 1, scr, r, F.lane); continue; } r -= I_G;
        if (r < I_G) { p0_transpose_item(INP(I_FWU), DFF, D, DFF, Wb + WO_GU, 128, 1, scr, r, F.lane); continue; } r -= I_G;
        p0_transpose_item(INP(I_FWD), D, DFF, D, Wb + WO_D, 0, 0, scr, r, F.lane);
    }
    bf16* XB = (bf16*)(WSP() + WS_XB);
    for (int m = gw; m < M; m += NGW) {
        const GAS f32x4* xr = (const GAS f32x4*)(INP(I_X) + (size_t)m * D) + F.lane;
        GAS unsigned long long* o8 = (GAS unsigned long long*)(XB + (size_t)m * D) + F.lane;
#pragma unroll
        for (int j = 0; j < 4; ++j) { const f32x4 v = xr[64 * j]; o8[64 * j] = (unsigned long long)pk2(v.x, v.y) | ((unsigned long long)pk2(v.z, v.w) << 32); }
    }
    float* rc = (float*)(WSP() + WS_MISC2 + M2_ROPE); float* rs = rc + T * 32;
    for (int i = F.vcu * 512 + F.tid; i < T * 32; i += F.G * 512) {
        const int t = i >> 5, d = i & 31;
        const float inv = powf(10000.0f, -(float)d / 32.0f); const float ang = (float)t * inv;
        float s, c; sincosf(ang, &s, &c); rc[i] = c; rs[i] = s;
    }
}
__device__ __forceinline__ void moe_weight_prologue(LAS unsigned char* lds_, const int wave_s) {
    const Frame F = make_frame(lds_, wave_s);
    LAS float* scr = (LAS float*)(F.lds + RING_OFF + F.wave * 16384);
    const int gw = F.vcu * NWAVES + F.wave, NGW = F.G * NWAVES;
    bf16* Wm = (bf16*)(WSP() + WS_MOEW);
    constexpr int I_G = 16 * 44, I_D = 44 * 16, I_E = 2 * I_G + I_D;
    for (int it = gw; it < NE * I_E; it += NGW) {
        const int e = it / I_E; int r = it - e * I_E;
        bf16* We = Wm + (size_t)e * MOE_E_SZ;
        if (r < I_G) { p0_transpose_item(INP(I_MWG) + (size_t)e * D * DFF, DFF, D, DFF, We, 0, 1, scr, r, F.lane); continue; } r -= I_G;
        if (r < I_G) { p0_transpose_item(INP(I_MWU) + (size_t)e * D * DFF, DFF, D, DFF, We, 128, 1, scr, r, F.lane); continue; } r -= I_G;
        p0_transpose_item(INP(I_MWD) + (size_t)e * DFF * D, D, DFF, D, We + W_GU_SZ, 0, 0, scr, r, F.lane);
    }
}

__device__ __forceinline__ void m2a_rope(LAS unsigned char* lds_, const int wave_s, bf16* proj) {
    const Frame F = make_frame(lds_, wave_s);
    const float* rc = (const float*)(WSP() + WS_MISC2 + M2_ROPE); const float* rs = rc + T * 32;
    float* ksum = (float*)(WSP() + WS_MISC2 + M2_KSUM);
    LAS float* ksl = (LAS float*)(F.lds);
    const int combo = F.lane >> 2, qk = combo >> 3, h = combo & 7, c = F.lane & 3;
    for (int u = F.vcu; u < M / 64; u += F.G) {
        float ks1[8], ks2[8];
#pragma unroll
        for (int j = 0; j < 8; ++j) { ks1[j] = 0.f; ks2[j] = 0.f; }
        for (int rr = 0; rr < 8; ++rr) {
            const int row = 64 * u + 8 * F.wave + rr, t = row % T;
            bf16* p = proj + (size_t)row * PT + (qk ? PC_K : PC_Q) + h * 64 + 8 * c;
            float x1[8], x2[8], cs[8], sn[8];
            unpack8(*(const v4u*)p, x1); unpack8(*(const v4u*)(p + 32), x2);
            const f32x4 c0 = *(const f32x4*)(rc + t * 32 + 8 * c), c1 = *(const f32x4*)(rc + t * 32 + 8 * c + 4);
            const f32x4 s0 = *(const f32x4*)(rs + t * 32 + 8 * c), s1 = *(const f32x4*)(rs + t * 32 + 8 * c + 4);
#pragma unroll
            for (int j = 0; j < 4; ++j) { cs[j] = c0[j]; cs[4 + j] = c1[j]; sn[j] = s0[j]; sn[4 + j] = s1[j]; }
            float o1[8], o2[8];
#pragma unroll
            for (int j = 0; j < 8; ++j) { o1[j] = x1[j] * cs[j] - x2[j] * sn[j]; o2[j] = x2[j] * cs[j] + x1[j] * sn[j]; }
            if (qk) {
#pragma unroll
                for (int j = 0; j < 8; ++j) { ks1[j] += o1[j]; ks2[j] += o2[j]; }
            } else {
#pragma unroll
                for (int j = 0; j < 8; ++j) { o1[j] *= C2; o2[j] *= C2; }
            }
            *(v4u*)p = pack8(o1); *(v4u*)(p + 32) = pack8(o2);
        }
        if (qk) {
#pragma unroll
            for (int j = 0; j < 8; ++j) { ksl[(F.wave * 8 + h) * 64 + 8 * c + j] = ks1[j]; ksl[(F.wave * 8 + h) * 64 + 32 + 8 * c + j] = ks2[j]; }
        }
        __syncthreads();
        { const int hh = F.tid >> 6, d = F.tid & 63; float s = 0.f;
#pragma unroll
          for (int w = 0; w < 8; ++w) s += ksl[(w * 8 + hh) * 64 + d];
          const int b = u / 64, n = (u % 64) >> 2, part = u & 3;
          ksum[((((size_t)b * NH + hh) * 16 + n) * 4 + part) * 64 + d] = s; }
        __syncthreads();
    }
}
__device__ __forceinline__ void m2a_conv(LAS unsigned char* lds_, const int wave_s, const bf16* proj, const float* cw  , bf16* ocat) {
    const Frame F = make_frame(lds_, wave_s);
    const int gw = F.vcu * NWAVES + F.wave, NGW = F.G * NWAVES, c0 = 8 * F.lane;
    float w0[8], w1[8], w2[8];
#pragma unroll
    for (int j = 0; j < 8; ++j) { w0[j] = cw[c0 + j]; w1[j] = cw[BR + c0 + j]; w2[j] = cw[2 * BR + c0 + j]; }
    for (int m = gw; m < M; m += NGW) {
        const int t = m % T; const bf16* r0 = proj + (size_t)m * PT + c0;
        float ch[8], cc[8], cb[8], u0[8], u1[8], u2[8];
        unpack8(*(const v4u*)(r0 + PC_CH), ch); unpack8(*(const v4u*)(r0 + PC_CC), cc); unpack8(*(const v4u*)(r0 + PC_CB), cb);
#pragma unroll
        for (int j = 0; j < 8; ++j) { u0[j] = cc[j] * ch[j]; u1[j] = 0.f; u2[j] = 0.f; }
        if (t >= 1) { unpack8(*(const v4u*)(r0 - PT + PC_CH), ch); unpack8(*(const v4u*)(r0 - PT + PC_CC), cc);
#pragma unroll
            for (int j = 0; j < 8; ++j) u1[j] = cc[j] * ch[j]; }
        if (t >= 2) { unpack8(*(const v4u*)(r0 - 2 * PT + PC_CH), ch); unpack8(*(const v4u*)(r0 - 2 * PT + PC_CC), cc);
#pragma unroll
            for (int j = 0; j < 8; ++j) u2[j] = cc[j] * ch[j]; }
        float o[8];
#pragma unroll
        for (int j = 0; j < 8; ++j) o[j] = cb[j] * (w0[j] * u2[j] + w1[j] * u1[j] + w2[j] * u0[j]);
        *(v4u*)(ocat + (size_t)m * 1536 + c0) = pack8(o);
    }
}
__device__ __forceinline__ void m2a_rwkv_prep(LAS unsigned char* lds_, const int wave_s, int l, const bf16* proj, bf16* rwx, bf16* ocat) {
    const Frame F = make_frame(lds_, wave_s);
    const int gw = F.vcu * NWAVES + F.wave, NGW = F.G * NWAVES, lane = F.lane, c0 = 8 * lane;
    LAS float* lin = (LAS float*)(F.lds + 16384 + F.wave * 8192);
    const float* mu = INP(I_MU) + l * SHIFT;
    const f32x4 mul = *(const f32x4*)(mu + 1536 + 4 * lane);
    for (int ru = gw; ru < M / 8; ru += NGW) {
        const int r0 = 8 * ru;
#pragma unroll
        for (int rr = 0; rr < 8; ++rr) {
            const int row = r0 + rr, t = row % T;
            const v2u cur = *(const v2u*)(proj + (size_t)row * PT + PC_WL + 4 * lane);
            v2u prv; prv.x = 0u; prv.y = 0u; if (t >= 1) prv = *(const v2u*)(proj + (size_t)(row - 1) * PT + PC_WL + 4 * lane);
            float u[4] = {bflo(cur.x), bfhi(cur.x), bflo(cur.y), bfhi(cur.y)}, up[4] = {bflo(prv.x), bfhi(prv.x), bflo(prv.y), bfhi(prv.y)};
            f32x4 v;
#pragma unroll
            for (int j = 0; j < 4; ++j) { float x = u[j] + (up[j] - u[j]) * mul[j]; if (lane < 16) x = tanhf(x); else if (lane >= 32) x = sigmoidf_(x); v[j] = x; }
            *(LAS f32x4*)(lin + rr * 256 + 4 * lane) = v;
        }
        LDS_WAIT(); asm volatile("" ::: "memory");
        float acc[8][8];
#define LORA_PASS(WPTR, KOFF, KLEN) do { \
        _Pragma("unroll") for (int rr = 0; rr < 8; ++rr) _Pragma("unroll") for (int j = 0; j < 8; ++j) acc[rr][j] = 0.f; \
        for (int k = 0; k < (KLEN); k += 4) { \
            f32x4 wa[4], wb[4]; \
            _Pragma("unroll") for (int q = 0; q < 4; ++q) { wa[q] = *(const f32x4*)((WPTR) + (size_t)(k + q) * BR + c0); wb[q] = *(const f32x4*)((WPTR) + (size_t)(k + q) * BR + c0 + 4); } \
            _Pragma("unroll") for (int rr = 0; rr < 8; ++rr) { const f32x4 in = *(const LAS f32x4*)(lin + rr * 256 + (KOFF) + k); \
                _Pragma("unroll") for (int q = 0; q < 4; ++q) _Pragma("unroll") for (int j = 0; j < 4; ++j) { acc[rr][j] = fmaf(in[q], wa[q][j], acc[rr][j]); acc[rr][4 + j] = fmaf(in[q], wb[q][j], acc[rr][4 + j]); } } \
        } } while (0)
        LORA_PASS(INP(I_DW2) + (size_t)l * 64 * BR, 0, 64);
        unsigned em1p[8][4];
        {
            float w0v[8];
#pragma unroll
            for (int j = 0; j < 8; ++j) w0v[j] = INP(I_DW0)[l * BR + c0 + j];
#pragma unroll
            for (int rr = 0; rr < 8; ++rr) { float o[8];
#pragma unroll
                for (int j = 0; j < 8; ++j) { const float z = -(w0v[j] + acc[rr][j]); const float sp = fmaxf(z, 0.f) + log1pf(expf(-fabsf(z))); o[j] = expm1f(-expf(-sp - 0.5f)); }
#pragma unroll
                for (int q = 0; q < 4; ++q) em1p[rr][q] = pk2(o[2 * q], o[2 * q + 1]); }
        }
        LORA_PASS(INP(I_AW2) + (size_t)l * 64 * BR, 64, 64);
        {
            float a0v[8], kkv[8], kav[8], muk[8];
#pragma unroll
            for (int j = 0; j < 8; ++j) { a0v[j] = INP(I_AA0)[l * BR + c0 + j]; kkv[j] = INP(I_KK)[l * BR + c0 + j]; kav[j] = INP(I_KA)[l * BR + c0 + j]; muk[j] = mu[512 + c0 + j]; }
#pragma unroll
            for (int rr = 0; rr < 8; ++rr) {
                const int row = r0 + rr, t = row % T;
                float kc[8], kp[8];
                unpack8(*(const v4u*)(proj + (size_t)row * PT + PC_RK + c0), kc);
                if (t >= 1) unpack8(*(const v4u*)(proj + (size_t)(row - 1) * PT + PC_RK + c0), kp);
                else {
#pragma unroll
                    for (int j = 0; j < 8; ++j) kp[j] = 0.f; }
                float k2[8], kk[8], bb[8]; float ss = 0.f;
#pragma unroll
                for (int j = 0; j < 8; ++j) { const float km = kc[j] + (kp[j] - kc[j]) * muk[j]; const float a = sigmoidf_(a0v[j] + acc[rr][j]);
                    kk[j] = km * kkv[j]; ss += kk[j] * kk[j]; k2[j] = km * (1.f + (a - 1.f) * kav[j]); bb[j] = a; }
                ss = sum8lanes(ss);
                const float inv = 1.f / fmaxf(sqrtf(ss), 1e-12f);
#pragma unroll
                for (int j = 0; j < 8; ++j) { kk[j] *= inv; bb[j] *= kk[j]; }
                unsigned* ow = (unsigned*)rwx + (size_t)row * 1024 + c0;
                v4u wa0, wa1, wb0, wb1;
                wa0.x = f2bf(k2[0]) | (f2bf(kk[0]) << 16); wa0.y = f2bf(k2[1]) | (f2bf(kk[1]) << 16); wa0.z = f2bf(k2[2]) | (f2bf(kk[2]) << 16); wa0.w = f2bf(k2[3]) | (f2bf(kk[3]) << 16);
                wa1.x = f2bf(k2[4]) | (f2bf(kk[4]) << 16); wa1.y = f2bf(k2[5]) | (f2bf(kk[5]) << 16); wa1.z = f2bf(k2[6]) | (f2bf(kk[6]) << 16); wa1.w = f2bf(k2[7]) | (f2bf(kk[7]) << 16);
                wb0.x = (em1p[rr][0] & 0xffffu) | (f2bf(bb[0]) << 16); wb0.y = (em1p[rr][0] >> 16) | (f2bf(bb[1]) << 16); wb0.z = (em1p[rr][1] & 0xffffu) | (f2bf(bb[2]) << 16); wb0.w = (em1p[rr][1] >> 16) | (f2bf(bb[3]) << 16);
                wb1.x = (em1p[rr][2] & 0xffffu) | (f2bf(bb[4]) << 16); wb1.y = (em1p[rr][2] >> 16) | (f2bf(bb[5]) << 16); wb1.z = (em1p[rr][3] & 0xffffu) | (f2bf(bb[6]) << 16); wb1.w = (em1p[rr][3] >> 16) | (f2bf(bb[7]) << 16);
                *(v4u*)(ow) = wa0; *(v4u*)(ow + 4) = wa1; *(v4u*)(ow + 512) = wb0; *(v4u*)(ow + 516) = wb1;
            }
        }
        LORA_PASS(INP(I_GW2) + (size_t)l * 128 * BR, 128, 128);
#pragma unroll
        for (int rr = 0; rr < 8; ++rr) { float o[8];
#pragma unroll
            for (int j = 0; j < 8; ++j) o[j] = acc[rr][j];
            *(v4u*)(ocat + (size_t)(r0 + rr) * 1536 + 1024 + c0) = pack8(o); }
#undef LORA_PASS
        LDS_WAIT(); asm volatile("" ::: "memory");
    }
}

__device__ __forceinline__ void m2b_attn_naive(LAS unsigned char* lds_, const int wave_s, const bf16* proj, bf16* ocat) {
    const Frame F = make_frame(lds_, wave_s);
    const float* ksum = (const float*)(WSP() + WS_MISC2 + M2_KSUM);
    LAS float* kml = (LAS float*)(F.lds);
    LAS float* gl = (LAS float*)(F.lds + 4096);
    for (int base = F.vcu * 512; base < M * NH; base += F.G * 512) {
        const int idx = base + F.tid;
        const int t = idx % T, h = (idx / T) % NH, b = idx / (T * NH), m = b * T + t, own = t >> 8;
        __syncthreads();
        for (int i = F.tid; i < 16 * 64; i += 512) { const float* km = ksum + ((((size_t)b * NH + h) * 16 + (i >> 6)) * 4) * 64 + (i & 63); kml[i] = (km[0] + km[64]) + (km[128] + km[192]); }
        __syncthreads();
        unsigned qw[32]; float acc[64];
        const bf16* qp = proj + (size_t)m * PT + PC_Q + h * 64;
#pragma unroll
        for (int d8 = 0; d8 < 8; ++d8) { const v4u w = *(const v4u*)(qp + 8 * d8); qw[4 * d8] = w.x; qw[4 * d8 + 1] = w.y; qw[4 * d8 + 2] = w.z; qw[4 * d8 + 3] = w.w;
#pragma unroll
            for (int j = 0; j < 8; ++j) acc[8 * d8 + j] = 0.f; }
#define QF(d) (((d) & 1) ? bfhi(qw[(d) >> 1]) : bflo(qw[(d) >> 1]))
        int mask = 0;
        if (own <= 3) mask = (1 << own) - 1;
        else {
            for (int n = 0; n < own; ++n) { float s = 0.f;
#pragma unroll
                for (int d = 0; d < 64; ++d) s = fmaf(QF(d), kml[n * 64 + d], s);
                gl[F.tid * 17 + n] = s; }
            for (int r = 0; r < 3; ++r) {
                float best = -INFINITY; int bi = -1;
                for (int n = 0; n < own; ++n) { const float g = gl[F.tid * 17 + n]; if (!((mask >> n) & 1) && (bi < 0 || g > best)) { best = g; bi = n; } }
                mask |= (1 << bi);
            }
        }
        float mx = -INFINITY, lsum = 0.f;
        for (int n = 0; n <= own; ++n) {
            const bool isown = (n == own);
            if (!isown && !((mask >> n) & 1)) continue;
            const int kend = isown ? (t & 255) : 255;
            const bf16* kb = proj + ((size_t)(b * T + n * 256)) * PT + PC_K + h * 64;
            for (int kk = 0; kk <= kend; ++kk) {
                const bf16* kr = kb + (size_t)kk * PT; const bf16* vr = kr + (PC_V - PC_K);
                float s = 0.f;
#pragma unroll
                for (int d8 = 0; d8 < 8; ++d8) { float f[8]; unpack8(*(const v4u*)(kr + 8 * d8), f);
#pragma unroll
                    for (int j = 0; j < 8; ++j) s = fmaf(QF(8 * d8 + j), f[j], s); }
                if (s > mx) { const float f = exp2f(mx - s); lsum *= f;
#pragma unroll
                    for (int d = 0; d < 64; ++d) acc[d] *= f;
                    mx = s; }
                const float p = exp2f(s - mx); lsum += p;
#pragma unroll
                for (int d8 = 0; d8 < 8; ++d8) { float f[8]; unpack8(*(const v4u*)(vr + 8 * d8), f);
#pragma unroll
                    for (int j = 0; j < 8; ++j) acc[8 * d8 + j] = fmaf(p, f[j], acc[8 * d8 + j]); }
            }
        }
        const float il = 1.f / lsum;
        bf16* op = ocat + (size_t)m * 1536 + 512 + h * 64;
#pragma unroll
        for (int d8 = 0; d8 < 8; ++d8) { float f[8];
#pragma unroll
            for (int j = 0; j < 8; ++j) f[j] = acc[8 * d8 + j] * il;
            *(v4u*)(op + 8 * d8) = pack8(f); }
#undef QF
    }
}
__device__ __forceinline__ void m2b_scan_naive(LAS unsigned char* lds_, const int wave_s, int l, const bf16* proj, const bf16* rwx, bf16* ysc) {
    const Frame F = make_frame(lds_, wave_s);
    const int NGW = F.G * NWAVES, lane = F.lane;
    const float* mu = INP(I_MU) + l * SHIFT;
    for (int gw = F.vcu * NWAVES + F.wave; gw < NB * NH * 64; gw += NGW) {
        const int i = gw & 63, h = (gw >> 6) & 7, b = gw >> 9, c = h * 64 + lane;
        const float mur = mu[c], muv = mu[1024 + h * 64 + i];
        float S = 0.f, rprev = 0.f, vprev = 0.f;
        for (int t = 0; t < T; ++t) {
            const size_t row = (size_t)b * T + t;
            const float rraw = bf1(proj[row * PT + PC_R + c]), vraw = bf1(proj[row * PT + PC_RV + h * 64 + i]);
            const float r = rraw + (rprev - rraw) * mur, vi = vraw + (vprev - vraw) * muv;
            rprev = rraw; vprev = vraw;
            const unsigned* x = (const unsigned*)rwx + row * 1024 + c;
            const unsigned wa = x[0], wb = x[512];
            const float k2 = bflo(wa), kk = bfhi(wa), em1 = bflo(wb), bb = bfhi(wb);
            const float sa = -wave_sum(S * kk);
            S = (S + S * em1) + sa * bb + vi * k2;
            const float y = wave_sum(S * r);
            if (lane == 0) ysc[row * BR + h * 64 + i] = (bf16)f2bf(y);
        }
    }
}
__device__ __forceinline__ float dpp_f(float x, const int sel) {
    const int v = __builtin_bit_cast(int, x); int r;
    switch (sel) {
      case 1: r = __builtin_amdgcn_update_dpp(0, v, 0x111, 0xF, 0xF, true); break;
      case 2: r = __builtin_amdgcn_update_dpp(0, v, 0x112, 0xF, 0xF, true); break;
      case 3: r = __builtin_amdgcn_update_dpp(0, v, 0x113, 0xF, 0xF, true); break;
      case 4: r = __builtin_amdgcn_update_dpp(0, v, 0x114, 0xF, 0xE, true); break;
      case 8: r = __builtin_amdgcn_update_dpp(0, v, 0x118, 0xF, 0xC, true); break;
      case 15: r = __builtin_amdgcn_update_dpp(0, v, 0x142, 0xA, 0xF, true); break;
      case 31: r = __builtin_amdgcn_update_dpp(0, v, 0x143, 0xC, 0xF, true); break;
      case 100: r = __builtin_amdgcn_update_dpp(0, v, 0xB1, 0xF, 0xF, true); break;
      case 101: r = __builtin_amdgcn_update_dpp(0, v, 0x4E, 0xF, 0xF, true); break;
      case 104: r = __builtin_amdgcn_update_dpp(0, v, 0x124, 0xF, 0xF, true); break;
      default: r = __builtin_amdgcn_update_dpp(0, v, 0x128, 0xF, 0xF, true); break;
    }
    return __builtin_bit_cast(float, r);
}
__device__ __forceinline__ float wsum_to_sgpr(float x) {
    float t = x + dpp_f(x, 1); t = t + dpp_f(x, 2); t = t + dpp_f(x, 3); t = t + dpp_f(t, 4); t = t + dpp_f(t, 8); t = t + dpp_f(t, 15); t = t + dpp_f(t, 31);
    return __builtin_bit_cast(float, __builtin_amdgcn_readlane(__builtin_bit_cast(int, t), 63));
}
struct ScanIn { unsigned r, wa, wb, vv; };
__device__ __forceinline__ void m2b_scan(LAS unsigned char* lds_, const int wave_s, int l, const bf16* __restrict__ proj, const bf16* __restrict__ rwx, bf16* __restrict__ ysc) {
    const Frame F = make_frame(lds_, wave_s);
    const int lane = F.lane;
    const float* mu = INP(I_MU) + l * SHIFT;
    const bool b0 = (lane & 1) != 0, b1 = (lane & 2) != 0;
    for (int gw = F.vcu * NWAVES + F.wave; gw < NB * NH * 64; gw += F.G * NWAVES) {
        const int i = gw & 63, h = (gw >> 6) & 7, b = gw >> 9, c = h * 64 + lane;
        const float mur = mu[c], muv = mu[1024 + h * 64 + i];
        const bf16* pr = proj + (size_t)b * T * PT + PC_R + c;
        const bf16* pv = proj + (size_t)b * T * PT + PC_RV + h * 64 + i;
        const unsigned* px = (const unsigned*)rwx + (size_t)b * T * 1024 + c;
        bf16* py = ysc + (size_t)b * T * BR + h * 64 + i;
        float S = 0.f, rp = 0.f, vp = 0.f;
#define SC_LOAD(X, t_) do { const int tt = (t_) < T ? (t_) : T - 1; X.r = pr[(size_t)tt * PT]; X.vv = pv[(size_t)tt * PT]; X.wa = px[(size_t)tt * 1024]; X.wb = px[(size_t)tt * 1024 + 512]; } while (0)
#define SC_STEP(X, Q) do { \
        const float rr = __uint_as_float(X.r << 16), vr = __uint_as_float(X.vv << 16); \
        const float r_ = rr + (rp - rr) * mur, vi = vr + (vp - vr) * muv; rp = rr; vp = vr; \
        const float k2 = bflo(X.wa), kk = bfhi(X.wa), em1 = bflo(X.wb), bb = bfhi(X.wb); \
        const float ps = wsum_to_sgpr(S * kk); \
        S = __builtin_fmaf(S, em1, S) + __builtin_fmaf(-ps, bb, vi * k2); \
        Q = S * r_; } while (0)
#define SC_YOUT(t0) do { \
        const float z = (b0 ? q1 : q0) + dpp_f(b0 ? q0 : q1, 100); \
        const float w = (b0 ? q3 : q2) + dpp_f(b0 ? q2 : q3, 100); \
        float v_ = (b1 ? w : z) + dpp_f(b1 ? z : w, 101); \
        v_ += dpp_f(v_, 104); v_ += dpp_f(v_, 108); \
        v_ += __shfl_xor(v_, 16); v_ += __shfl_xor(v_, 32); \
        if (lane < 4) py[(size_t)((t0) + lane) * BR] = (bf16)f2bf(v_); } while (0)
        ScanIn a0, a1, a2, a3, e0, e1, e2, e3, g0, g1, g2, g3, h0, h1, h2, h3;
        float q0, q1, q2, q3;
        SC_LOAD(a0, 0); SC_LOAD(a1, 1); SC_LOAD(a2, 2); SC_LOAD(a3, 3);
        SC_LOAD(e0, 4); SC_LOAD(e1, 5); SC_LOAD(e2, 6); SC_LOAD(e3, 7);
        SC_LOAD(g0, 8); SC_LOAD(g1, 9); SC_LOAD(g2, 10); SC_LOAD(g3, 11);
        for (int t = 0; t < T; t += 16) {
            SC_LOAD(h0, t + 12); SC_LOAD(h1, t + 13); SC_LOAD(h2, t + 14); SC_LOAD(h3, t + 15);
            SC_STEP(a0, q0); SC_STEP(a1, q1); SC_STEP(a2, q2); SC_STEP(a3, q3); SC_YOUT(t);
            SC_LOAD(a0, t + 16); SC_LOAD(a1, t + 17); SC_LOAD(a2, t + 18); SC_LOAD(a3, t + 19);
            SC_STEP(e0, q0); SC_STEP(e1, q1); SC_STEP(e2, q2); SC_STEP(e3, q3); SC_YOUT(t + 4);
            SC_LOAD(e0, t + 20); SC_LOAD(e1, t + 21); SC_LOAD(e2, t + 22); SC_LOAD(e3, t + 23);
            SC_STEP(g0, q0); SC_STEP(g1, q1); SC_STEP(g2, q2); SC_STEP(g3, q3); SC_YOUT(t + 8);
            SC_LOAD(g0, t + 24); SC_LOAD(g1, t + 25); SC_LOAD(g2, t + 26); SC_LOAD(g3, t + 27);
            SC_STEP(h0, q0); SC_STEP(h1, q1); SC_STEP(h2, q2); SC_STEP(h3, q3); SC_YOUT(t + 12);
        }
#undef SC_LOAD
#undef SC_STEP
#undef SC_YOUT
    }
}
__device__ __forceinline__ void m2c_rwkv_post(LAS unsigned char* lds_, const int wave_s, int l, const bf16* proj, const bf16* rwx, const bf16* ysc, bf16* ocat) {
    const Frame F = make_frame(lds_, wave_s);
    const int gw = F.vcu * NWAVES + F.wave, NGW = F.G * NWAVES, c0 = 8 * F.lane;
    const float* mu = INP(I_MU) + l * SHIFT;
    float mur[8], muv[8], rk[8], gg[8], gb[8];
#pragma unroll
    for (int j = 0; j < 8; ++j) { mur[j] = mu[c0 + j]; muv[j] = mu[1024 + c0 + j]; rk[j] = INP(I_RK)[l * BR + c0 + j]; gg[j] = INP(I_GNG)[l * BR + c0 + j]; gb[j] = INP(I_GNB)[l * BR + c0 + j]; }
    for (int m = gw; m < M; m += NGW) {
        const int t = m % T;
        float y[8], rc[8], rp[8], vc[8], vp[8], k2[8], g[8];
        unpack8(*(const v4u*)(ysc + (size_t)m * BR + c0), y);
        unpack8(*(const v4u*)(proj + (size_t)m * PT + PC_R + c0), rc); unpack8(*(const v4u*)(proj + (size_t)m * PT + PC_RV + c0), vc);
        if (t >= 1) { unpack8(*(const v4u*)(proj + (size_t)(m - 1) * PT + PC_R + c0), rp); unpack8(*(const v4u*)(proj + (size_t)(m - 1) * PT + PC_RV + c0), vp); }
        else {
#pragma unroll
            for (int j = 0; j < 8; ++j) { rp[j] = 0.f; vp[j] = 0.f; } }
        { const unsigned* wa = (const unsigned*)rwx + (size_t)m * 1024 + c0; const v4u a0 = *(const v4u*)wa, a1 = *(const v4u*)(wa + 4);
          k2[0] = bflo(a0.x); k2[1] = bflo(a0.y); k2[2] = bflo(a0.z); k2[3] = bflo(a0.w); k2[4] = bflo(a1.x); k2[5] = bflo(a1.y); k2[6] = bflo(a1.z); k2[7] = bflo(a1.w); }
        unpack8(*(const v4u*)(ocat + (size_t)m * 1536 + 1024 + c0), g);
        float s = 0.f;
#pragma unroll
        for (int j = 0; j < 8; ++j) s += y[j];
        const float mean = sum8lanes(s) * (1.f / 64.f);
        float q = 0.f, bn = 0.f;
#pragma unroll
        for (int j = 0; j < 8; ++j) { y[j] -= mean; q += y[j] * y[j]; const float r = rc[j] + (rp[j] - rc[j]) * mur[j]; bn += r * k2[j] * rk[j]; }
        const float rstd = rsqrtf(sum8lanes(q) * (1.f / 64.f) + GN_EPS);
        bn = sum8lanes(bn);
        float o[8];
#pragma unroll
        for (int j = 0; j < 8; ++j) { const float v = vc[j] + (vp[j] - vc[j]) * muv[j]; o[j] = (y[j] * rstd * gg[j] + gb[j] + bn * v) * g[j]; }
        *(v4u*)(ocat + (size_t)m * 1536 + 1024 + c0) = pack8(o);
    }
}

template <bool ROUTE, bool WRITE_XB>
__device__ __forceinline__ void ln_pass(LAS unsigned char* lds_, const int wave_s, const float* g, const float* bta, float* xio, bf16* xb, const float* rw, int* cnt, int* asg_e, int* asg_rank, float* asg_gate) {
    const Frame F = make_frame(lds_, wave_s);
    const int gw = F.vcu * NWAVES + F.wave, NGW = F.G * NWAVES, lane = F.lane;
    for (int m = gw; m < M; m += NGW) {
        GAS f32x4* xr = (GAS f32x4*)(xio + (size_t)m * D) + lane;
        f32x4 v[4]; float s = 0.f;
#pragma unroll
        for (int j = 0; j < 4; ++j) { v[j] = xr[64 * j]; s += (v[j].x + v[j].y) + (v[j].z + v[j].w); }
        const float mean = wave_sum(s) * (1.f / D); float s2 = 0.f;
#pragma unroll
        for (int j = 0; j < 4; ++j) { v[j] = v[j] - mean; s2 += (v[j].x * v[j].x + v[j].y * v[j].y) + (v[j].z * v[j].z + v[j].w * v[j].w); }
        const float rstd = 1.f / sqrtf(wave_sum(s2) * (1.f / D) + LN_EPS);
#pragma unroll
        for (int j = 0; j < 4; ++j) { const f32x4 gv = *(const f32x4*)(g + 4 * lane + 256 * j), bv = *(const f32x4*)(bta + 4 * lane + 256 * j); v[j] = v[j] * rstd * gv + bv; xr[64 * j] = v[j]; }
        if (WRITE_XB) { GAS unsigned long long* o8 = (GAS unsigned long long*)(xb + (size_t)m * D) + lane;
#pragma unroll
            for (int j = 0; j < 4; ++j) o8[64 * j] = (unsigned long long)pk2(v[j].x, v[j].y) | ((unsigned long long)pk2(v[j].z, v[j].w) << 32); }
        if (ROUTE) {
            float lg[8];
#pragma unroll
            for (int e = 0; e < 8; ++e) lg[e] = 0.f;
#pragma unroll
            for (int j = 0; j < 4; ++j)
#pragma unroll
                for (int i = 0; i < 4; ++i) { const int d = 4 * lane + 256 * j + i; const f32x4 r0 = *(const f32x4*)(rw + d * NE), r1 = *(const f32x4*)(rw + d * NE + 4); const float xv = v[j][i];
#pragma unroll
                    for (int e = 0; e < 4; ++e) { lg[e] = fmaf(xv, r0[e], lg[e]); lg[4 + e] = fmaf(xv, r1[e], lg[4 + e]); } }
#pragma unroll
            for (int e = 0; e < 8; ++e) lg[e] = wave_sum(lg[e]);
            if (lane == 0) {
                int e1 = 0; float l1 = lg[0];
#pragma unroll
                for (int e = 1; e < 8; ++e) if (lg[e] > l1) { l1 = lg[e]; e1 = e; }
                int e2 = -1; float l2 = -INFINITY;
#pragma unroll
                for (int e = 0; e < 8; ++e) if (e != e1 && (e2 < 0 || lg[e] > l2)) { l2 = lg[e]; e2 = e; }
                const float p2 = expf(l2 - l1); const float g1 = 1.f / (1.f + p2), g2 = p2 / (1.f + p2);
                asg_e[2 * m] = e1; asg_e[2 * m + 1] = e2; asg_gate[2 * m] = g1; asg_gate[2 * m + 1] = g2;
                asg_rank[2 * m] = atomicAdd(&cnt[e1], 1); asg_rank[2 * m + 1] = atomicAdd(&cnt[e2], 1);
            }
        }
    }
}

__device__ __forceinline__ void moe_scatter(LAS unsigned char* lds_, const int wave_s, const int* cnt, const int* asg_e, const int* asg_rank, int* asg_pos, const bf16* xb, bf16* xs, int* tile_e) {
    const Frame F = make_frame(lds_, wave_s);
    const int gw = F.vcu * NWAVES + F.wave, NGW = F.G * NWAVES, lane = F.lane;
    int pstart[NE + 1]; int c[NE];
    { int s = 0;
#pragma unroll
      for (int e = 0; e < NE; ++e) { c[e] = cnt[e]; pstart[e] = s; s += ((c[e] + 255) >> 8) << 8; }
      pstart[NE] = s; }
    if (F.vcu == 0 && F.tid == 0) {
        const int ntiles = pstart[NE] >> 8;
        for (int ti = 0; ti < ntiles; ++ti) { int e = 0;
#pragma unroll
            for (int q = 1; q < NE; ++q) if ((ti << 8) >= pstart[q]) e = q;
            tile_e[ti] = e; }
        tile_e[MOE_MAXT] = ntiles;
    }
    for (int a = gw; a < 2 * M; a += NGW) {
        const int e = asg_e[a]; int ps = 0;
#pragma unroll
        for (int q = 0; q < NE; ++q) if (q == e) ps = pstart[q];
        const int pos = ps + asg_rank[a];
        if (lane == 0) asg_pos[a] = pos;
        const v4u* src = (const v4u*)(xb + (size_t)(a >> 1) * D); v4u* dst = (v4u*)(xs + (size_t)pos * D);
        dst[lane] = src[lane]; dst[64 + lane] = src[64 + lane];
    }
#pragma unroll
    for (int e = 0; e < NE; ++e) {
        const int p0 = pstart[e] + c[e], p1 = pstart[e + 1];
        for (int p = p0 + gw; p < p1; p += NGW) { v4u* dst = (v4u*)(xs + (size_t)p * D); const v4u z = {0u, 0u, 0u, 0u}; dst[lane] = z; dst[64 + lane] = z; }
    }
}
__device__ __forceinline__ void moe_final_ln(LAS unsigned char* lds_, const int wave_s, const float* g, const float* bta, float* xio, const bf16* ybuf, const int* asg_pos, const float* asg_gate) {
    const Frame F = make_frame(lds_, wave_s);
    const int gw = F.vcu * NWAVES + F.wave, NGW = F.G * NWAVES, lane = F.lane;
    for (int m = gw; m < M; m += NGW) {
        GAS f32x4* xr = (GAS f32x4*)(xio + (size_t)m * D) + lane;
        const int p0 = asg_pos[2 * m], p1 = asg_pos[2 * m + 1]; const float g0 = asg_gate[2 * m], g1 = asg_gate[2 * m + 1];
        const v2u* y0 = (const v2u*)(ybuf + (size_t)p0 * D) + lane; const v2u* y1 = (const v2u*)(ybuf + (size_t)p1 * D) + lane;
        f32x4 v[4]; float s = 0.f;
#pragma unroll
        for (int j = 0; j < 4; ++j) { const v2u a = y0[64 * j], b = y1[64 * j]; const f32x4 x = xr[64 * j];
            v[j].x = ALPHA * x.x + g0 * bflo(a.x) + g1 * bflo(b.x); v[j].y = ALPHA * x.y + g0 * bfhi(a.x) + g1 * bfhi(b.x);
            v[j].z = ALPHA * x.z + g0 * bflo(a.y) + g1 * bflo(b.y); v[j].w = ALPHA * x.w + g0 * bfhi(a.y) + g1 * bfhi(b.y);
            s += (v[j].x + v[j].y) + (v[j].z + v[j].w); }
        const float mean = wave_sum(s) * (1.f / D); float s2 = 0.f;
#pragma unroll
        for (int j = 0; j < 4; ++j) { v[j] = v[j] - mean; s2 += (v[j].x * v[j].x + v[j].y * v[j].y) + (v[j].z * v[j].z + v[j].w * v[j].w); }
        const float rstd = 1.f / sqrtf(wave_sum(s2) * (1.f / D) + LN_EPS);
#pragma unroll
        for (int j = 0; j < 4; ++j) { const f32x4 gv = *(const f32x4*)(g + 4 * lane + 256 * j), bv = *(const f32x4*)(bta + 4 * lane + 256 * j); xr[64 * j] = v[j] * rstd * gv + bv; }
    }
}

#define XB ((bf16*)(WSP() + WS_XB))
#define MERGED ((bf16*)(WSP() + WS_MERGED))
#define RWX ((bf16*)(WSP() + WS_RWX))
#define Wb ((bf16*)(WSP() + WS_W))
#define PROJ ((bf16*)(WSP() + WS_PROJ))
#define OCAT ((bf16*)(WSP() + WS_OCAT))
#define YSC ((bf16*)(WSP() + WS_YSC))
#define HBUF ((bf16*)(WSP() + WS_HBUF))
#define MOEW ((bf16*)(WSP() + WS_MOEW))
#define HMOE ((bf16*)(WSP() + WS_HMOE))
#define XS ((bf16*)(WSP() + WS_XS))
#define YBUF ((bf16*)(WSP() + WS_YBUF))
#define CNT ((int*)(WSP() + WS_CTL) + CW_CNT)
#define ASG_E ((int*)(WSP() + WS_MISC + M1_ASG))
#define ASG_RANK (ASG_E + 2 * M)
#define ASG_GATE ((float*)(ASG_E + 4 * M))
#define ASG_POS (ASG_E + 6 * M)
#define TILE_E ((int*)(WSP() + WS_MISC + M1_TILE))
#define GRID_BAR() do { XcdBarrier b_; b_.bar = (unsigned*)(WSP() + WS_CTL) + CW_BAR; b_.x = xb_xcc_id(); b_.st = (volatile LAS unsigned*)(L + MISC_OFF) + 8; xcd_barrier(b_, wave_s == 0 && lane_id() == 0); } while (0)
#define GRIDSZ() ((int)gridDim.x)


#ifndef REP_ATTN
#define REP_ATTN 1
#endif
#ifndef REP_SCAN
#define REP_SCAN 1
#endif
#ifndef REP_PREP
#define REP_PREP 1
#endif
#ifndef REP_CONV
#define REP_CONV 1
#endif
#ifndef REP_P0
#define REP_P0 1
#endif
#ifdef PROBE_MASK
#define STAMP() do { if (blockIdx.x == 0 && wave_s == 0 && lane_id() == 0) { volatile LAS unsigned* ms_ = (volatile LAS unsigned*)(L + MISC_OFF); \
    const unsigned long long t_ = __builtin_amdgcn_s_memrealtime(); const unsigned long long p_ = ((unsigned long long)ms_[17] << 32) | ms_[16]; const unsigned i_ = ms_[20]; \
    if ((PROBE_MASK >> i_) & 1ull) { const unsigned long long s_ = (((unsigned long long)ms_[19] << 32) | ms_[18]) + (t_ - p_); ms_[18] = (unsigned)s_; ms_[19] = (unsigned)(s_ >> 32); } \
    ms_[16] = (unsigned)t_; ms_[17] = (unsigned)(t_ >> 32); ms_[20] = i_ + 1u; } } while (0)
#else
#define STAMP() do {} while (0)
#endif
template <int l> __device__ __forceinline__ void layer_body(LAS unsigned char* const L, const int wave_s) {
    extern __shared__ __attribute__((aligned(16))) unsigned char lds[];

#ifndef NO_G1
        { pg8::Gemm g{XB, Wb + WO_IN + (size_t)l * W_IN_SZ, M, PT, D}; pg8::StaticOrder S; { int bx_ = blockIdx.x, G_ = gridDim.x; asm volatile("" : "+s"(bx_), "+s"(G_)); S.init(M, PT, G_, bx_); }
          pg8::EpiStoreBf16 E{PROJ, PT};
          pg8::gemm_phase<pg8::EpiStoreBf16, pg8::StaticOrder, true, true>(L + RING_OFF, g, S, E, wave_s); }
#endif
        GRID_BAR(); STAMP();
#ifndef NO_ROPE
        m2a_rope(L, wave_s, PROJ);
#endif
#ifndef NO_CONV
        for (int rep_ = 0; rep_ < REP_CONV; ++rep_) m2a_conv(L, wave_s, PROJ, INP(I_CONVW) + l * 3 * BR, OCAT);
#endif
#ifndef NO_PREP
        for (int rep_ = 0; rep_ < REP_PREP; ++rep_) m2a_rwkv_prep(L, wave_s, l, PROJ, RWX, OCAT);
#endif
        GRID_BAR(); STAMP();
#ifdef NAIVE_ATTN
        m2b_attn_naive(L, wave_s, PROJ, OCAT);
#else
        for (int rep_ = 0; rep_ < REP_ATTN; ++rep_)
        { const Frame F = make_frame(L, wave_s);
          attn_body::attn_phase<8>((char*)lds + RING_OFF, PROJ + PC_Q, PROJ + PC_K, PROJ + PC_V, OCAT + 512, (const float*)(WSP() + WS_MISC2 + M2_KSUM), F.vcu, F.G, wave_s); }
#endif
        STAMP();
#ifdef NAIVE_SCAN
        m2b_scan_naive(L, wave_s, l, PROJ, RWX, YSC);
#else
        for (int rep_ = 0; rep_ < REP_SCAN; ++rep_) m2b_scan(L, wave_s, l, PROJ, RWX, YSC);
#endif
        GRID_BAR(); STAMP();
#ifndef NO_POST
        m2c_rwkv_post(L, wave_s, l, PROJ, RWX, YSC, OCAT);
#endif
        GRID_BAR(); STAMP();
#ifndef NO_G2
        { pg8::Gemm g{OCAT, Wb + WO_BR + (size_t)l * W_BR_SZ, M, D, 1536}; pg8::StaticOrder S; { int bx_ = blockIdx.x, G_ = gridDim.x; asm volatile("" : "+s"(bx_), "+s"(G_)); S.init(M, D, G_, bx_); }
          pg8::EpiMerge E{MERGED, D, PROJ + PC_GATE, PT};
          pg8::gemm_phase<pg8::EpiMerge, pg8::StaticOrder, true, true>(L + RING_OFF, g, S, E, wave_s); }
#endif
        GRID_BAR(); STAMP();
#ifndef NO_G3
        { pg8::Gemm g{MERGED, Wb + WO_O + (size_t)l * W_O_SZ, M, D, D}; pg8::StaticOrder S; { int bx_ = blockIdx.x, G_ = gridDim.x; asm volatile("" : "+s"(bx_), "+s"(G_)); S.init(M, D, G_, bx_); }
          pg8::EpiResF32 E{l == 0 ? INP(I_X) : OUTP(), OUTP(), D, ALPHA};
          pg8::gemm_phase<pg8::EpiResF32, pg8::StaticOrder, true, true>(L + RING_OFF, g, S, E, wave_s); }
#endif
#ifndef NO_MOEW
        if (l == 1) moe_weight_prologue(L, wave_s);
#endif
        GRID_BAR(); STAMP();
        if (l == 0) {
            ln_pass<false, true>(L, wave_s, INP(I_LN1G), INP(I_LN1B), OUTP(), XB, nullptr, nullptr, nullptr, nullptr, nullptr);
            GRID_BAR(); STAMP();
#ifndef NO_G4
            { pg8::Gemm g{XB, Wb + WO_GU, M, 2 * DFF, D}; pg8::StaticOrder S; { int bx_ = blockIdx.x, G_ = gridDim.x; asm volatile("" : "+s"(bx_), "+s"(G_)); S.init(M, 2 * DFF, G_, bx_); }
              pg8::EpiSwiGLU E{HBUF, DFF};
              pg8::gemm_phase<pg8::EpiSwiGLU, pg8::StaticOrder, true, true>(L + RING_OFF, g, S, E, wave_s); }
#endif
            GRID_BAR(); STAMP();
#ifndef NO_G5
            { pg8::Gemm g{HBUF, Wb + WO_D, M, D, DFF}; pg8::StaticOrder S; { int bx_ = blockIdx.x, G_ = gridDim.x; asm volatile("" : "+s"(bx_), "+s"(G_)); S.init(M, D, G_, bx_); }
              pg8::EpiResF32 E{OUTP(), OUTP(), D, ALPHA};
              pg8::gemm_phase<pg8::EpiResF32, pg8::StaticOrder, true, true>(L + RING_OFF, g, S, E, wave_s); }
#endif
            GRID_BAR(); STAMP();
            ln_pass<false, true>(L, wave_s, INP(I_LN2G), INP(I_LN2B), OUTP(), XB, nullptr, nullptr, nullptr, nullptr, nullptr);
            GRID_BAR(); STAMP();
        } else {
            ln_pass<true, true>(L, wave_s, INP(I_LN1G) + D, INP(I_LN1B) + D, OUTP(), XB, INP(I_RW), CNT, ASG_E, ASG_RANK, ASG_GATE);
            GRID_BAR(); STAMP();
#ifndef NO_SCAT
            moe_scatter(L, wave_s, CNT, ASG_E, ASG_RANK, ASG_POS, XB, XS, TILE_E);
#endif
            GRID_BAR(); STAMP();
            const int ntiles = __builtin_amdgcn_readfirstlane(TILE_E[MOE_MAXT]);
#ifndef NO_G6
            { pg8::Gemm g{XS, MOEW, ntiles * 256, 2 * DFF, D}; pg8::MoeOrder S; { int bx_ = blockIdx.x, G_ = gridDim.x; asm volatile("" : "+s"(bx_), "+s"(G_)); S.init(ntiles * 256, 2 * DFF, G_, bx_); } S.tile_e = TILE_E; S.estride = MOE_E_SZ * 2;
              pg8::EpiSwiGLU E{HMOE, DFF};
              pg8::gemm_phase<pg8::EpiSwiGLU, pg8::MoeOrder, true, true>(L + RING_OFF, g, S, E, wave_s); }
#endif
            GRID_BAR(); STAMP();
#ifndef NO_G7
            { pg8::Gemm g{HMOE, MOEW + W_GU_SZ, ntiles * 256, D, DFF}; pg8::MoeOrder S; { int bx_ = blockIdx.x, G_ = gridDim.x; asm volatile("" : "+s"(bx_), "+s"(G_)); S.init(ntiles * 256, D, G_, bx_); } S.tile_e = TILE_E; S.estride = MOE_E_SZ * 2;
              pg8::EpiStoreBf16 E{YBUF, D};
              pg8::gemm_phase<pg8::EpiStoreBf16, pg8::MoeOrder, true, true>(L + RING_OFF, g, S, E, wave_s); }
#endif
            GRID_BAR(); STAMP();
            moe_final_ln(L, wave_s, INP(I_LN2G) + D, INP(I_LN2B) + D, OUTP(), YBUF, ASG_POS, ASG_GATE);
        }
    }

struct Args { const float* in[27]; float* out; unsigned char* ws; };
__global__ void __launch_bounds__(NWAVES * 64, 2) mega_fwd(Args args) {
    extern __shared__ __attribute__((aligned(16))) unsigned char lds[];
    LAS unsigned char* const L = (LAS unsigned char*)lds;
    const int wave_s = __builtin_amdgcn_readfirstlane((int)threadIdx.x >> 6);
    for (int u = wave_s * 64 + lane_id(); u < (LDS_BYTES - LDSCTL_OFF) / 4; u += NWAVES * 64) ((LAS unsigned*)(L + LDSCTL_OFF))[u] = 0u;
    __syncthreads();
#ifdef PROBE_MASK
    if (blockIdx.x == 0 && wave_s == 0 && lane_id() == 0) { volatile LAS unsigned* ms_ = (volatile LAS unsigned*)(L + MISC_OFF); const unsigned long long t_ = __builtin_amdgcn_s_memrealtime(); ms_[16] = (unsigned)t_; ms_[17] = (unsigned)(t_ >> 32); }
#endif
    (void)xcd_barrier_post((unsigned*)(WSP() + WS_CTL) + CW_BAR, (volatile LAS unsigned*)(L + MISC_OFF) + 8, wave_s == 0 && lane_id() == 0);

#ifndef NO_P0
    for (int rep_ = 0; rep_ < REP_P0; ++rep_) p0_prologue(L, wave_s);
#endif
    GRID_BAR(); STAMP();
    layer_body<0>(L, wave_s);
    layer_body<1>(L, wave_s);
    if (xb_ld((unsigned*)(WSP() + WS_CTL) + CW_BAR + XB_TMO) != 0u) {
        __syncthreads();
        const float q = __builtin_nanf("");
        for (size_t i = (size_t)blockIdx.x * 512 + wave_s * 64 + lane_id(); i < (size_t)M * D; i += (size_t)GRIDSZ() * 512) OUTP()[i] = q;
    }
}

extern "C" void kernel_launch(void* const* d_in, const int* in_sizes, int n_in, void* d_out, int out_size, void* d_ws, size_t ws_size, hipStream_t stream) {
    static int grid = 0;
    if (grid == 0) {
        int dev = 0, cus = 0;
        if (n_in != 27 || out_size != M * D || ws_size < WS_END) { fprintf(stderr, "kernel_launch: unexpected problem geometry (n_in %d out %d ws %zu)\n", n_in, out_size, ws_size); grid = -1; return; }
        if (hipGetDevice(&dev) != hipSuccess || hipDeviceGetAttribute(&cus, hipDeviceAttributeMultiprocessorCount, dev) != hipSuccess) { grid = -1; return; }
        if (hipFuncSetAttribute((const void*)mega_fwd, hipFuncAttributeMaxDynamicSharedMemorySize, LDS_BYTES) != hipSuccess) { grid = -1; return; }
        grid = cus;
    }
    if (grid < 0) return;
    if (hipMemsetAsync((char*)d_ws + WS_CTL, 0, CTL_ZERO_BYTES, stream) != hipSuccess) return;
    Args a{};
    for (int i = 0; i < 27; ++i) a.in[i] = (const float*)d_in[i];
    a.out = (float*)d_out; a.ws = (unsigned char*)d_ws;
    hipLaunchKernelGGL(mega_fwd, dim3(grid), dim3(NWAVES * 64), LDS_BYTES, stream, a);
}
```

```cpp
#include <hip/hip_runtime.h>
#include <cstdio>
#include <cstdint>
#include <cmath>
namespace pg8 {
#define PG8_LAS __attribute__((address_space(3)))
typedef unsigned short bf16_t;
typedef short bf16x8 __attribute__((ext_vector_type(8)));
typedef float f32x4 __attribute__((ext_vector_type(4)));
typedef unsigned u32x4 __attribute__((ext_vector_type(4)));
constexpr int BM = 256, BK = 64, HALF = 128, HTB = HALF * BK * 2  , STAGE_BYTES = 8 * HTB, NXCD = 8, WGM = 8;

__host__ __device__ __forceinline__ int lds_byte(int r, int c) { const int st = (r >> 4) * 2 + (c >> 5), rr = r & 15, cc = c & 31, ob = rr * 64 + cc * 2; return st * 1024 + (ob ^ (((ob >> 9) & 1) << 5)); }
__host__ __device__ __forceinline__ void stage_rc(int b, int& R, int& C) { const int st = b / 1024, sb = b % 1024, swz = sb ^ (((sb >> 9) & 1) << 5); R = (st >> 1) * 16 + swz / 64; C = (st & 1) * 32 + (swz % 64) / 2; }
__host__ __device__ __forceinline__ int perm32(int rho) { const int n = rho >> 4, i = rho & 15; return 8 * (i >> 2) + 4 * n + (i & 3); }

struct Unit { int pm, pn; };
struct Gemm { const bf16_t* A; const bf16_t* Bt; int M, N, K; };

struct StaticOrder {
    int nM, nN, nwg, G, c;
    __host__ __device__ void init(int M, int N, int G_, int c_) { nM = M / BM; nN = N / BM; nwg = nM * nN; G = G_; c = c_; }
    __host__ __device__ bool next(int i, Unit& u) const {
        const long L = (long)i * G + c; if (L >= nwg) return false;
        int wgid = (int)L; { const int q = nwg / NXCD, r = nwg % NXCD, xcd = wgid % NXCD, off = wgid / NXCD; wgid = (xcd < r ? xcd * (q + 1) : r * (q + 1) + (xcd - r) * q) + off; }
        const int nig = WGM * nN, gid = wgid / nig, fm = gid * WGM, gsz = (nM - fm) < WGM ? (nM - fm) : WGM;
        u.pm = fm + ((wgid % nig) % gsz); u.pn = (wgid % nig) / gsz; return true;
    }
    __device__ __forceinline__ void a_ready(const Unit&) const {}
    __device__ __forceinline__ void done(const Unit&) const {}
    __device__ __forceinline__ size_t boff(const Unit&) const { return 0; }
};

__device__ __forceinline__ unsigned cvt_pk_bf16(float lo, float hi) { unsigned r; asm volatile("v_cvt_pk_bf16_f32 %0, %1, %2" : "=v"(r) : "v"(lo), "v"(hi)); return r; }
__device__ __forceinline__ float bf_lo(unsigned w) { return __uint_as_float(w << 16); }
__device__ __forceinline__ float bf_hi(unsigned w) { return __uint_as_float(w & 0xffff0000u); }
__device__ __forceinline__ float fast_exp(float x) { return __builtin_amdgcn_exp2f(x * 1.4426950408889634f); }
__device__ __forceinline__ float fast_sigmoid(float x) { return __builtin_amdgcn_rcpf(1.0f + fast_exp(-x)); }

struct EpiStoreBf16 {
    static constexpr bool PERM = true, AFTER_DRAIN = false, KHOOK = false;
    bf16_t* O; int ldc;
    __device__ __forceinline__ void khook(f32x4 (&)[2][2][4][2], const Unit&, int, int, int, int, int) const {}
    __device__ __forceinline__ void operator()(const f32x4 (&acc)[2][2][4][2], const Unit& u, int wr, int wc, int fr, int fq) const {
        const int row0 = u.pm * BM + wr * 64 + fr, col0 = u.pn * BM + wc * 32 + 8 * fq;
#pragma unroll
        for (int ai = 0; ai < 2; ++ai)
#pragma unroll
            for (int m = 0; m < 4; ++m) { bf16_t* rowp = O + (size_t)(row0 + ai * HALF + m * 16) * ldc + col0;
#pragma unroll
                for (int bj = 0; bj < 2; ++bj) { const f32x4 v0 = acc[ai][bj][m][0], v1 = acc[ai][bj][m][1];
                    u32x4 w; w.x = cvt_pk_bf16(v0[0], v0[1]); w.y = cvt_pk_bf16(v0[2], v0[3]); w.z = cvt_pk_bf16(v1[0], v1[1]); w.w = cvt_pk_bf16(v1[2], v1[3]);
                    *(u32x4*)(rowp + bj * HALF) = w; } }
    }
};

struct EpiMerge {
    static constexpr bool PERM = true, AFTER_DRAIN = false, KHOOK = true;
    bf16_t* O; int ldc; const bf16_t* gates; int ldg;
    __device__ __forceinline__ void khook(f32x4 (&acc)[2][2][4][2], const Unit& u, int t, int wr, int wc, int fr, int fq) const {
        const int b = (t >> 3) - 1;
        int fr_ = fr, fq_ = fq; asm volatile("" : "+v"(fr_), "+v"(fq_));
        const int row0 = u.pm * BM + wr * 64 + fr_, col0 = u.pn * BM + wc * 32 + 8 * fq_;
#pragma unroll
        for (int ai = 0; ai < 2; ++ai)
#pragma unroll
            for (int m = 0; m < 4; ++m) { const bf16_t* gp = gates + (size_t)(row0 + ai * HALF + m * 16) * ldg + b * 1024 + col0;
#pragma unroll
                for (int bj = 0; bj < 2; ++bj) { const u32x4 ga = *(const u32x4*)(gp + bj * HALF), gb = *(const u32x4*)(gp + bj * HALF + 1024);
                    const unsigned aw[4] = {ga.x, ga.y, ga.z, ga.w}, bw[4] = {gb.x, gb.y, gb.z, gb.w};
#pragma unroll
                    for (int q = 0; q < 4; ++q) {
                        const float r0 = (1.0f + fast_exp(-bf_lo(bw[q]))) * __builtin_amdgcn_rcpf(1.0f + fast_exp(-bf_lo(aw[q])));
                        const float r1 = (1.0f + fast_exp(-bf_hi(bw[q]))) * __builtin_amdgcn_rcpf(1.0f + fast_exp(-bf_hi(aw[q])));
                        acc[ai][bj][m][q >> 1][(q & 1) * 2 + 0] *= r0; acc[ai][bj][m][q >> 1][(q & 1) * 2 + 1] *= r1; }
                    asm volatile("" ::: "memory"); } }
    }
    __device__ __forceinline__ void operator()(const f32x4 (&acc)[2][2][4][2], const Unit& u, int wr, int wc, int fr, int fq) const {
        const int row0 = u.pm * BM + wr * 64 + fr, col0 = u.pn * BM + wc * 32 + 8 * fq;
#pragma unroll
        for (int ai = 0; ai < 2; ++ai)
#pragma unroll
            for (int m = 0; m < 4; ++m) { const size_t r = (size_t)(row0 + ai * HALF + m * 16); const bf16_t* gp = gates + r * ldg + 2 * 1024 + col0; bf16_t* rowp = O + r * ldc + col0;
#pragma unroll
                for (int bj = 0; bj < 2; ++bj) { const u32x4 gc = *(const u32x4*)(gp + bj * HALF); const f32x4 v0 = acc[ai][bj][m][0], v1 = acc[ai][bj][m][1];
                    u32x4 w;
                    w.x = cvt_pk_bf16(v0[0] * fast_sigmoid(bf_lo(gc.x)), v0[1] * fast_sigmoid(bf_hi(gc.x)));
                    w.y = cvt_pk_bf16(v0[2] * fast_sigmoid(bf_lo(gc.y)), v0[3] * fast_sigmoid(bf_hi(gc.y)));
                    w.z = cvt_pk_bf16(v1[0] * fast_sigmoid(bf_lo(gc.z)), v1[1] * fast_sigmoid(bf_hi(gc.z)));
                    w.w = cvt_pk_bf16(v1[2] * fast_sigmoid(bf_lo(gc.w)), v1[3] * fast_sigmoid(bf_hi(gc.w)));
                    *(u32x4*)(rowp + bj * HALF) = w; asm volatile("" ::: "memory"); } }
    }
};

struct EpiSwiGLU {
    static constexpr bool PERM = true, AFTER_DRAIN = false, KHOOK = false;
    bf16_t* O; int ldc;
    __device__ __forceinline__ void khook(f32x4 (&)[2][2][4][2], const Unit&, int, int, int, int, int) const {}
    __device__ __forceinline__ void operator()(const f32x4 (&acc)[2][2][4][2], const Unit& u, int wr, int wc, int fr, int fq) const {
        const int row0 = u.pm * BM + wr * 64 + fr, col0 = u.pn * HALF + wc * 32 + 8 * fq;
#pragma unroll
        for (int ai = 0; ai < 2; ++ai)
#pragma unroll
            for (int m = 0; m < 4; ++m) { bf16_t* rowp = O + (size_t)(row0 + ai * HALF + m * 16) * ldc + col0;
                float h[8];
#pragma unroll
                for (int n = 0; n < 2; ++n)
#pragma unroll
                    for (int i = 0; i < 4; ++i) { const float g = acc[ai][0][m][n][i], up = acc[ai][1][m][n][i]; h[n * 4 + i] = g * fast_sigmoid(g) * up; }
                u32x4 w; w.x = cvt_pk_bf16(h[0], h[1]); w.y = cvt_pk_bf16(h[2], h[3]); w.z = cvt_pk_bf16(h[4], h[5]); w.w = cvt_pk_bf16(h[6], h[7]);
                *(u32x4*)rowp = w; }
    }
};

struct EpiResF32 {
    static constexpr bool PERM = false, AFTER_DRAIN = false, KHOOK = false;
    const float* base; float* out; int ldc; float alpha;
    __device__ __forceinline__ void khook(f32x4 (&)[2][2][4][2], const Unit&, int, int, int, int, int) const {}
    __device__ __forceinline__ void operator()(const f32x4 (&acc)[2][2][4][2], const Unit& u, int wr, int wc, int fr, int fq) const {
        const int row0 = u.pm * BM + wr * 64 + fr, col0 = u.pn * BM + wc * 32 + 4 * fq;
#pragma unroll
        for (int ai = 0; ai < 2; ++ai)
#pragma unroll
            for (int m = 0; m < 4; ++m) { const size_t off = (size_t)(row0 + ai * HALF + m * 16) * ldc + col0;
#pragma unroll
                for (int bj = 0; bj < 2; ++bj)
#pragma unroll
                    for (int n = 0; n < 2; ++n) { const f32x4 bs = *(const f32x4*)(base + off + bj * HALF + n * 16); *(f32x4*)(out + off + bj * HALF + n * 16) = bs * alpha + acc[ai][bj][m][n]; } }
    }
};

struct MoeOrder : StaticOrder {
    const int* tile_e; size_t estride;
    __device__ __forceinline__ size_t boff(const Unit& u) const { return (size_t)__builtin_amdgcn_readfirstlane(tile_e[u.pm]) * estride; }
};

template <class Epi, class Sched, bool ALIGN_EPI = false, bool SP2 = false>
__device__ __forceinline__ void gemm_phase(PG8_LAS unsigned char* lds, const Gemm g, const Sched& S, const Epi& E, const int wave_s) {
    int lane_; asm volatile("v_mbcnt_lo_u32_b32 %0, -1, 0\n\tv_mbcnt_hi_u32_b32 %0, -1, %0" : "=v"(lane_));
    const int tid = wave_s * 64 + lane_, wid = wave_s, lane = tid & 63, wr = wid >> 2, wc = wid & 3, fr = lane & 15, fq = lane >> 4;
    const int K = g.K, nt = K / BK;
    unsigned voffA[2], voffB[2];
#pragma unroll
    for (int i = 0; i < 2; ++i) { int R, C; stage_rc(tid * 16 + i * 8192, R, C); const int Rb = Epi::PERM ? ((R & ~31) + perm32(R & 31)) : R;
        voffA[i] = (unsigned)(R * K + C) * 2u; voffB[i] = (unsigned)(Rb * K + C) * 2u; }
    const size_t kstep = (size_t)(BK * 2);
    const size_t hstep = (size_t)HALF * K * 2;
    const size_t tstep = 2 * hstep;
    const unsigned ldsw = (unsigned)wid * 1024u;
    const int aoff = lds_byte(wr * 64 + fr, fq * 8), boff = lds_byte(wc * 32 + fr, fq * 8);
#define PG8_SA(b, h) (((b) * 2 + (h)) * HTB)
#define PG8_SB(b, h) ((4 + (b) * 2 + (h)) * HTB)
#define PG8_STAGE(bufoff, gbase, voff) do { _Pragma("unroll") for (int _i = 0; _i < 2; ++_i) \
        __builtin_amdgcn_global_load_lds((const unsigned*)((const char*)(gbase) + (voff)[_i]), (PG8_LAS unsigned*)(lds + (bufoff) + ldsw + _i * 8192), 16, 0, 0); } while (0)
#define PG8_LDA(dst, b, h) do { _Pragma("unroll") for (int m = 0; m < 4; ++m) _Pragma("unroll") for (int k = 0; k < 2; ++k) dst[m][k] = *(const PG8_LAS bf16x8*)(lds + PG8_SA(b, h) + aoff + m * 2048 + k * 1024); } while (0)
#define PG8_LDB(dst, b, h) do { _Pragma("unroll") for (int n = 0; n < 2; ++n) _Pragma("unroll") for (int k = 0; k < 2; ++k) dst[n][k] = *(const PG8_LAS bf16x8*)(lds + PG8_SB(b, h) + boff + n * 2048 + k * 1024); } while (0)
#define PG8_MMA(ai, bj, At, Bt) do { __builtin_amdgcn_s_setprio(1); _Pragma("unroll") for (int m = 0; m < 4; ++m) _Pragma("unroll") for (int n = 0; n < 2; ++n) _Pragma("unroll") for (int k = 0; k < 2; ++k) \
        acc[ai][bj][m][n] = __builtin_amdgcn_mfma_f32_16x16x32_bf16(Bt[n][k], At[m][k], acc[ai][bj][m][n], 0, 0, 0); __builtin_amdgcn_s_setprio(0); } while (0)
#define PG8_WAIT_V(n) asm volatile("s_waitcnt vmcnt(" #n ")" ::: "memory")
#define PG8_WAIT_L(n) asm volatile("s_waitcnt lgkmcnt(" #n ")" ::: "memory")
#define PG8_BAR __builtin_amdgcn_s_barrier()
#define PG8_SCHED __builtin_amdgcn_sched_barrier(0)
    Unit cur, nxt; int ui = 0;
    if (!S.next(0, cur)) return;
    f32x4 acc[2][2][4][2];
#pragma unroll
    for (int a = 0; a < 2; ++a)
#pragma unroll
        for (int b = 0; b < 2; ++b)
#pragma unroll
            for (int m = 0; m < 4; ++m)
#pragma unroll
                for (int n = 0; n < 2; ++n) acc[a][b][m][n] = (f32x4){0.f, 0.f, 0.f, 0.f};
    bf16x8 At[4][2], B0[2][2], B1[2][2];
    const char* cA = (const char*)g.A + (size_t)cur.pm * tstep; const char* cB = (const char*)g.Bt + (size_t)cur.pn * tstep + S.boff(cur);
    S.a_ready(cur);
    if constexpr (SP2) {
        PG8_STAGE(PG8_SB(0, 0), cB, voffB); PG8_STAGE(PG8_SB(0, 1), cB + hstep, voffB); PG8_STAGE(PG8_SA(0, 0), cA, voffA); PG8_STAGE(PG8_SA(0, 1), cA + hstep, voffA);
        if (wr == 1) PG8_BAR;
        PG8_WAIT_V(2); PG8_BAR;
        PG8_STAGE(PG8_SB(1, 0), cB + kstep, voffB); PG8_STAGE(PG8_SA(1, 0), cA + kstep, voffA); PG8_STAGE(PG8_SB(1, 1), cB + hstep + kstep, voffB);
        PG8_WAIT_V(6); PG8_BAR;
    } else {
        PG8_STAGE(PG8_SB(0, 0), cB, voffB); PG8_STAGE(PG8_SA(0, 0), cA, voffA); PG8_STAGE(PG8_SB(0, 1), cB + hstep, voffB); PG8_STAGE(PG8_SA(0, 1), cA + hstep, voffA);
        if (wr == 1) PG8_BAR;
        PG8_WAIT_V(4); PG8_BAR;
        PG8_STAGE(PG8_SB(1, 0), cB + kstep, voffB); PG8_STAGE(PG8_SA(1, 0), cA + kstep, voffA); PG8_STAGE(PG8_SB(1, 1), cB + hstep + kstep, voffB);
        PG8_WAIT_V(6); PG8_BAR;
    }
    for (;;) {
        const bool has_next = S.next(ui + 1, nxt);
        const char* nA = has_next ? (const char*)g.A + (size_t)nxt.pm * tstep : cA; const char* nB = has_next ? (const char*)g.Bt + (size_t)nxt.pn * tstep + S.boff(nxt) : cB;
        for (int t = 0; t < nt; t += 2) {
            if constexpr (Epi::KHOOK) { if (t == 8 || t == 16) E.khook(acc, cur, t, wr, wc, fr, fq); }
            const bool last = (t == nt - 2);
            const char* a1 = cA + (size_t)(t + 1) * kstep;
            const char* a2 = last ? nA : cA + (size_t)(t + 2) * kstep; const char* b2 = last ? nB : cB + (size_t)(t + 2) * kstep;
            const char* a3 = a2 + kstep; const char* b3 = b2 + kstep;
            if (last && has_next) S.a_ready(nxt);
            if constexpr (SP2) {
            PG8_LDB(B0, 0, 0); PG8_LDB(B1, 0, 1); PG8_SCHED; PG8_LDA(At, 0, 0); PG8_STAGE(PG8_SA(1, 1), a1 + hstep, voffA);
            PG8_WAIT_V(8); PG8_WAIT_L(0); PG8_BAR; PG8_MMA(0, 0, At, B0); PG8_MMA(0, 1, At, B1); PG8_BAR; PG8_SCHED;
            PG8_LDA(At, 0, 1); PG8_STAGE(PG8_SB(0, 0), b2, voffB); PG8_STAGE(PG8_SB(0, 1), b2 + hstep, voffB); PG8_STAGE(PG8_SA(0, 0), a2, voffA);
            PG8_WAIT_V(8); PG8_WAIT_L(0); PG8_BAR; PG8_MMA(1, 0, At, B0); PG8_MMA(1, 1, At, B1); PG8_BAR; PG8_SCHED;
            PG8_LDB(B0, 1, 0); PG8_LDB(B1, 1, 1); PG8_SCHED; PG8_LDA(At, 1, 0); PG8_STAGE(PG8_SA(0, 1), a2 + hstep, voffA);
            PG8_WAIT_V(8); PG8_WAIT_L(0); PG8_BAR; PG8_MMA(0, 0, At, B0); PG8_MMA(0, 1, At, B1); PG8_BAR; PG8_SCHED;
            PG8_LDA(At, 1, 1); PG8_STAGE(PG8_SB(1, 0), b3, voffB); PG8_STAGE(PG8_SB(1, 1), b3 + hstep, voffB); PG8_STAGE(PG8_SA(1, 0), a3, voffA);
            PG8_WAIT_V(8); PG8_WAIT_L(0); PG8_BAR; PG8_MMA(1, 0, At, B0); PG8_MMA(1, 1, At, B1); PG8_BAR; PG8_SCHED;
            } else {
            PG8_LDB(B0, 0, 0); PG8_SCHED; PG8_LDA(At, 0, 0); PG8_STAGE(PG8_SA(1, 1), a1 + hstep, voffA);
            PG8_WAIT_L(8); PG8_BAR; PG8_WAIT_L(0); PG8_MMA(0, 0, At, B0); PG8_BAR; PG8_SCHED;
            PG8_LDB(B1, 0, 1); PG8_STAGE(PG8_SB(0, 0), b2, voffB);
            PG8_BAR; PG8_WAIT_L(0); PG8_MMA(0, 1, At, B1); PG8_BAR;
            PG8_LDA(At, 0, 1); PG8_STAGE(PG8_SA(0, 0), a2, voffA);
            PG8_BAR; PG8_WAIT_L(0); PG8_MMA(1, 0, At, B0); PG8_BAR; PG8_SCHED;
            PG8_STAGE(PG8_SB(0, 1), b2 + hstep, voffB);
            PG8_WAIT_V(6); PG8_BAR; PG8_MMA(1, 1, At, B1); PG8_BAR;
            PG8_LDB(B0, 1, 0); PG8_SCHED; PG8_LDA(At, 1, 0); PG8_STAGE(PG8_SA(0, 1), a2 + hstep, voffA);
            PG8_WAIT_L(8); PG8_BAR; PG8_WAIT_L(0); PG8_MMA(0, 0, At, B0); PG8_BAR; PG8_SCHED;
            PG8_LDB(B1, 1, 1); PG8_STAGE(PG8_SB(1, 0), b3, voffB);
            PG8_BAR; PG8_WAIT_L(0); PG8_MMA(0, 1, At, B1); PG8_BAR;
            PG8_LDA(At, 1, 1); PG8_STAGE(PG8_SA(1, 0), a3, voffA);
            PG8_BAR; PG8_WAIT_L(0); PG8_MMA(1, 0, At, B0); PG8_BAR; PG8_SCHED;
            PG8_STAGE(PG8_SB(1, 1), b3 + hstep, voffB);
            PG8_WAIT_V(6); PG8_BAR; PG8_MMA(1, 1, At, B1); PG8_BAR;
            }
        }
        if constexpr (ALIGN_EPI) { if (wr == 0) PG8_BAR; }
        if constexpr (!Epi::AFTER_DRAIN) { E(acc, cur, wr, wc, fr, fq); S.done(cur); }
        if (!has_next) break;
#pragma unroll
        for (int a = 0; a < 2; ++a)
#pragma unroll
            for (int b = 0; b < 2; ++b)
#pragma unroll
                for (int m = 0; m < 4; ++m)
#pragma unroll
                    for (int n = 0; n < 2; ++n) acc[a][b][m][n] = (f32x4){0.f, 0.f, 0.f, 0.f};
        cur = nxt; cA = nA; cB = nB; ++ui;
        if constexpr (ALIGN_EPI) { if (wr == 1) PG8_BAR; }
    }
    PG8_WAIT_V(0);
    if constexpr (!ALIGN_EPI) { if (wr == 0) PG8_BAR; }
    PG8_BAR;
    if constexpr (Epi::AFTER_DRAIN) { E.fused(acc, cur, wr, wc, fr, fq, lds, wid, lane); S.done(cur); }
#undef PG8_SA
#undef PG8_SB
#undef PG8_STAGE
#undef PG8_LDA
#undef PG8_LDB
#undef PG8_MMA
#undef PG8_WAIT_V
#undef PG8_WAIT_L
#undef PG8_BAR
#undef PG8_SCHED
}

}

constexpr int NWAVES = 8;
constexpr int D = 1024, NB = 4, T = 4096, M = NB * T, BR = 512, NH = 8, PT = 7936, DFF = 2816, NE = 8, SHIFT = 1792;
constexpr float LN_EPS = 1e-5f, GN_EPS = 64e-5f;
constexpr float ALPHA = 1.41421356237309515f;
constexpr float C2 = 0.125f * 1.4426950408889634f;
constexpr int PC_CH = 0, PC_CB = 512, PC_CC = 1024, PC_Q = 1536, PC_K = 2048, PC_V = 2560, PC_R = 3072, PC_RK = 3584, PC_RV = 4096, PC_WL = 4608, PC_AL = 4672, PC_GL = 4736, PC_GATE = 4864;
constexpr int MOE_MAXT = 136, MOE_ROWS_MAX = MOE_MAXT * 256;

constexpr size_t MiB = 1u << 20;
constexpr size_t WS_CTL = 0, CTL_ZERO_BYTES = 1 * MiB;
constexpr size_t WS_MISC = 1 * MiB;
constexpr size_t WS_XB = 2 * MiB;
constexpr size_t WS_MERGED = 34 * MiB;
constexpr size_t WS_RWX = 2 * MiB;
constexpr size_t WS_W = 66 * MiB;
constexpr size_t WS_PROJ = 124 * MiB;
constexpr size_t WS_OCAT = 372 * MiB;
constexpr size_t WS_YSC = 420 * MiB;
constexpr size_t WS_MISC2 = 436 * MiB;
constexpr size_t WS_HBUF = WS_PROJ;
constexpr size_t WS_MOEW = 124 * MiB;
constexpr size_t WS_HMOE = 256 * MiB;
constexpr size_t WS_XS = 34 * MiB;
constexpr size_t WS_YBUF = 2 * MiB;
constexpr size_t WS_END = 444 * MiB;
constexpr size_t W_IN_SZ = (size_t)PT * D, W_BR_SZ = (size_t)D * 1536, W_O_SZ = (size_t)D * D, W_GU_SZ = (size_t)2 * DFF * D, W_D_SZ = (size_t)D * DFF;
constexpr size_t WO_IN = 0, WO_BR = WO_IN + 2 * W_IN_SZ, WO_O = WO_BR + 2 * W_BR_SZ, WO_GU = WO_O + 2 * W_O_SZ, WO_D = WO_GU + W_GU_SZ, WO_END = WO_D + W_D_SZ;
static_assert(WO_END * 2 <= 58 * MiB, "weights fit");
constexpr size_t MOE_E_SZ = W_GU_SZ + W_D_SZ;
static_assert(WS_MOEW + NE * MOE_E_SZ * 2 <= WS_HMOE, "moe weights fit");
static_assert(WS_HMOE + (size_t)MOE_ROWS_MAX * DFF * 2 <= WS_END, "hmoe fits");
constexpr size_t M2_ROPE = 0;
constexpr size_t M2_KSUM = 1 * MiB;
constexpr size_t M2_GC = 2 * MiB;
constexpr size_t M2_BONUS = 3 * MiB;
constexpr size_t M1_ASG = 0;
constexpr size_t M1_TILE = 768 * 1024;
constexpr int CW_BAR = 4096;
constexpr int CW_CNT = 64;

constexpr int RING_OFF = 0, RING_BYTES = 131072;
constexpr int LDSCTL_OFF = 147456, MISC_OFF = LDSCTL_OFF + 320;
constexpr int LDS_BYTES = 151552;

#define GAS __attribute__((address_space(1)))
#define LAS __attribute__((address_space(3)))
typedef unsigned short bf16;
typedef unsigned v4u __attribute__((ext_vector_type(4)));
typedef unsigned v2u __attribute__((ext_vector_type(2)));
typedef float f32x4 __attribute__((ext_vector_type(4)));
typedef GAS unsigned gu32;
#define RLX_AGENT __ATOMIC_RELAXED, __HIP_MEMORY_SCOPE_AGENT
#define LDS_WAIT() asm volatile("s_waitcnt lgkmcnt(0)" ::: "memory")
typedef float f32x2_c __attribute__((ext_vector_type(2))); typedef __bf16 bf16x2_c __attribute__((ext_vector_type(2)));
__device__ __forceinline__ unsigned pk2(float lo, float hi) { f32x2_c v = {lo, hi}; bf16x2_c b = __builtin_convertvector(v, bf16x2_c); return __builtin_bit_cast(unsigned, b); }
__device__ __forceinline__ unsigned f2bf(float f) { return pk2(f, 0.f) & 0xffffu; }
__device__ __forceinline__ float bflo(unsigned w) { return __uint_as_float(w << 16); }
__device__ __forceinline__ float bfhi(unsigned w) { return __uint_as_float(w & 0xffff0000u); }
__device__ __forceinline__ float bf1(bf16 h) { return __uint_as_float((unsigned)h << 16); }
__device__ __forceinline__ void unpack8(const v4u w, float (&f)[8]) { f[0] = bflo(w.x); f[1] = bfhi(w.x); f[2] = bflo(w.y); f[3] = bfhi(w.y); f[4] = bflo(w.z); f[5] = bfhi(w.z); f[6] = bflo(w.w); f[7] = bfhi(w.w); }
__device__ __forceinline__ v4u pack8(const float (&f)[8]) { v4u w; w.x = pk2(f[0], f[1]); w.y = pk2(f[2], f[3]); w.z = pk2(f[4], f[5]); w.w = pk2(f[6], f[7]); return w; }
__device__ __forceinline__ float wave_sum(float v) {
#pragma unroll
    for (int o = 1; o < 64; o <<= 1) v += __shfl_xor(v, o);
    return v;
}
__device__ __forceinline__ float sum8lanes(float v) { v += __shfl_xor(v, 1); v += __shfl_xor(v, 2); v += __shfl_xor(v, 4); return v; }
__device__ __forceinline__ float sigmoidf_(float x) { return 1.f / (1.f + expf(-x)); }

__device__ __forceinline__ int lane_id() { int r; asm volatile("v_mbcnt_lo_u32_b32 %0, -1, 0\n\tv_mbcnt_hi_u32_b32 %0, -1, %0" : "=v"(r)); return r; }
#define XB_TMO      128
#define XB_XCNT(j)  (256  + 64 * (j))
#define XB_XSUB(j)  (1280 + 64 * (j))
#define XB_XGEN(j)  (2304 + 64 * (j))
#define XB_TOP      3328
#define XB_TOPGEN   3392
#define XCD_BAR_WORDS 3456
#define XB_SPIN_CAP (1u << 18)
__device__ __forceinline__ unsigned xb_ld(unsigned* p)              { return __hip_atomic_load(p, __ATOMIC_RELAXED, __HIP_MEMORY_SCOPE_AGENT); }
__device__ __forceinline__ unsigned xb_add(unsigned* p, unsigned v) { return __hip_atomic_fetch_add(p, v, __ATOMIC_RELAXED, __HIP_MEMORY_SCOPE_AGENT); }
__device__ __forceinline__ unsigned xb_xcc_id() { return (unsigned)__builtin_amdgcn_s_getreg((3 << 11) | 20) & 0xFu; }
#define XB_SPIN(cond, bar) do { unsigned _sp = 0; while (cond) { __builtin_amdgcn_s_sleep(1); \
    if ((++_sp & 255u) == 0u) { if (xb_ld(&(bar)[XB_TMO])) break; if (_sp > XB_SPIN_CAP) { atomicAdd(&(bar)[XB_TMO], 1u); break; } } } } while (0)
struct XcdBarrier { unsigned* bar; unsigned x; volatile LAS unsigned* st; };
__device__ __forceinline__ XcdBarrier xcd_barrier_post(unsigned* bar, volatile LAS unsigned* st, const bool leader) {
    XcdBarrier b; b.bar = bar; b.x = xb_xcc_id(); b.st = st;
    if (leader) (void)xb_add(&bar[XB_XCNT(b.x)], 1u);
    return b;
}
__device__ __forceinline__ void xcd_barrier_complete(unsigned* bar, unsigned x, unsigned& nloc, unsigned& nx) {
    const unsigned G = gridDim.x * gridDim.y * gridDim.z;
    unsigned sum, cnt, mine, sp = 0u;
    for (;;) {
        sum = 0u; cnt = 0u; mine = 0u;
#pragma unroll
        for (unsigned j = 0; j < 16; ++j) { const unsigned c = xb_ld(&bar[XB_XCNT(j)]); sum += c; cnt += (c > 0u) ? 1u : 0u; mine = (j == x) ? c : mine; }
        if (sum == G) break;
        __builtin_amdgcn_s_sleep(1);
        if ((++sp & 255u) == 0u) { if (xb_ld(&bar[XB_TMO])) break; if (sp > XB_SPIN_CAP) { atomicAdd(&bar[XB_TMO], 1u); break; } }
    }
    nloc = mine > 0u ? mine : 1u; nx = cnt > 0u ? cnt : 1u;
}
__device__ __forceinline__ void xcd_barrier(const XcdBarrier& b, const bool leader) {
    asm volatile("s_waitcnt vmcnt(0)" ::: "memory");
    __syncthreads();
    if (leader) {
        unsigned* bar = b.bar;
        __builtin_amdgcn_s_waitcnt(0);
        unsigned nloc = b.st[0], nx = b.st[1];
        if (nloc == 0u) { xcd_barrier_complete(bar, b.x, nloc, nx); b.st[0] = nloc; b.st[1] = nx; }
        const unsigned old = xb_add(&bar[XB_XSUB(b.x)], 1u);
        const unsigned gen = old / nloc;
        if (old + 1u == (gen + 1u) * nloc) {
            __builtin_amdgcn_fence(__ATOMIC_RELEASE, "agent");
            asm volatile("s_waitcnt vmcnt(0)" ::: "memory");
            const unsigned og = xb_add(&bar[XB_TOP], 1u);
            const unsigned tg = og / nx;
            if (og + 1u == (tg + 1u) * nx) xb_add(&bar[XB_TOPGEN], 1u);
            else XB_SPIN(xb_ld(&bar[XB_TOPGEN]) == tg, bar);
            __builtin_amdgcn_fence(__ATOMIC_ACQUIRE, "agent");
            xb_add(&bar[XB_XGEN(b.x)], 1u);
            asm volatile("s_waitcnt vmcnt(0)" ::: "memory");
        } else {
            XB_SPIN(xb_ld(&bar[XB_XGEN(b.x)]) == gen, bar);
            __builtin_amdgcn_fence(__ATOMIC_ACQUIRE, "agent");
            asm volatile("s_waitcnt vmcnt(0)" ::: "memory");
        }
    }
    __syncthreads();
}

struct Frame {
    LAS unsigned char* lds;
    int tid, lane, wave;
    int vcu, G;
};
__device__ __forceinline__ Frame make_frame(LAS unsigned char* lds, const int wave_s) {
    Frame F; F.lds = lds;
    const int t = lane_id(); F.lane = t; F.wave = wave_s; F.tid = wave_s * 64 + t;
    int bx = blockIdx.x, G = gridDim.x; asm volatile("" : "+s"(bx), "+s"(G));
    F.G = G; F.vcu = (G % 8 == 0) ? (bx % 8) * (G / 8) + bx / 8 : bx;
    return F;
}

namespace attn_body {
typedef unsigned short bf16;
using bf16x8=__attribute__((ext_vector_type(8)))short;
using s16x4=__attribute__((ext_vector_type(4)))short;
using f32x16=__attribute__((ext_vector_type(16)))float;
using u32x4=__attribute__((ext_vector_type(4)))unsigned;
constexpr int BATCH=4,NHEAD=8,SEQ=4096,D=64,PQ=7936,PO=1536;
constexpr int NW=8,QBLK=32,QB=QBLK*NW,KVBLK=64,NQB=SEQ/QB;
__device__ __forceinline__ int crow(int r,int hi){return (r&3)+8*(r>>2)+4*hi;}
#define SBAR() __builtin_amdgcn_sched_barrier(0)
__device__ __forceinline__ void cmask(f32x16&p0,f32x16&p1,int jb,int qrel,int hi){
  const float NEG=-INFINITY; int kb=64*jb+4*hi;
  #pragma unroll
  for(int r=0;r<16;++r){int kv=kb+(r&3)+8*(r>>2); if(kv>qrel)p0[r]=NEG; if(kv+32>qrel)p1[r]=NEG;}
}

constexpr int NSLOT=3, SLOTB=8192;
constexpr int LDS_K=0, LDS_V=NSLOT*SLOTB, LDS_WS=2*NSLOT*SLOTB, LDS_OST=LDS_WS+NW*64*4, LDS_KML=LDS_OST+NW*4096, LDS_BYTES=LDS_KML+4096;
constexpr float C2=0.125f*1.4426950408889634f;
__device__ __forceinline__ void glds16(const void*gbase,unsigned voff,unsigned lds_dst){unsigned keep;
  asm volatile("s_mov_b32 %0, m0\n\ts_mov_b32 m0, %2\n\ts_nop 4\n\tglobal_load_lds_dwordx4 %1, %3\n\ts_mov_b32 m0, %0":"=&s"(keep):"v"(voff),"s"(lds_dst),"s"(gbase):"memory");}
__device__ __forceinline__ float max3f(float a,float b,float c){float r;asm("v_max3_f32 %0, %1, %2, %3":"=v"(r):"v"(a),"v"(b),"v"(c));return r;}
__device__ __forceinline__ float max2f(float a,float b){float r;asm("v_max_f32_e32 %0, %1, %2":"=v"(r):"v"(a),"v"(b));return r;}
__device__ __forceinline__ float fadd_s(float a,float b){float r;asm("v_add_f32_e32 %0, %1, %2":"=v"(r):"v"(a),"v"(b));return r;}
__device__ __forceinline__ float fsub_s(float a,float b){float r;asm("v_sub_f32_e32 %0, %1, %2":"=v"(r):"v"(a),"v"(b));return r;}
typedef float f32x2_t __attribute__((ext_vector_type(2))); typedef __bf16 bf16x2_t __attribute__((ext_vector_type(2)));
__device__ __forceinline__ unsigned cvtpk_s(float lo,float hi){f32x2_t v={lo,hi};bf16x2_t b=__builtin_convertvector(v,bf16x2_t);return __builtin_bit_cast(unsigned,b);}
#define WAIT_BAR(N) asm volatile("s_waitcnt vmcnt(" #N ") lgkmcnt(0)\n\ts_barrier":::"memory")

__device__ __forceinline__ void qkt(f32x16&p0,f32x16&p1,const char*Kslot,const bf16x8*qr,int r32,int hi){ const f32x16 negm=f32x16{};
  const char*kb=Kslot+hi*1024+r32*16;
  #pragma unroll
  for(int d0=0;d0<4;++d0){
    const bf16x8 b0=*reinterpret_cast<const bf16x8*>(kb+d0*2048);
    const bf16x8 b1=*reinterpret_cast<const bf16x8*>(kb+d0*2048+512);
    if(d0==0){p0=__builtin_amdgcn_mfma_f32_32x32x16_bf16(b0,qr[0],negm,0,0,0);p1=__builtin_amdgcn_mfma_f32_32x32x16_bf16(b1,qr[0],negm,0,0,0);}
    else{p0=__builtin_amdgcn_mfma_f32_32x32x16_bf16(b0,qr[d0],p0,0,0,0);p1=__builtin_amdgcn_mfma_f32_32x32x16_bf16(b1,qr[d0],p1,0,0,0);}}
}
typedef __attribute__((address_space(3))) const char* lds_cptr;
typedef short v4i16_t __attribute__((ext_vector_type(4)));
__device__ __forceinline__ void kload8(bf16x8*kf,lds_cptr kp){
  kf[0]=*(const __attribute__((address_space(3))) bf16x8*)(kp);      kf[1]=*(const __attribute__((address_space(3))) bf16x8*)(kp+512);
  kf[2]=*(const __attribute__((address_space(3))) bf16x8*)(kp+2048); kf[3]=*(const __attribute__((address_space(3))) bf16x8*)(kp+2560);
  kf[4]=*(const __attribute__((address_space(3))) bf16x8*)(kp+4096); kf[5]=*(const __attribute__((address_space(3))) bf16x8*)(kp+4608);
  kf[6]=*(const __attribute__((address_space(3))) bf16x8*)(kp+6144); kf[7]=*(const __attribute__((address_space(3))) bf16x8*)(kp+6656);
}
__device__ __forceinline__ void kload2(bf16x8*kf,lds_cptr kp,int j){ kf[2*j]=*(const __attribute__((address_space(3))) bf16x8*)(kp+j*2048); kf[2*j+1]=*(const __attribute__((address_space(3))) bf16x8*)(kp+j*2048+512); }
__device__ __forceinline__ s16x4 vtr(lds_cptr p){ return __builtin_bit_cast(s16x4,__builtin_amdgcn_ds_read_tr16_b64_v4i16((__attribute__((address_space(3))) v4i16_t*)p)); }
__device__ __forceinline__ float rowmax(const f32x16&p0,const f32x16&p1){
  float a=max3f(p0[0],p0[1],p1[0]),b=max3f(p0[2],p0[3],p1[1]);a=max3f(a,p1[2],p1[3]);
  #pragma unroll
  for(int r=4;r<16;r+=4){a=max3f(a,p0[r],p0[r+1]);b=max3f(b,p0[r+2],p0[r+3]);a=max3f(a,p1[r],p1[r+1]);b=max3f(b,p1[r+2],p1[r+3]);}
  const float m=max2f(a,b);
  auto rr=__builtin_amdgcn_permlane32_swap(__float_as_uint(m),__float_as_uint(m),false,false);
  return max2f(__uint_as_float(rr[0]),__uint_as_float(rr[1]));
}
__device__ __forceinline__ void pv(f32x16*o,int vb,bf16x8 pa0,bf16x8 pa1,bf16x8 pa2,bf16x8 pa3){
  #pragma unroll
  for(int d0=0;d0<2;++d0){s16x4 lo[4],hi[4];
    #pragma unroll
    for(int ks=0;ks<4;++ks){
      asm volatile("ds_read_b64_tr_b16 %0,%1 offset:%c2":"=&v"(lo[ks]):"v"(vb),"i"(d0*4096+ks*1024):"memory");
      asm volatile("ds_read_b64_tr_b16 %0,%1 offset:%c2":"=&v"(hi[ks]):"v"(vb),"i"(d0*4096+ks*1024+512):"memory");}
    asm volatile("s_waitcnt lgkmcnt(0)":::"memory");SBAR();
    #define PK(k) (bf16x8){lo[k][0],lo[k][1],lo[k][2],lo[k][3],hi[k][0],hi[k][1],hi[k][2],hi[k][3]}
    o[d0]=__builtin_amdgcn_mfma_f32_32x32x16_bf16(pa0,PK(0),o[d0],0,0,0);
    o[d0]=__builtin_amdgcn_mfma_f32_32x32x16_bf16(pa1,PK(1),o[d0],0,0,0);
    o[d0]=__builtin_amdgcn_mfma_f32_32x32x16_bf16(pa2,PK(2),o[d0],0,0,0);
    o[d0]=__builtin_amdgcn_mfma_f32_32x32x16_bf16(pa3,PK(3),o[d0],0,0,0);
    #undef PK
  }
}

#ifndef ATTN_STORE16
#define ATTN_STORE16(p,v) (*(u32x4*)(p)=(v))
#endif
template<int THRL> __device__ __forceinline__ void attn_unit(int b,int h,int qb,const bf16*Q,const bf16*__restrict__ K,const bf16*__restrict__ V,bf16*O,const float*__restrict__ ksum,char*shm,const int wave_s){
  int lane; asm volatile("v_mbcnt_lo_u32_b32 %0, -1, 0\n\tv_mbcnt_hi_u32_b32 %0, -1, %0" : "=v"(lane)); const int wid=wave_s,tid=wid*64+lane,r32=lane&31,hi=lane>>5;
  const long rowbase=(long)b*SEQ; const int q0=qb*QB;
  const bf16*Qw=Q+(rowbase+q0+wid*QBLK)*PQ+h*D;
  const bf16*Kh=K+rowbase*PQ+h*D,*Vh=V+rowbase*PQ+h*D;
  const unsigned lds0=(unsigned)(uintptr_t)shm;
  float*wsf=(float*)(shm+LDS_WS)+wid*64;
  const unsigned kvo=(unsigned)(lane*PQ+wid*8)*2u;
  const unsigned vvo=(unsigned)((16*(wid&3)+(lane>>2))*PQ+(wid>>2)*32+(lane&3)*8)*2u;
  const unsigned kdst=lds0+LDS_K+wid*1024, vdst=lds0+LDS_V+wid*1024;
  #define DMA_K(t,slot) glds16(Kh+(long)(t)*KVBLK*PQ,kvo,(unsigned)__builtin_amdgcn_readfirstlane(kdst+(slot)))
  #define DMA_V(t,slot) glds16(Vh+(long)(t)*KVBLK*PQ,vvo,(unsigned)__builtin_amdgcn_readfirstlane(vdst+(slot)))
  const int vb0=(int)(lds0+LDS_V)+((lane>>4)&1)*32+(lane&3)*8+(4*hi+((lane&15)>>2))*64;
  const char*Kbase=shm+LDS_K; bf16x8 kf[8];
  const lds_cptr shm3=(lds_cptr)shm; const lds_cptr kp0=shm3+LDS_K+hi*1024+r32*16; const lds_cptr vp0=shm3+LDS_V+((lane>>4)&1)*32+(lane&3)*8+(4*hi+((lane&15)>>2))*64;
  const int NT=(q0+QB)/KVBLK;
  { float*kml=(float*)(shm+LDS_KML); const float*ks=ksum+(size_t)(b*NHEAD+h)*16*4*64;
    _Pragma("unroll") for(int i=0;i<2;++i){const int e=tid+512*i; const float*kp=ks+(size_t)(e>>6)*256+(e&63); kml[e]=((kp[0]+kp[64])+(kp[128]+kp[192]))*(1.0f/256.0f);} }
  DMA_K(0,0);DMA_V(0,0);DMA_K(1,SLOTB);
  bf16x8 qr[4];
  #pragma unroll
  for(int d0=0;d0<4;++d0)qr[d0]=*reinterpret_cast<const bf16x8*>(&Qw[(long)r32*PQ+d0*16+hi*8]);
  float mhat=0.f,l_reg=0.f;f32x16 o[2];o[0]=f32x16{};o[1]=f32x16{};
  const int qrel=wid*QBLK+r32;
  #define CMASK(P0,P1,t) do{int jb_=(t)-(NT-4); if(jb_>=0)cmask(P0,P1,jb_,qrel,hi);}while(0)
  bool resc=false;
  #define START(P0,P1) do{ const float rm=rowmax(P0,P1); resc=false; \
    { const float dl=(rm==-INFINITY)?0.f:rm; mhat=fadd_s(mhat,dl);     \
      _Pragma("unroll") for(int r=0;r<16;++r){P0[r]=fsub_s(P0[r],dl);P1[r]=fsub_s(P1[r],dl);} \
      } \
    _Pragma("unroll") for(int r=0;r<16;++r)P0[r]=__builtin_amdgcn_exp2f(P0[r]); }while(0)
  #define RESC() do{ if(resc){ asm volatile("s_waitcnt lgkmcnt(0)":::"memory"); \
      _Pragma("unroll") for(int d_=0;d_<2;++d_) _Pragma("unroll") for(int r=0;r<16;++r)o[d_][r]*=wsf[crow(r,hi)]; } }while(0)
  f32x16 pA0,pA1,pB0,pB1;
  int sl_prev=0,sl_cur=0,sl_next=SLOTB;
  #define ROT() do{sl_prev=sl_cur;sl_cur=sl_next;sl_next=(sl_next==(NSLOT-1)*SLOTB)?0:sl_next+SLOTB;}while(0)
  DMA_K(2,2*SLOTB);
  WAIT_BAR(3);
  unsigned selmask=(qb<=3)?((1u<<qb)-1u):0u;
  if(qb>3){ const float*kml=(const float*)(shm+LDS_KML); float v0=-INFINITY,v1=-INFINITY,v2=-INFINITY; int i0=0,i1=0,i2=0;
    for(int n=0;n<qb;++n){ float g=0.f;
      _Pragma("unroll") for(int d0=0;d0<4;++d0){ const float*kr=kml+n*64+d0*16+hi*8;
        _Pragma("unroll") for(int j=0;j<8;++j) g=__builtin_fmaf(__uint_as_float(((unsigned)(unsigned short)qr[d0][j])<<16),kr[j],g); }
      g+=__shfl_xor(g,32);
      if(g>v0){v2=v1;i2=i1;v1=v0;i1=i0;v0=g;i0=n;} else if(g>v1){v2=v1;i2=i1;v1=g;i1=n;} else if(g>v2){v2=g;i2=n;} }
    selmask=(1u<<i0)|(1u<<i1)|(1u<<i2); }
  #define SUBREF(t) ((((t)<NT-4)&&!((selmask>>((t)>>2))&1u))?INFINITY:mhat)
  #define BMASK(P0,P1,t) do{ if(!((selmask>>((t)>>2))&1u)){ _Pragma("unroll") for(int r=0;r<16;++r){P0[r]=-INFINITY;P1[r]=-INFINITY;} } }while(0)
  qkt(pA0,pA1,Kbase,qr,r32,hi);asm volatile("s_nop 15\n\ts_nop 7":"+v"(pA0),"+v"(pA1));CMASK(pA0,pA1,0); if(NT>4)BMASK(pA0,pA1,0);
  START(pA0,pA1);
  _Pragma("unroll") for(int r=0;r<16;++r)pA1[r]=__builtin_amdgcn_exp2f(pA1[r]);
  WAIT_BAR(0);
  DMA_K(3,0);DMA_V(1,SLOTB);
  ROT();
  kload8(kf,kp0+sl_cur);
  WAIT_BAR(2);
  s16x4 vlo[8],vhi[8]; u32x4 pw0,pw1,pw2,pw3;
  #define PKW(P,B) cvtpk_s(P[B],P[B+1])
  #define PAF(k) __builtin_bit_cast(bf16x8,pw##k)
  #define VFR(i) (bf16x8){vlo[i][0],vlo[i][1],vlo[i][2],vlo[i][3],vhi[i][0],vhi[i][1],vhi[i][2],vhi[i][3]}
  #define PIN(x) asm volatile("":"+v"(x))
  #define MX3(a,b,c) __builtin_fmaxf(__builtin_fmaxf((a),(b)),(c))
  #define GAPA(MF,A0,A1,A2,A3,W0,W1,PW) do{ MF; sacc+=A0; sacc+=A1; sacc+=A2; sacc+=A3; PIN(sacc); W0; W1; PIN(PW); SBAR(); }while(0)
  #define EX(v) __builtin_amdgcn_exp2f(v)
  #define GAPB(MF,X,B) do{ MF; X[B]=EX(X[B]); X[B+1]=EX(X[B+1]); X[B+2]=EX(X[B+2]); X[B+3]=EX(X[B+3]); PIN(X); SBAR(); }while(0)
  #define VRD(i) do{ vlo[i]=vtr(vp_+(((i)>>2)*4096+((i)&3)*1024)); vhi[i]=vtr(vp_+(((i)>>2)*4096+((i)&3)*1024+512)); }while(0)
  #define KRD(G,j) do{ if(G){ kload2(kf,kp0+sl_next,j); SBAR(); } }while(0)
  #define STEP(C0,C1,P0,P1,t,GK,GV,GL) do{ SBAR(); \
    const lds_cptr vp_=vp0+sl_prev; \
    VRD(0); SBAR(); float sacc=(P0[0]+P0[1]); \
    GAPA(C0=__builtin_amdgcn_mfma_f32_32x32x16_bf16(kf[0],qr[0],f32x16{},0,0,0), P0[2],P0[3],P0[4],P0[5],     pw0[0]=PKW(P0,0), pw0[1]=PKW(P0,2), pw0); \
    VRD(4); SBAR(); GAPA(C1=__builtin_amdgcn_mfma_f32_32x32x16_bf16(kf[1],qr[0],f32x16{},0,0,0), P0[6],P0[7],P0[8],P0[9],     pw0[2]=PKW(P0,4), pw0[3]=PKW(P0,6), pw0); \
    VRD(1); SBAR(); GAPA(C0=__builtin_amdgcn_mfma_f32_32x32x16_bf16(kf[2],qr[1],C0,0,0,0),   P0[10],P0[11],P0[12],P0[13], pw1[0]=PKW(P0,8), pw1[1]=PKW(P0,10), pw1); \
    VRD(5); SBAR(); GAPA(C1=__builtin_amdgcn_mfma_f32_32x32x16_bf16(kf[3],qr[1],C1,0,0,0),   P0[14],P0[15],P1[0],P1[1],   pw1[2]=PKW(P0,12),pw1[3]=PKW(P0,14), pw1); \
    VRD(2); SBAR(); GAPA(C0=__builtin_amdgcn_mfma_f32_32x32x16_bf16(kf[4],qr[2],C0,0,0,0),   P1[2],P1[3],P1[4],P1[5],     pw2[0]=PKW(P1,0), pw2[1]=PKW(P1,2), pw2); \
    VRD(6); SBAR(); GAPA(C1=__builtin_amdgcn_mfma_f32_32x32x16_bf16(kf[5],qr[2],C1,0,0,0),   P1[6],P1[7],P1[8],P1[9],     pw2[2]=PKW(P1,4), pw2[3]=PKW(P1,6), pw2); \
    VRD(3); SBAR(); GAPA(C0=__builtin_amdgcn_mfma_f32_32x32x16_bf16(kf[6],qr[3],C0,0,0,0),   P1[10],P1[11],P1[12],P1[13], pw3[0]=PKW(P1,8), pw3[1]=PKW(P1,10), pw3); \
    VRD(7); SBAR(); GAPA(C1=__builtin_amdgcn_mfma_f32_32x32x16_bf16(kf[7],qr[3],C1,0,0,0),   P1[14],P1[15],0.f,0.f,       pw3[2]=PKW(P1,12),pw3[3]=PKW(P1,14), pw3); \
    l_reg+=sacc; \
    if(GK){DMA_K((t)+3,sl_cur);} if(GV){DMA_V((t)+1,sl_next);} \
    { const float sub_=SUBREF(t); _Pragma("unroll") for(int r=0;r<16;++r){C0[r]-=sub_;C1[r]-=sub_;} } \
    CMASK(C0,C1,t); \
    { float a=MX3(C0[0],C0[1],C1[0]),b=MX3(C0[2],C0[3],C1[1]); a=MX3(a,C1[2],C1[3]); \
      _Pragma("unroll") for(int r=4;r<16;r+=4){a=MX3(a,C0[r],C0[r+1]);b=MX3(b,C0[r+2],C0[r+3]);a=MX3(a,C1[r],C1[r+1]);b=MX3(b,C1[r+2],C1[r+3]);} \
      float rm=__builtin_fmaxf(a,b); { auto rr=__builtin_amdgcn_permlane32_swap(__float_as_uint(rm),__float_as_uint(rm),false,false); rm=__builtin_fmaxf(__uint_as_float(rr[0]),__uint_as_float(rr[1])); } \
      resc=false; \
      if(__builtin_expect(__any(rm>(float)THRL),0)){ const float dl=__builtin_fmaxf(rm,0.f); mhat+=dl; \
        _Pragma("unroll") for(int r=0;r<16;++r){C0[r]-=dl;C1[r]-=dl;} \
        const float f=__builtin_amdgcn_exp2f(-dl); l_reg*=f; if(hi==0)wsf[r32]=f; resc=true; } } \
    SBAR(); \
    GAPB(o[0]=__builtin_amdgcn_mfma_f32_32x32x16_bf16(PAF(0),VFR(0),o[0],0,0,0), C0,0); \
    GAPB(o[1]=__builtin_amdgcn_mfma_f32_32x32x16_bf16(PAF(0),VFR(4),o[1],0,0,0), C0,4); \
    KRD(GL,0); GAPB(o[0]=__builtin_amdgcn_mfma_f32_32x32x16_bf16(PAF(1),VFR(1),o[0],0,0,0), C0,8); \
    KRD(GL,1); GAPB(o[1]=__builtin_amdgcn_mfma_f32_32x32x16_bf16(PAF(1),VFR(5),o[1],0,0,0), C0,12); \
    KRD(GL,2); GAPB(o[0]=__builtin_amdgcn_mfma_f32_32x32x16_bf16(PAF(2),VFR(2),o[0],0,0,0), C1,0); \
    KRD(GL,3); GAPB(o[1]=__builtin_amdgcn_mfma_f32_32x32x16_bf16(PAF(2),VFR(6),o[1],0,0,0), C1,4); \
    GAPB(o[0]=__builtin_amdgcn_mfma_f32_32x32x16_bf16(PAF(3),VFR(3),o[0],0,0,0), C1,8); \
    GAPB(o[1]=__builtin_amdgcn_mfma_f32_32x32x16_bf16(PAF(3),VFR(7),o[1],0,0,0), C1,12); \
    }while(0)
  int t=1;
  #undef CMASK
  #define CMASK(P0,P1,t) do{}while(0)
  for(;t+5<NT;t+=2){
    STEP(pB0,pB1,pA0,pA1,t,true,true,true);     WAIT_BAR(2); RESC(); ROT();
    STEP(pA0,pA1,pB0,pB1,t+1,true,true,true);   WAIT_BAR(2); RESC(); ROT();
  }
  #undef CMASK
  #define CMASK(P0,P1,t) do{int jb_=(t)-(NT-4); if(jb_>=0)cmask(P0,P1,jb_,qrel,hi);}while(0)
  #define ENDW(tt) do{ if((tt)+3<NT){WAIT_BAR(2);} else if((tt)+2<NT){WAIT_BAR(1);} else {WAIT_BAR(0);} }while(0)
  for(;t+1<NT;t+=2){
    STEP(pB0,pB1,pA0,pA1,t,(t+3<NT),(t+1<NT),(t+1<NT));       ENDW(t);   RESC(); ROT();
    STEP(pA0,pA1,pB0,pB1,t+1,(t+4<NT),(t+2<NT),(t+2<NT));     ENDW(t+1); RESC(); ROT();
  }
  STEP(pB0,pB1,pA0,pA1,NT-1,false,false,false); RESC();
  { float sacc=pB0[0]+pB0[1]; _Pragma("unroll") for(int r=2;r<16;++r)sacc+=pB0[r]; _Pragma("unroll") for(int r=0;r<16;++r)sacc+=pB1[r]; l_reg+=sacc;
    pw0=(u32x4){PKW(pB0,0),PKW(pB0,2),PKW(pB0,4),PKW(pB0,6)};pw1=(u32x4){PKW(pB0,8),PKW(pB0,10),PKW(pB0,12),PKW(pB0,14)};pw2=(u32x4){PKW(pB1,0),PKW(pB1,2),PKW(pB1,4),PKW(pB1,6)};pw3=(u32x4){PKW(pB1,8),PKW(pB1,10),PKW(pB1,12),PKW(pB1,14)};
    SBAR(); pv(o,vb0+sl_cur,PAF(0),PAF(1),PAF(2),PAF(3)); }
  #undef PKW
  #undef PAF
  #undef VFR
  #undef PIN
  #undef MX3
  #undef GAPA
  #undef GAPB
  #undef EX
  #undef VRD
  #undef KRD
  #undef STEP
  #undef ENDW
  {auto rr=__builtin_amdgcn_permlane32_swap(__float_as_uint(l_reg),__float_as_uint(l_reg),false,false);l_reg=__uint_as_float(rr[0])+__uint_as_float(rr[1]);}
  if(hi==0)wsf[32+r32]=l_reg;asm volatile("s_waitcnt lgkmcnt(0)":::"memory");
  float rli[16];
  #pragma unroll
  for(int r=0;r<16;++r)rli[r]=__builtin_amdgcn_rcpf(wsf[32+crow(r,hi)]);
  bf16*Ow=O+(rowbase+q0+wid*QBLK)*PO+h*D;
  { bf16*stg=(bf16*)(shm+LDS_OST)+wid*2048;
    #pragma unroll
    for(int r=0;r<16;++r){const int orow=crow(r,hi);
      #pragma unroll
      for(int d0=0;d0<2;++d0)stg[orow*64+d0*32+r32]=(bf16)(cvtpk_s(o[d0][r]*rli[r],0.f)&0xffffu);}
    asm volatile("s_waitcnt lgkmcnt(0)":::"memory");
    #pragma unroll
    for(int i=0;i<4;++i){const int row=i*8+(lane>>3),ch=lane&7; const u32x4 v=*(const u32x4*)(stg+row*64+ch*8); ATTN_STORE16(Ow+(long)row*PO+ch*8,v);} }
  asm volatile("s_waitcnt lgkmcnt(0)\n\ts_barrier":::"memory");
  #undef DMA_K
  #undef DMA_V
  #undef BMASK
  #undef SUBREF
  #undef CMASK
  #undef START
  #undef RESC
  #undef ROT
}
constexpr int ATTN_LDS_BYTES=LDS_BYTES;
template<int THRL=8> __device__ __forceinline__ void attn_phase(char*lds,const bf16*Q,const bf16*K,const bf16*V,bf16*O,const float*ksum,int vcu,int G,const int wave_s){
  for(int p=vcu;p<BATCH*NHEAD*8;p+=G){ const int bh=p>>3,sq=p&7;
    attn_unit<THRL>(bh/NHEAD,bh%NHEAD,sq,Q,K,V,O,ksum,lds,wave_s);
    attn_unit<THRL>(bh/NHEAD,bh%NHEAD,15-sq,Q,K,V,O,ksum,lds,wave_s); }
}
#undef SBAR
#undef WAIT_BAR
}

__device__ __forceinline__ int opq(int x) { asm volatile("" : "+v"(x)); return x; }
__device__ __forceinline__ void p0_transpose_item(const float* W, int ldw, int K, int N, bf16* WT, int row_off, int mode, LAS float* scr_, int item, int lane) {
    LAS unsigned* scr = (LAS unsigned*)scr_;
    const int nblk = N / 64, kb = item / nblk, nb = item % nblk, k0 = 64 * kb, n0 = 64 * nb;
    const int n4 = (lane & 15) * 4, kq = lane >> 4;
#pragma unroll
    for (int i = 0; i < 8; ++i) { const int kk = 8 * i + 2 * kq;
        const f32x4 a = *(const f32x4*)(W + (size_t)(k0 + kk) * ldw + n0 + n4), b = *(const f32x4*)(W + (size_t)(k0 + kk + 1) * ldw + n0 + n4);
        scr[(n4 + 0) * 36 + (kk >> 1)] = pk2(a.x, b.x); scr[(n4 + 1) * 36 + (kk >> 1)] = pk2(a.y, b.y); scr[(n4 + 2) * 36 + (kk >> 1)] = pk2(a.z, b.z); scr[(n4 + 3) * 36 + (kk >> 1)] = pk2(a.w, b.w); }
    LDS_WAIT(); asm volatile("" ::: "memory");
    const int c = lane & 7;
    const int obase = mode ? (256 * (n0 >> 7) + (n0 & 127) + row_off) : (row_off + n0);
#pragma unroll
    for (int j = 0; j < 8; ++j) { const int n = (lane >> 3) + 8 * j;
        const v4u o = *(const LAS v4u*)(scr + n * 36 + 4 * c);
        *(GAS v4u*)(WT + (size_t)(obase + n) * K + k0 + 8 * c) = o; }
    LDS_WAIT(); asm volatile("" ::: "memory");
}

typedef __attribute__((address_space(4))) const unsigned long long* kargp_t;
__device__ __forceinline__ unsigned long long karg_u64(int idx) { kargp_t kp = (kargp_t)__builtin_amdgcn_kernarg_segment_ptr(); asm volatile("" : "+s"(kp)); return kp[idx]; }
#define INP(k) ((const float*)karg_u64(k))
#define OUTP() ((float*)karg_u64(27))
#define WSP() ((unsigned char*)karg_u64(28))
enum { I_X = 0, I_WIN, I_CONVW, I_MU, I_DW0, I_DW2, I_AA0, I_AW2, I_GW2, I_KK, I_KA, I_RK, I_GNG, I_GNB, I_WBR, I_WOUT, I_LN1G, I_LN1B, I_LN2G, I_LN2B, I_FWG, I_FWU, I_FWD, I_RW, I_MWG, I_MWU, I_MWD };

__device__ __forceinline__ void p0_prologue(LAS unsigned char* lds_, const int wave_s) {
    const Frame F = make_frame(lds_, wave_s);
    LAS float* scr = (LAS float*)(F.lds + RING_OFF + F.wave * 16384);
    const int gw = F.vcu * NWAVES + F.wave, NGW = F.G * NWAVES;
    bf16* Wb = (bf16*)(WSP() + WS_W);
    constexpr int I_IN = 16 * 124, I_BR = 24 * 16, I_O = 16 * 16, I_G = 16 * 44, I_D = 44 * 16;
    constexpr int I_LAYER = I_IN + I_BR + I_O;
    constexpr int NITEMS = 2 * I_LAYER + 2 * I_G + I_D;
    for (int it = gw; it < NITEMS; it += NGW) {
        int r = it;
        if (r < 2 * I_LAYER) { const int l = r / I_LAYER; r -= l * I_LAYER;
            if (r < I_IN) { p0_transpose_item(INP(I_WIN) + (size_t)l * D * PT, PT, D, PT, Wb + WO_IN + l * W_IN_SZ, 0, 0, scr, r, F.lane); continue; } r -= I_IN;
            if (r < I_BR) { p0_transpose_item(INP(I_WBR) + (size_t)l * 1536 * D, D, 1536, D, Wb + WO_BR + l * W_BR_SZ, 0, 0, scr, r, F.lane); continue; } r -= I_BR;
            p0_transpose_item(INP(I_WOUT) + (size_t)l * D * D, D, D, D, Wb + WO_O + l * W_O_SZ, 0, 0, scr, r, F.lane); continue; }
        r -= 2 * I_LAYER;
        if (r < I_G) { p0_transpose_item(INP(I_FWG), DFF, D, DFF, Wb + WO_GU, 0, 1, scr, r, F.lane); continue; } r -= I_G;
        if (r < I_G) { p0_transpose_item(INP(I_FWU), DFF, D, DFF, Wb + WO_GU, 128, 1, scr, r, F.lane); continue; } r -= I_G;
        p0_transpose_item(INP(I_FWD), D, DFF, D, Wb + WO_D, 0, 0, scr, r, F.lane);
    }
    bf16* XB = (bf16*)(WSP() + WS_XB);
    for (int m = gw; m < M; m += NGW) {
        const GAS f32x4* xr = (const GAS f32x4*)(INP(I_X) + (size_t)m * D) + F.lane;
        GAS unsigned long long* o8 = (GAS unsigned long long*)(XB + (size_t)m * D) + F.lane;
#pragma unroll
        for (int j = 0; j < 4; ++j) { const f32x4 v = xr[64 * j]; o8[64 * j] = (unsigned long long)pk2(v.x, v.y) | ((unsigned long long)pk2(v.z, v.w) << 32); }
    }
    float* rc = (float*)(WSP() + WS_MISC2 + M2_ROPE); float* rs = rc + T * 32;
    for (int i = F.vcu * 512 + F.tid; i < T * 32; i += F.G * 512) {
        const int t = i >> 5, d = i & 31;
        const float inv = powf(10000.0f, -(float)d / 32.0f); const float ang = (float)t * inv;
        float s, c; sincosf(ang, &s, &c); rc[i] = c; rs[i] = s;
    }
}
__device__ __forceinline__ void moe_weight_prologue(LAS unsigned char* lds_, const int wave_s) {
    const Frame F = make_frame(lds_, wave_s);
    LAS float* scr = (LAS float*)(F.lds + RING_OFF + F.wave * 16384);
    const int gw = F.vcu * NWAVES + F.wave, NGW = F.G * NWAVES;
    bf16* Wm = (bf16*)(WSP() + WS_MOEW);
    constexpr int I_G = 16 * 44, I_D = 44 * 16, I_E = 2 * I_G + I_D;
    for (int it = gw; it < NE * I_E; it += NGW) {
        const int e = it / I_E; int r = it - e * I_E;
        bf16* We = Wm + (size_t)e * MOE_E_SZ;
        if (r < I_G) { p0_transpose_item(INP(I_MWG) + (size_t)e * D * DFF, DFF, D, DFF, We, 0, 1, scr, r, F.lane); continue; } r -= I_G;
        if (r < I_G) { p0_transpose_item(INP(I_MWU) + (size_t)e * D * DFF, DFF, D, DFF, We, 128, 1, scr, r, F.lane); continue; } r -= I_G;
        p0_transpose_item(INP(I_MWD) + (size_t)e * DFF * D, D, DFF, D, We + W_GU_SZ, 0, 0, scr, r, F.lane);
    }
}

__device__ __forceinline__ void m2a_rope(LAS unsigned char* lds_, const int wave_s, bf16* proj) {
    const Frame F = make_frame(lds_, wave_s);
    const float* rc = (const float*)(WSP() + WS_MISC2 + M2_ROPE); const float* rs = rc + T * 32;
    float* ksum = (float*)(WSP() + WS_MISC2 + M2_KSUM);
    LAS float* ksl = (LAS float*)(F.lds);
    const int combo = F.lane >> 2, qk = combo >> 3, h = combo & 7, c = F.lane & 3;
    for (int u = F.vcu; u < M / 64; u += F.G) {
        float ks1[8], ks2[8];
#pragma unroll
        for (int j = 0; j < 8; ++j) { ks1[j] = 0.f; ks2[j] = 0.f; }
        for (int rr = 0; rr < 8; ++rr) {
            const int row = 64 * u + 8 * F.wave + rr, t = row % T;
            bf16* p = proj + (size_t)row * PT + (qk ? PC_K : PC_Q) + h * 64 + 8 * c;
            float x1[8], x2[8], cs[8], sn[8];
            unpack8(*(const v4u*)p, x1); unpack8(*(const v4u*)(p + 32), x2);
            const f32x4 c0 = *(const f32x4*)(rc + t * 32 + 8 * c), c1 = *(const f32x4*)(rc + t * 32 + 8 * c + 4);
            const f32x4 s0 = *(const f32x4*)(rs + t * 32 + 8 * c), s1 = *(const f32x4*)(rs + t * 32 + 8 * c + 4);
#pragma unroll
            for (int j = 0; j < 4; ++j) { cs[j] = c0[j]; cs[4 + j] = c1[j]; sn[j] = s0[j]; sn[4 + j] = s1[j]; }
            float o1[8], o2[8];
#pragma unroll
            for (int j = 0; j < 8; ++j) { o1[j] = x1[j] * cs[j] - x2[j] * sn[j]; o2[j] = x2[j] * cs[j] + x1[j] * sn[j]; }
            if (qk) {
#pragma unroll
                for (int j = 0; j < 8; ++j) { ks1[j] += o1[j]; ks2[j] += o2[j]; }
            } else {
#pragma unroll
                for (int j = 0; j < 8; ++j) { o1[j] *= C2; o2[j] *= C2; }
            }
            *(v4u*)p = pack8(o1); *(v4u*)(p + 32) = pack8(o2);
        }
        if (qk) {
#pragma unroll
            for (int j = 0; j < 8; ++j) { ksl[(F.wave * 8 + h) * 64 + 8 * c + j] = ks1[j]; ksl[(F.wave * 8 + h) * 64 + 32 + 8 * c + j] = ks2[j]; }
        }
        __syncthreads();
        { const int hh = F.tid >> 6, d = F.tid & 63; float s = 0.f;
#pragma unroll
          for (int w = 0; w < 8; ++w) s += ksl[(w * 8 + hh) * 64 + d];
          const int b = u / 64, n = (u % 64) >> 2, part = u & 3;
          ksum[((((size_t)b * NH + hh) * 16 + n) * 4 + part) * 64 + d] = s; }
        __syncthreads();
    }
}
__device__ __forceinline__ void m2a_conv(LAS unsigned char* lds_, const int wave_s, const bf16* proj, const float* cw  , bf16* ocat) {
    const Frame F = make_frame(lds_, wave_s);
    const int gw = F.vcu * NWAVES + F.wave, NGW = F.G * NWAVES, c0 = 8 * F.lane;
    float w0[8], w1[8], w2[8];
#pragma unroll
    for (int j = 0; j < 8; ++j) { w0[j] = cw[c0 + j]; w1[j] = cw[BR + c0 + j]; w2[j] = cw[2 * BR + c0 + j]; }
    for (int m = gw; m < M; m += NGW) {
        const int t = m % T; const bf16* r0 = proj + (size_t)m * PT + c0;
        float ch[8], cc[8], cb[8], u0[8], u1[8], u2[8];
        unpack8(*(const v4u*)(r0 + PC_CH), ch); unpack8(*(const v4u*)(r0 + PC_CC), cc); unpack8(*(const v4u*)(r0 + PC_CB), cb);
#pragma unroll
        for (int j = 0; j < 8; ++j) { u0[j] = cc[j] * ch[j]; u1[j] = 0.f; u2[j] = 0.f; }
        if (t >= 1) { unpack8(*(const v4u*)(r0 - PT + PC_CH), ch); unpack8(*(const v4u*)(r0 - PT + PC_CC), cc);
#pragma unroll
            for (int j = 0; j < 8; ++j) u1[j] = cc[j] * ch[j]; }
        if (t >= 2) { unpack8(*(const v4u*)(r0 - 2 * PT + PC_CH), ch); unpack8(*(const v4u*)(r0 - 2 * PT + PC_CC), cc);
#pragma unroll
            for (int j = 0; j < 8; ++j) u2[j] = cc[j] * ch[j]; }
        float o[8];
#pragma unroll
        for (int j = 0; j < 8; ++j) o[j] = cb[j] * (w0[j] * u2[j] + w1[j] * u1[j] + w2[j] * u0[j]);
        *(v4u*)(ocat + (size_t)m * 1536 + c0) = pack8(o);
    }
}
__device__ __forceinline__ void m2a_rwkv_prep(LAS unsigned char* lds_, const int wave_s, int l, const bf16* proj, bf16* rwx, bf16* ocat) {
    const Frame F = make_frame(lds_, wave_s);
    const int gw = F.vcu * NWAVES + F.wave, NGW = F.G * NWAVES, lane = F.lane, c0 = 8 * lane;
    LAS float* lin = (LAS float*)(F.lds + 16384 + F.wave * 8192);
    const float* mu = INP(I_MU) + l * SHIFT;
    const f32x4 mul = *(const f32x4*)(mu + 1536 + 4 * lane);
    for (int ru = gw; ru < M / 8; ru += NGW) {
        const int r0 = 8 * ru;
#pragma unroll
        for (int rr = 0; rr < 8; ++rr) {
            const int row = r0 + rr, t = row % T;
            const v2u cur = *(const v2u*)(proj + (size_t)row * PT + PC_WL + 4 * lane);
            v2u prv; prv.x = 0u; prv.y = 0u; if (t >= 1) prv = *(const v2u*)(proj + (size_t)(row - 1) * PT + PC_WL + 4 * lane);
            float u[4] = {bflo(cur.x), bfhi(cur.x), bflo(cur.y), bfhi(cur.y)}, up[4] = {bflo(prv.x), bfhi(prv.x), bflo(prv.y), bfhi(prv.y)};
            f32x4 v;
#pragma unroll
            for (int j = 0; j < 4; ++j) { float x = u[j] + (up[j] - u[j]) * mul[j]; if (lane < 16) x = tanhf(x); else if (lane >= 32) x = sigmoidf_(x); v[j] = x; }
            *(LAS f32x4*)(lin + rr * 256 + 4 * lane) = v;
        }
        LDS_WAIT(); asm volatile("" ::: "memory");
        float acc[8][8];
#define LORA_PASS(WPTR, KOFF, KLEN) do { \
        _Pragma("unroll") for (int rr = 0; rr < 8; ++rr) _Pragma("unroll") for (int j = 0; j < 8; ++j) acc[rr][j] = 0.f; \
        for (int k = 0; k < (KLEN); k += 4) { \
            f32x4 wa[4], wb[4]; \
            _Pragma("unroll") for (int q = 0; q < 4; ++q) { wa[q] = *(const f32x4*)((WPTR) + (size_t)(k + q) * BR + c0); wb[q] = *(const f32x4*)((WPTR) + (size_t)(k + q) * BR + c0 + 4); } \
            _Pragma("unroll") for (int rr = 0; rr < 8; ++rr) { const f32x4 in = *(const LAS f32x4*)(lin + rr * 256 + (KOFF) + k); \
                _Pragma("unroll") for (int q = 0; q < 4; ++q) _Pragma("unroll") for (int j = 0; j < 4; ++j) { acc[rr][j] = fmaf(in[q], wa[q][j], acc[rr][j]); acc[rr][4 + j] = fmaf(in[q], wb[q][j], acc[rr][4 + j]); } } \
        } } while (0)
        LORA_PASS(INP(I_DW2) + (size_t)l * 64 * BR, 0, 64);
        unsigned em1p[8][4];
        {
            float w0v[8];
#pragma unroll
            for (int j = 0; j < 8; ++j) w0v[j] = INP(I_DW0)[l * BR + c0 + j];
#pragma unroll
            for (int rr = 0; rr < 8; ++rr) { float o[8];
#pragma unroll
                for (int j = 0; j < 8; ++j) { const float z = -(w0v[j] + acc[rr][j]); const float sp = fmaxf(z, 0.f) + log1pf(expf(-fabsf(z))); o[j] = expm1f(-expf(-sp - 0.5f)); }
#pragma unroll
                for (int q = 0; q < 4; ++q) em1p[rr][q] = pk2(o[2 * q], o[2 * q + 1]); }
        }
        LORA_PASS(INP(I_AW2) + (size_t)l * 64 * BR, 64, 64);
        {
            float a0v[8], kkv[8], kav[8], muk[8];
#pragma unroll
            for (int j = 0; j < 8; ++j) { a0v[j] = INP(I_AA0)[l * BR + c0 + j]; kkv[j] = INP(I_KK)[l * BR + c0 + j]; kav[j] = INP(I_KA)[l * BR + c0 + j]; muk[j] = mu[512 + c0 + j]; }
#pragma unroll
            for (int rr = 0; rr < 8; ++rr) {
                const int row = r0 + rr, t = row % T;
                float kc[8], kp[8];
                unpack8(*(const v4u*)(proj + (size_t)row * PT + PC_RK + c0), kc);
                if (t >= 1) unpack8(*(const v4u*)(proj + (size_t)(row - 1) * PT + PC_RK + c0), kp);
                else {
#pragma unroll
                    for (int j = 0; j < 8; ++j) kp[j] = 0.f; }
                float k2[8], kk[8], bb[8]; float ss = 0.f;
#pragma unroll
                for (int j = 0; j < 8; ++j) { const float km = kc[j] + (kp[j] - kc[j]) * muk[j]; const float a = sigmoidf_(a0v[j] + acc[rr][j]);
                    kk[j] = km * kkv[j]; ss += kk[j] * kk[j]; k2[j] = km * (1.f + (a - 1.f) * kav[j]); bb[j] = a; }
                ss = sum8lanes(ss);
                const float inv = 1.f / fmaxf(sqrtf(ss), 1e-12f);
#pragma unroll
                for (int j = 0; j < 8; ++j) { kk[j] *= inv; bb[j] *= kk[j]; }
                unsigned* ow = (unsigned*)rwx + (size_t)row * 1024 + c0;
                v4u wa0, wa1, wb0, wb1;
                wa0.x = f2bf(k2[0]) | (f2bf(kk[0]) << 16); wa0.y = f2bf(k2[1]) | (f2bf(kk[1]) << 16); wa0.z = f2bf(k2[2]) | (f2bf(kk[2]) << 16); wa0.w = f2bf(k2[3]) | (f2bf(kk[3]) << 16);
                wa1.x = f2bf(k2[4]) | (f2bf(kk[4]) << 16); wa1.y = f2bf(k2[5]) | (f2bf(kk[5]) << 16); wa1.z = f2bf(k2[6]) | (f2bf(kk[6]) << 16); wa1.w = f2bf(k2[7]) | (f2bf(kk[7]) << 16);
                wb0.x = (em1p[rr][0] & 0xffffu) | (f2bf(bb[0]) << 16); wb0.y = (em1p[rr][0] >> 16) | (f2bf(bb[1]) << 16); wb0.z = (em1p[rr][1] & 0xffffu) | (f2bf(bb[2]) << 16); wb0.w = (em1p[rr][1] >> 16) | (f2bf(bb[3]) << 16);
                wb1.x = (em1p[rr][2] & 0xffffu) | (f2bf(bb[4]) << 16); wb1.y = (em1p[rr][2] >> 16) | (f2bf(bb[5]) << 16); wb1.z = (em1p[rr][3] & 0xffffu) | (f2bf(bb[6]) << 16); wb1.w = (em1p[rr][3] >> 16) | (f2bf(bb[7]) << 16);
                *(v4u*)(ow) = wa0; *(v4u*)(ow + 4) = wa1; *(v4u*)(ow + 512) = wb0; *(v4u*)(ow + 516) = wb1;
            }
        }
        LORA_PASS(INP(I_GW2) + (size_t)l * 128 * BR, 128, 128);
#pragma unroll
        for (int rr = 0; rr < 8; ++rr) { float o[8];
#pragma unroll
            for (int j = 0; j < 8; ++j) o[j] = acc[rr][j];
            *(v4u*)(ocat + (size_t)(r0 + rr) * 1536 + 1024 + c0) = pack8(o); }
#undef LORA_PASS
        LDS_WAIT(); asm volatile("" ::: "memory");
    }
}

__device__ __forceinline__ void m2a_rwkv_prep_chunk(LAS unsigned char* lds_, const int wave_s, int l, const bf16* proj, bf16* rwx, bf16* ocat) {
    const Frame F = make_frame(lds_, wave_s);
    const int lane_ = F.lane;
    LAS float* lin = (LAS float*)(F.lds + 16384 + F.wave * 8192);
    LAS float* wtot = (LAS float*)(F.lds + 16384 + 65536);
    float* gC = (float*)(WSP() + WS_MISC2 + M2_GC); float* bonus = (float*)(WSP() + WS_MISC2 + M2_BONUS);
    const float* mu = INP(I_MU) + l * SHIFT;
    for (int u = F.vcu; u < M / 64; u += F.G) {
        const int r0 = 64 * u + 8 * F.wave;
        int lane = lane_; asm volatile("" : "+v"(lane));
        const int c0 = 8 * lane;
        const f32x4 mul = *(const f32x4*)(mu + 1536 + 4 * lane);
#pragma unroll
        for (int rr = 0; rr < 8; ++rr) {
            const int row = r0 + rr, t = row % T;
            const v2u cur = *(const v2u*)(proj + (size_t)row * PT + PC_WL + 4 * lane);
            v2u prv; prv.x = 0u; prv.y = 0u; if (t >= 1) prv = *(const v2u*)(proj + (size_t)(row - 1) * PT + PC_WL + 4 * lane);
            float u[4] = {bflo(cur.x), bfhi(cur.x), bflo(cur.y), bfhi(cur.y)}, up[4] = {bflo(prv.x), bfhi(prv.x), bflo(prv.y), bfhi(prv.y)};
            f32x4 v;
#pragma unroll
            for (int j = 0; j < 4; ++j) { float x = u[j] + (up[j] - u[j]) * mul[j]; if (lane < 16) x = tanhf(x); else if (lane >= 32) x = sigmoidf_(x); v[j] = x; }
            *(LAS f32x4*)(lin + rr * 256 + 4 * lane) = v;
        }
        LDS_WAIT(); asm volatile("" ::: "memory");
        float acc[8][8];
#define LORA_PASS(WPTR, KOFF, KLEN) do { \
        _Pragma("unroll") for (int rr = 0; rr < 8; ++rr) _Pragma("unroll") for (int j = 0; j < 8; ++j) acc[rr][j] = 0.f; \
        for (int k = 0; k < (KLEN); k += 4) { \
            f32x4 wa[4], wb[4]; \
            _Pragma("unroll") for (int q = 0; q < 4; ++q) { wa[q] = *(const f32x4*)((WPTR) + (size_t)(k + q) * BR + c0); wb[q] = *(const f32x4*)((WPTR) + (size_t)(k + q) * BR + c0 + 4); } \
            _Pragma("unroll") for (int rr = 0; rr < 8; ++rr) { const f32x4 in = *(const LAS f32x4*)(lin + rr * 256 + (KOFF) + k); \
                _Pragma("unroll") for (int q = 0; q < 4; ++q) _Pragma("unroll") for (int j = 0; j < 4; ++j) { acc[rr][j] = fmaf(in[q], wa[q][j], acc[rr][j]); acc[rr][4 + j] = fmaf(in[q], wb[q][j], acc[rr][4 + j]); } } \
        } } while (0)
        LORA_PASS(INP(I_DW2) + (size_t)l * 64 * BR, 0, 64);
        float lwv[8][8];
        float off[8];
        {
            float w0v[8], tot[8];
#pragma unroll
            for (int j = 0; j < 8; ++j) { w0v[j] = INP(I_DW0)[l * BR + c0 + j]; tot[j] = 0.f; }
#pragma unroll
            for (int rr = 0; rr < 8; ++rr)
#pragma unroll
                for (int j = 0; j < 8; ++j) { const float z = -(w0v[j] + acc[rr][j]); const float sp = fmaxf(z, 0.f) + log1pf(expf(-fabsf(z))); lwv[rr][j] = -expf(-sp - 0.5f); tot[j] += lwv[rr][j]; }
            *(LAS f32x4*)(wtot + F.wave * 512 + c0) = (f32x4){tot[0], tot[1], tot[2], tot[3]}; *(LAS f32x4*)(wtot + F.wave * 512 + c0 + 4) = (f32x4){tot[4], tot[5], tot[6], tot[7]};
            __syncthreads();
#pragma unroll
            for (int j = 0; j < 8; ++j) off[j] = 0.f;
            for (int w = 0; w < F.wave; ++w) { const f32x4 a0 = *(const LAS f32x4*)(wtot + w * 512 + c0), a1 = *(const LAS f32x4*)(wtot + w * 512 + c0 + 4);
#pragma unroll
                for (int j = 0; j < 4; ++j) { off[j] += a0[j]; off[4 + j] += a1[j]; } }
            if (F.wave == 7) {
#pragma unroll
                for (int j = 0; j < 8; ++j) gC[(size_t)u * 512 + c0 + j] = expf(off[j] + tot[j]); }
        }
        LORA_PASS(INP(I_AW2) + (size_t)l * 64 * BR, 64, 64);
        {
#pragma unroll
            for (int rr = 0; rr < 8; ++rr) {
                const int row = r0 + rr, t = row % T;
                float a0v[8], kkv[8], kav[8], muk[8], mur[8], rkv[8];
#pragma unroll
                for (int j = 0; j < 8; ++j) { a0v[j] = INP(I_AA0)[l * BR + c0 + j]; kkv[j] = INP(I_KK)[l * BR + c0 + j]; kav[j] = INP(I_KA)[l * BR + c0 + j]; muk[j] = mu[512 + c0 + j]; mur[j] = mu[c0 + j]; rkv[j] = INP(I_RK)[l * BR + c0 + j]; }
                float kc[8], kp[8], rc[8], rp[8];
                unpack8(*(const v4u*)(proj + (size_t)row * PT + PC_RK + c0), kc); unpack8(*(const v4u*)(proj + (size_t)row * PT + PC_R + c0), rc);
                if (t >= 1) { unpack8(*(const v4u*)(proj + (size_t)(row - 1) * PT + PC_RK + c0), kp); unpack8(*(const v4u*)(proj + (size_t)(row - 1) * PT + PC_R + c0), rp); }
                else {
#pragma unroll
                    for (int j = 0; j < 8; ++j) { kp[j] = 0.f; rp[j] = 0.f; } }
                float k2[8], kk[8], bb[8], rm[8]; float ss = 0.f, bn = 0.f;
#pragma unroll
                for (int j = 0; j < 8; ++j) { const float km = kc[j] + (kp[j] - kc[j]) * muk[j]; const float a = sigmoidf_(a0v[j] + acc[rr][j]);
                    kk[j] = km * kkv[j]; ss += kk[j] * kk[j]; k2[j] = km * (1.f + (a - 1.f) * kav[j]); bb[j] = a;
                    rm[j] = rc[j] + (rp[j] - rc[j]) * mur[j]; bn += rm[j] * k2[j] * rkv[j]; }
                ss = sum8lanes(ss); bn = sum8lanes(bn);
                if ((lane & 7) == 0) bonus[(size_t)row * NH + (lane >> 3)] = bn;
                const float inv = 1.f / fmaxf(sqrtf(ss), 1e-12f);
                float okt[8], okp[8], orh[8], obt[8];
#pragma unroll
                for (int j = 0; j < 8; ++j) { const float Lp = off[j]; off[j] += lwv[rr][j];
                    const float eL = expf(off[j]), eLm = expf(-off[j]), eLp = expf(Lp);
                    kk[j] *= inv; bb[j] *= kk[j];
                    okt[j] = k2[j] * eLm; okp[j] = kk[j] * eLp; orh[j] = rm[j] * eL; obt[j] = bb[j] * eLm; }
                bf16* o = rwx + (size_t)row * 2048 + c0;
                *(v4u*)(o) = pack8(okt); *(v4u*)(o + 512) = pack8(okp); *(v4u*)(o + 1024) = pack8(orh); *(v4u*)(o + 1536) = pack8(obt);
                asm volatile("" ::: "memory");
            }
        }
        LORA_PASS(INP(I_GW2) + (size_t)l * 128 * BR, 128, 128);
#pragma unroll
        for (int rr = 0; rr < 8; ++rr) { float o[8];
#pragma unroll
            for (int j = 0; j < 8; ++j) o[j] = acc[rr][j];
            *(v4u*)(ocat + (size_t)(r0 + rr) * 1536 + 1024 + c0) = pack8(o); }
#undef LORA_PASS
        LDS_WAIT(); asm volatile("" ::: "memory");
        __syncthreads();
    }
}

__device__ __forceinline__ void m2b_attn_naive(LAS unsigned char* lds_, const int wave_s, const bf16* proj, bf16* ocat) {
    const Frame F = make_frame(lds_, wave_s);
    const float* ksum = (const float*)(WSP() + WS_MISC2 + M2_KSUM);
    LAS float* kml = (LAS float*)(F.lds);
    LAS float* gl = (LAS float*)(F.lds + 4096);
    for (int base = F.vcu * 512; base < M * NH; base += F.G * 512) {
        const int idx = base + F.tid;
        const int t = idx % T, h = (idx / T) % NH, b = idx / (T * NH), m = b * T + t, own = t >> 8;
        __syncthreads();
        for (int i = F.tid; i < 16 * 64; i += 512) { const float* km = ksum + ((((size_t)b * NH + h) * 16 + (i >> 6)) * 4) * 64 + (i & 63); kml[i] = (km[0] + km[64]) + (km[128] + km[192]); }
        __syncthreads();
        unsigned qw[32]; float acc[64];
        const bf16* qp = proj + (size_t)m * PT + PC_Q + h * 64;
#pragma unroll
        for (int d8 = 0; d8 < 8; ++d8) { const v4u w = *(const v4u*)(qp + 8 * d8); qw[4 * d8] = w.x; qw[4 * d8 + 1] = w.y; qw[4 * d8 + 2] = w.z; qw[4 * d8 + 3] = w.w;
#pragma unroll
            for (int j = 0; j < 8; ++j) acc[8 * d8 + j] = 0.f; }
#define QF(d) (((d) & 1) ? bfhi(qw[(d) >> 1]) : bflo(qw[(d) >> 1]))
        int mask = 0;
        if (own <= 3) mask = (1 << own) - 1;
        else {
            for (int n = 0; n < own; ++n) { float s = 0.f;
#pragma unroll
                for (int d = 0; d < 64; ++d) s = fmaf(QF(d), kml[n * 64 + d], s);
                gl[F.tid * 17 + n] = s; }
            for (int r = 0; r < 3; ++r) {
                float best = -INFINITY; int bi = -1;
                for (int n = 0; n < own; ++n) { const float g = gl[F.tid * 17 + n]; if (!((mask >> n) & 1) && (bi < 0 || g > best)) { best = g; bi = n; } }
                mask |= (1 << bi);
            }
        }
        float mx = -INFINITY, lsum = 0.f;
        for (int n = 0; n <= own; ++n) {
            const bool isown = (n == own);
            if (!isown && !((mask >> n) & 1)) continue;
            const int kend = isown ? (t & 255) : 255;
            const bf16* kb = proj + ((size_t)(b * T + n * 256)) * PT + PC_K + h * 64;
            for (int kk = 0; kk <= kend; ++kk) {
                const bf16* kr = kb + (size_t)kk * PT; const bf16* vr = kr + (PC_V - PC_K);
                float s = 0.f;
#pragma unroll
                for (int d8 = 0; d8 < 8; ++d8) { float f[8]; unpack8(*(const v4u*)(kr + 8 * d8), f);
#pragma unroll
                    for (int j = 0; j < 8; ++j) s = fmaf(QF(8 * d8 + j), f[j], s); }
                if (s > mx) { const float f = exp2f(mx - s); lsum *= f;
#pragma unroll
                    for (int d = 0; d < 64; ++d) acc[d] *= f;
                    mx = s; }
                const float p = exp2f(s - mx); lsum += p;
#pragma unroll
                for (int d8 = 0; d8 < 8; ++d8) { float f[8]; unpack8(*(const v4u*)(vr + 8 * d8), f);
#pragma unroll
                    for (int j = 0; j < 8; ++j) acc[8 * d8 + j] = fmaf(p, f[j], acc[8 * d8 + j]); }
            }
        }
        const float il = 1.f / lsum;
        bf16* op = ocat + (size_t)m * 1536 + 512 + h * 64;
#pragma unroll
        for (int d8 = 0; d8 < 8; ++d8) { float f[8];
#pragma unroll
            for (int j = 0; j < 8; ++j) f[j] = acc[8 * d8 + j] * il;
            *(v4u*)(op + 8 * d8) = pack8(f); }
#undef QF
    }
}
__device__ __forceinline__ void m2b_scan_naive(LAS unsigned char* lds_, const int wave_s, int l, const bf16* proj, const bf16* rwx, bf16* ysc) {
    const Frame F = make_frame(lds_, wave_s);
    const int NGW = F.G * NWAVES, lane = F.lane;
    const float* mu = INP(I_MU) + l * SHIFT;
    for (int gw = F.vcu * NWAVES + F.wave; gw < NB * NH * 64; gw += NGW) {
        const int i = gw & 63, h = (gw >> 6) & 7, b = gw >> 9, c = h * 64 + lane;
        const float mur = mu[c], muv = mu[1024 + h * 64 + i];
        float S = 0.f, rprev = 0.f, vprev = 0.f;
        for (int t = 0; t < T; ++t) {
            const size_t row = (size_t)b * T + t;
            const float rraw = bf1(proj[row * PT + PC_R + c]), vraw = bf1(proj[row * PT + PC_RV + h * 64 + i]);
            const float r = rraw + (rprev - rraw) * mur, vi = vraw + (vprev - vraw) * muv;
            rprev = rraw; vprev = vraw;
            const unsigned* x = (const unsigned*)rwx + row * 1024 + c;
            const unsigned wa = x[0], wb = x[512];
            const float k2 = bflo(wa), kk = bfhi(wa), em1 = bflo(wb), bb = bfhi(wb);
            const float sa = -wave_sum(S * kk);
            S = (S + S * em1) + sa * bb + vi * k2;
            const float y = wave_sum(S * r);
            if (lane == 0) ysc[row * BR + h * 64 + i] = (bf16)f2bf(y);
        }
    }
}
__device__ __forceinline__ float dpp_f(float x, const int sel) {
    const int v = __builtin_bit_cast(int, x); int r;
    switch (sel) {
      case 1: r = __builtin_amdgcn_update_dpp(0, v, 0x111, 0xF, 0xF, true); break;
      case 2: r = __builtin_amdgcn_update_dpp(0, v, 0x112, 0xF, 0xF, true); break;
      case 3: r = __builtin_amdgcn_update_dpp(0, v, 0x113, 0xF, 0xF, true); break;
      case 4: r = __builtin_amdgcn_update_dpp(0, v, 0x114, 0xF, 0xE, true); break;
      case 8: r = __builtin_amdgcn_update_dpp(0, v, 0x118, 0xF, 0xC, true); break;
      case 15: r = __builtin_amdgcn_update_dpp(0, v, 0x142, 0xA, 0xF, true); break;
      case 31: r = __builtin_amdgcn_update_dpp(0, v, 0x143, 0xC, 0xF, true); break;
      case 100: r = __builtin_amdgcn_update_dpp(0, v, 0xB1, 0xF, 0xF, true); break;
      case 101: r = __builtin_amdgcn_update_dpp(0, v, 0x4E, 0xF, 0xF, true); break;
      case 104: r = __builtin_amdgcn_update_dpp(0, v, 0x124, 0xF, 0xF, true); break;
      default: r = __builtin_amdgcn_update_dpp(0, v, 0x128, 0xF, 0xF, true); break;
    }
    return __builtin_bit_cast(float, r);
}
__device__ __forceinline__ float wsum_to_sgpr(float x) {
    float t = x + dpp_f(x, 1); t = t + dpp_f(x, 2); t = t + dpp_f(x, 3); t = t + dpp_f(t, 4); t = t + dpp_f(t, 8); t = t + dpp_f(t, 15); t = t + dpp_f(t, 31);
    return __builtin_bit_cast(float, __builtin_amdgcn_readlane(__builtin_bit_cast(int, t), 63));
}
struct ScanIn { unsigned r, wa, wb, vv; };
__device__ __forceinline__ void m2b_scan(LAS unsigned char* lds_, const int wave_s, int l, const bf16* __restrict__ proj, const bf16* __restrict__ rwx, bf16* __restrict__ ysc) {
    const Frame F = make_frame(lds_, wave_s);
    const int lane = F.lane;
    const float* mu = INP(I_MU) + l * SHIFT;
    const bool b0 = (lane & 1) != 0, b1 = (lane & 2) != 0;
    for (int gw = F.vcu * NWAVES + F.wave; gw < NB * NH * 64; gw += F.G * NWAVES) {
        const int i = gw & 63, h = (gw >> 6) & 7, b = gw >> 9, c = h * 64 + lane;
        const float mur = mu[c], muv = mu[1024 + h * 64 + i];
        const bf16* pr = proj + (size_t)b * T * PT + PC_R + c;
        const bf16* pv = proj + (size_t)b * T * PT + PC_RV + h * 64 + i;
        const unsigned* px = (const unsigned*)rwx + (size_t)b * T * 1024 + c;
        bf16* py = ysc + (size_t)b * T * BR + h * 64 + i;
        float S = 0.f, rp = 0.f, vp = 0.f;
#define SC_LOAD(X, t_) do { const int tt = (t_) < T ? (t_) : T - 1; X.r = pr[(size_t)tt * PT]; X.vv = pv[(size_t)tt * PT]; X.wa = px[(size_t)tt * 1024]; X.wb = px[(size_t)tt * 1024 + 512]; } while (0)
#define SC_STEP(X, Q) do { \
        const float rr = __uint_as_float(X.r << 16), vr = __uint_as_float(X.vv << 16); \
        const float r_ = rr + (rp - rr) * mur, vi = vr + (vp - vr) * muv; rp = rr; vp = vr; \
        const float k2 = bflo(X.wa), kk = bfhi(X.wa), em1 = bflo(X.wb), bb = bfhi(X.wb); \
        const float ps = wsum_to_sgpr(S * kk); \
        S = __builtin_fmaf(S, em1, S) + __builtin_fmaf(-ps, bb, vi * k2); \
        Q = S * r_; } while (0)
#define SC_YOUT(t0) do { \
        const float z = (b0 ? q1 : q0) + dpp_f(b0 ? q0 : q1, 100); \
        const float w = (b0 ? q3 : q2) + dpp_f(b0 ? q2 : q3, 100); \
        float v_ = (b1 ? w : z) + dpp_f(b1 ? z : w, 101); \
        v_ += dpp_f(v_, 104); v_ += dpp_f(v_, 108); \
        v_ += __shfl_xor(v_, 16); v_ += __shfl_xor(v_, 32); \
        if (lane < 4) py[(size_t)((t0) + lane) * BR] = (bf16)f2bf(v_); } while (0)
        ScanIn a0, a1, a2, a3, e0, e1, e2, e3, g0, g1, g2, g3, h0, h1, h2, h3;
        float q0, q1, q2, q3;
        SC_LOAD(a0, 0); SC_LOAD(a1, 1); SC_LOAD(a2, 2); SC_LOAD(a3, 3);
        SC_LOAD(e0, 4); SC_LOAD(e1, 5); SC_LOAD(e2, 6); SC_LOAD(e3, 7);
        SC_LOAD(g0, 8); SC_LOAD(g1, 9); SC_LOAD(g2, 10); SC_LOAD(g3, 11);
        for (int t = 0; t < T; t += 16) {
            SC_LOAD(h0, t + 12); SC_LOAD(h1, t + 13); SC_LOAD(h2, t + 14); SC_LOAD(h3, t + 15);
            SC_STEP(a0, q0); SC_STEP(a1, q1); SC_STEP(a2, q2); SC_STEP(a3, q3); SC_YOUT(t);
            SC_LOAD(a0, t + 16); SC_LOAD(a1, t + 17); SC_LOAD(a2, t + 18); SC_LOAD(a3, t + 19);
            SC_STEP(e0, q0); SC_STEP(e1, q1); SC_STEP(e2, q2); SC_STEP(e3, q3); SC_YOUT(t + 4);
            SC_LOAD(e0, t + 20); SC_LOAD(e1, t + 21); SC_LOAD(e2, t + 22); SC_LOAD(e3, t + 23);
            SC_STEP(g0, q0); SC_STEP(g1, q1); SC_STEP(g2, q2); SC_STEP(g3, q3); SC_YOUT(t + 8);
            SC_LOAD(g0, t + 24); SC_LOAD(g1, t + 25); SC_LOAD(g2, t + 26); SC_LOAD(g3, t + 27);
            SC_STEP(h0, q0); SC_STEP(h1, q1); SC_STEP(h2, q2); SC_STEP(h3, q3); SC_YOUT(t + 12);
        }
#undef SC_LOAD
#undef SC_STEP
#undef SC_YOUT
    }
}
__device__ __forceinline__ void m2c_rwkv_post(LAS unsigned char* lds_, const int wave_s, int l, const bf16* proj, const bf16* rwx, const bf16* ysc, bf16* ocat) {
    const Frame F = make_frame(lds_, wave_s);
    const int gw = F.vcu * NWAVES + F.wave, NGW = F.G * NWAVES, c0 = 8 * F.lane;
    const float* mu = INP(I_MU) + l * SHIFT;
    float mur[8], muv[8], rk[8], gg[8], gb[8];
#pragma unroll
    for (int j = 0; j < 8; ++j) { mur[j] = mu[c0 + j]; muv[j] = mu[1024 + c0 + j]; rk[j] = INP(I_RK)[l * BR + c0 + j]; gg[j] = INP(I_GNG)[l * BR + c0 + j]; gb[j] = INP(I_GNB)[l * BR + c0 + j]; }
    for (int m = gw; m < M; m += NGW) {
        const int t = m % T;
        float y[8], rc[8], rp[8], vc[8], vp[8], k2[8], g[8];
        unpack8(*(const v4u*)(ysc + (size_t)m * BR + c0), y);
        unpack8(*(const v4u*)(proj + (size_t)m * PT + PC_R + c0), rc); unpack8(*(const v4u*)(proj + (size_t)m * PT + PC_RV + c0), vc);
        if (t >= 1) { unpack8(*(const v4u*)(proj + (size_t)(m - 1) * PT + PC_R + c0), rp); unpack8(*(const v4u*)(proj + (size_t)(m - 1) * PT + PC_RV + c0), vp); }
        else {
#pragma unroll
            for (int j = 0; j < 8; ++j) { rp[j] = 0.f; vp[j] = 0.f; } }
        { const unsigned* wa = (const unsigned*)rwx + (size_t)m * 1024 + c0; const v4u a0 = *(const v4u*)wa, a1 = *(const v4u*)(wa + 4);
          k2[0] = bflo(a0.x); k2[1] = bflo(a0.y); k2[2] = bflo(a0.z); k2[3] = bflo(a0.w); k2[4] = bflo(a1.x); k2[5] = bflo(a1.y); k2[6] = bflo(a1.z); k2[7] = bflo(a1.w); }
        unpack8(*(const v4u*)(ocat + (size_t)m * 1536 + 1024 + c0), g);
        float s = 0.f;
#pragma unroll
        for (int j = 0; j < 8; ++j) s += y[j];
        const float mean = sum8lanes(s) * (1.f / 64.f);
        float q = 0.f, bn = 0.f;
#pragma unroll
        for (int j = 0; j < 8; ++j) { y[j] -= mean; q += y[j] * y[j]; const float r = rc[j] + (rp[j] - rc[j]) * mur[j]; bn += r * k2[j] * rk[j]; }
        const float rstd = rsqrtf(sum8lanes(q) * (1.f / 64.f) + GN_EPS);
        bn = sum8lanes(bn);
        float o[8];
#pragma unroll
        for (int j = 0; j < 8; ++j) { const float v = vc[j] + (vp[j] - vc[j]) * muv[j]; o[j] = (y[j] * rstd * gg[j] + gb[j] + bn * v) * g[j]; }
        *(v4u*)(ocat + (size_t)m * 1536 + 1024 + c0) = pack8(o);
    }
}

__device__ __forceinline__ void m2c_rwkv_post2(LAS unsigned char* lds_, const int wave_s, int l, const bf16* proj, const bf16* ysc, bf16* ocat) {
    const Frame F = make_frame(lds_, wave_s);
    const int gw = F.vcu * NWAVES + F.wave, NGW = F.G * NWAVES, c0 = 8 * F.lane;
    const float* mu = INP(I_MU) + l * SHIFT;
    float mur[8], muv[8], rk[8], gg[8], gb[8];
#pragma unroll
    for (int j = 0; j < 8; ++j) { mur[j] = mu[c0 + j]; muv[j] = mu[1024 + c0 + j]; rk[j] = INP(I_RK)[l * BR + c0 + j]; gg[j] = INP(I_GNG)[l * BR + c0 + j]; gb[j] = INP(I_GNB)[l * BR + c0 + j]; }
    for (int m = gw; m < M; m += NGW) {
        const int t = m % T;
        float y[8], vc[8], vp[8], g[8];
        unpack8(*(const v4u*)(ysc + (size_t)m * BR + c0), y);
        unpack8(*(const v4u*)(proj + (size_t)m * PT + PC_RV + c0), vc);
        if (t >= 1) { unpack8(*(const v4u*)(proj + (size_t)(m - 1) * PT + PC_RV + c0), vp); }
        else {
#pragma unroll
            for (int j = 0; j < 8; ++j) { vp[j] = 0.f; } }
        unpack8(*(const v4u*)(ocat + (size_t)m * 1536 + 1024 + c0), g);
        float s = 0.f;
#pragma unroll
        for (int j = 0; j < 8; ++j) s += y[j];
        const float mean = sum8lanes(s) * (1.f / 64.f);
        float q = 0.f; const float bn = ((const float*)(WSP() + WS_MISC2 + M2_BONUS))[(size_t)m * NH + (F.lane >> 3)];
#pragma unroll
        for (int j = 0; j < 8; ++j) { y[j] -= mean; q += y[j] * y[j]; }
        const float rstd = rsqrtf(sum8lanes(q) * (1.f / 64.f) + GN_EPS);
        float o[8];
#pragma unroll
        for (int j = 0; j < 8; ++j) { const float v = vc[j] + (vp[j] - vc[j]) * muv[j]; o[j] = (y[j] * rstd * gg[j] + gb[j] + bn * v) * g[j]; }
        *(v4u*)(ocat + (size_t)m * 1536 + 1024 + c0) = pack8(o);
    }
}

template <bool ROUTE, bool WRITE_XB>
__device__ __forceinline__ void ln_pass(LAS unsigned char* lds_, const int wave_s, const float* g, const float* bta, float* xio, bf16* xb, const float* rw, int* cnt, int* asg_e, int* asg_rank, float* asg_gate) {
    const Frame F = make_frame(lds_, wave_s);
    const int gw = F.vcu * NWAVES + F.wave, NGW = F.G * NWAVES, lane = F.lane;
    for (int m = gw; m < M; m += NGW) {
        GAS f32x4* xr = (GAS f32x4*)(xio + (size_t)m * D) + lane;
        f32x4 v[4]; float s = 0.f;
#pragma unroll
        for (int j = 0; j < 4; ++j) { v[j] = xr[64 * j]; s += (v[j].x + v[j].y) + (v[j].z + v[j].w); }
        const float mean = wave_sum(s) * (1.f / D); float s2 = 0.f;
#pragma unroll
        for (int j = 0; j < 4; ++j) { v[j] = v[j] - mean; s2 += (v[j].x * v[j].x + v[j].y * v[j].y) + (v[j].z * v[j].z + v[j].w * v[j].w); }
        const float rstd = 1.f / sqrtf(wave_sum(s2) * (1.f / D) + LN_EPS);
#pragma unroll
        for (int j = 0; j < 4; ++j) { const f32x4 gv = *(const f32x4*)(g + 4 * lane + 256 * j), bv = *(const f32x4*)(bta + 4 * lane + 256 * j); v[j] = v[j] * rstd * gv + bv; xr[64 * j] = v[j]; }
        if (WRITE_XB) { GAS unsigned long long* o8 = (GAS unsigned long long*)(xb + (size_t)m * D) + lane;
#pragma unroll
            for (int j = 0; j < 4; ++j) o8[64 * j] = (unsigned long long)pk2(v[j].x, v[j].y) | ((unsigned long long)pk2(v[j].z, v[j].w) << 32); }
        if (ROUTE) {
            float lg[8];
#pragma unroll
            for (int e = 0; e < 8; ++e) lg[e] = 0.f;
#pragma unroll
            for (int j = 0; j < 4; ++j)
#pragma unroll
                for (int i = 0; i < 4; ++i) { const int d = 4 * lane + 256 * j + i; const f32x4 r0 = *(const f32x4*)(rw + d * NE), r1 = *(const f32x4*)(rw + d * NE + 4); const float xv = v[j][i];
#pragma unroll
                    for (int e = 0; e < 4; ++e) { lg[e] = fmaf(xv, r0[e], lg[e]); lg[4 + e] = fmaf(xv, r1[e], lg[4 + e]); } }
#pragma unroll
            for (int e = 0; e < 8; ++e) lg[e] = wave_sum(lg[e]);
            if (lane == 0) {
                int e1 = 0; float l1 = lg[0];
#pragma unroll
                for (int e = 1; e < 8; ++e) if (lg[e] > l1) { l1 = lg[e]; e1 = e; }
                int e2 = -1; float l2 = -INFINITY;
#pragma unroll
                for (int e = 0; e < 8; ++e) if (e != e1 && (e2 < 0 || lg[e] > l2)) { l2 = lg[e]; e2 = e; }
                const float p2 = expf(l2 - l1); const float g1 = 1.f / (1.f + p2), g2 = p2 / (1.f + p2);
                asg_e[2 * m] = e1; asg_e[2 * m + 1] = e2; asg_gate[2 * m] = g1; asg_gate[2 * m + 1] = g2;
                asg_rank[2 * m] = atomicAdd(&cnt[e1], 1); asg_rank[2 * m + 1] = atomicAdd(&cnt[e2], 1);
            }
        }
    }
}

__device__ __forceinline__ void moe_scatter(LAS unsigned char* lds_, const int wave_s, const int* cnt, const int* asg_e, const int* asg_rank, int* asg_pos, const bf16* xb, bf16* xs, int* tile_e) {
    const Frame F = make_frame(lds_, wave_s);
    const int gw = F.vcu * NWAVES + F.wave, NGW = F.G * NWAVES, lane = F.lane;
    int pstart[NE + 1]; int c[NE];
    { int s = 0;
#pragma unroll
      for (int e = 0; e < NE; ++e) { c[e] = cnt[e]; pstart[e] = s; s += ((c[e] + 255) >> 8) << 8; }
      pstart[NE] = s; }
    if (F.vcu == 0 && F.tid == 0) {
        const int ntiles = pstart[NE] >> 8;
        for (int ti = 0; ti < ntiles; ++ti) { int e = 0;
#pragma unroll
            for (int q = 1; q < NE; ++q) if ((ti << 8) >= pstart[q]) e = q;
            tile_e[ti] = e; }
        tile_e[MOE_MAXT] = ntiles;
    }
    for (int a = gw; a < 2 * M; a += NGW) {
        const int e = asg_e[a]; int ps = 0;
#pragma unroll
        for (int q = 0; q < NE; ++q) if (q == e) ps = pstart[q];
        const int pos = ps + asg_rank[a];
        if (lane == 0) asg_pos[a] = pos;
        const v4u* src = (const v4u*)(xb + (size_t)(a >> 1) * D); v4u* dst = (v4u*)(xs + (size_t)pos * D);
        dst[lane] = src[lane]; dst[64 + lane] = src[64 + lane];
    }
#pragma unroll
    for (int e = 0; e < NE; ++e) {
        const int p0 = pstart[e] + c[e], p1 = pstart[e + 1];
        for (int p = p0 + gw; p < p1; p += NGW) { v4u* dst = (v4u*)(xs + (size_t)p * D); const v4u z = {0u, 0u, 0u, 0u}; dst[lane] = z; dst[64 + lane] = z; }
    }
}
__device__ __forceinline__ void moe_final_ln(LAS unsigned char* lds_, const int wave_s, const float* g, const float* bta, float* xio, const bf16* ybuf, const int* asg_pos, const float* asg_gate) {
    const Frame F = make_frame(lds_, wave_s);
    const int gw = F.vcu * NWAVES + F.wave, NGW = F.G * NWAVES, lane = F.lane;
    for (int m = gw; m < M; m += NGW) {
        GAS f32x4* xr = (GAS f32x4*)(xio + (size_t)m * D) + lane;
        const int p0 = asg_pos[2 * m], p1 = asg_pos[2 * m + 1]; const float g0 = asg_gate[2 * m], g1 = asg_gate[2 * m + 1];
        const v2u* y0 = (const v2u*)(ybuf + (size_t)p0 * D) + lane; const v2u* y1 = (const v2u*)(ybuf + (size_t)p1 * D) + lane;
        f32x4 v[4]; float s = 0.f;
#pragma unroll
        for (int j = 0; j < 4; ++j) { const v2u a = y0[64 * j], b = y1[64 * j]; const f32x4 x = xr[64 * j];
            v[j].x = ALPHA * x.x + g0 * bflo(a.x) + g1 * bflo(b.x); v[j].y = ALPHA * x.y + g0 * bfhi(a.x) + g1 * bfhi(b.x);
            v[j].z = ALPHA * x.z + g0 * bflo(a.y) + g1 * bflo(b.y); v[j].w = ALPHA * x.w + g0 * bfhi(a.y) + g1 * bfhi(b.y);
            s += (v[j].x + v[j].y) + (v[j].z + v[j].w); }
        const float mean = wave_sum(s) * (1.f / D); float s2 = 0.f;
#pragma unroll
        for (int j = 0; j < 4; ++j) { v[j] = v[j] - mean; s2 += (v[j].x * v[j].x + v[j].y * v[j].y) + (v[j].z * v[j].z + v[j].w * v[j].w); }
        const float rstd = 1.f / sqrtf(wave_sum(s2) * (1.f / D) + LN_EPS);
#pragma unroll
        for (int j = 0; j < 4; ++j) { const f32x4 gv = *(const f32x4*)(g + 4 * lane + 256 * j), bv = *(const f32x4*)(bta + 4 * lane + 256 * j); xr[64 * j] = v[j] * rstd * gv + bv; }
    }
}

namespace ck {
typedef float f32x16 __attribute__((ext_vector_type(16)));
typedef short bf16x8 __attribute__((ext_vector_type(8)));
constexpr int PIT = 144, IMG = 64 * PIT;
struct M4 { f32x16 t[2][2]; };
__device__ __forceinline__ void lwait() { asm volatile("s_waitcnt lgkmcnt(0)" ::: "memory"); }
template <bool UPPER> __device__ __forceinline__ void mm(M4& acc, const LAS unsigned char* A, const LAS unsigned char* Bt, int r, int h) {
#pragma unroll
    for (int a = 0; a < 2; ++a)
#pragma unroll
        for (int b = 0; b < 2; ++b) acc.t[a][b] = f32x16{};
#pragma unroll
    for (int ks = 0; ks < 4; ++ks) {
        const LAS unsigned char* ab = A + r * PIT + 16 * h; const LAS unsigned char* bb = Bt + r * PIT + 16 * h;
        const bf16x8 a0 = *(const LAS bf16x8*)(ab + 32 * ks), a1 = *(const LAS bf16x8*)(ab + 32 * PIT + 32 * ks);
        const bf16x8 b0 = *(const LAS bf16x8*)(bb + 32 * ks), b1 = *(const LAS bf16x8*)(bb + 32 * PIT + 32 * ks);
        acc.t[0][0] = __builtin_amdgcn_mfma_f32_32x32x16_bf16(a0, b0, acc.t[0][0], 0, 0, 0);
        acc.t[0][1] = __builtin_amdgcn_mfma_f32_32x32x16_bf16(a0, b1, acc.t[0][1], 0, 0, 0);
        if (!UPPER) acc.t[1][0] = __builtin_amdgcn_mfma_f32_32x32x16_bf16(a1, b0, acc.t[1][0], 0, 0, 0);
        acc.t[1][1] = __builtin_amdgcn_mfma_f32_32x32x16_bf16(a1, b1, acc.t[1][1], 0, 0, 0);
    }
}
template <bool STRICT> __device__ __forceinline__ void mask_upper(M4& a, int r, int h) {
#pragma unroll
    for (int d = 0; d < 2; ++d)
#pragma unroll
        for (int reg = 0; reg < 16; ++reg) { const int row = (reg & 3) + 8 * (reg >> 2) + 4 * h; const bool keep = STRICT ? (row < r) : (row <= r); if (!keep) a.t[d][d][reg] = 0.f; }
}
__device__ __forceinline__ void accT_to_img(LAS unsigned char* img, const M4& a, int r, int h) {
    LAS unsigned char* base = img + r * PIT + 8 * h;
#pragma unroll
    for (int rt = 0; rt < 2; ++rt)
#pragma unroll
        for (int ct = 0; ct < 2; ++ct)
#pragma unroll
            for (int g = 0; g < 4; ++g) { v2u w; w.x = pk2(a.t[rt][ct][4 * g], a.t[rt][ct][4 * g + 1]); w.y = pk2(a.t[rt][ct][4 * g + 2], a.t[rt][ct][4 * g + 3]);
                *(LAS v2u*)(base + 32 * ct * PIT + (32 * rt + 8 * g) * 2) = w; }
}
__device__ __forceinline__ void acc_to_f32(LAS unsigned char* img, const M4& a, int r, int h) {
    LAS unsigned char* base = img + (4 * h * 72 + r) * 4;
#pragma unroll
    for (int rt = 0; rt < 2; ++rt)
#pragma unroll
        for (int ct = 0; ct < 2; ++ct)
#pragma unroll
            for (int reg = 0; reg < 16; ++reg) *(LAS float*)(base + ((32 * rt + (reg & 3) + 8 * (reg >> 2)) * 72 + 32 * ct) * 4) = a.t[rt][ct][reg];
}
__device__ __forceinline__ void stage_nat(LAS unsigned char* img, const bf16* g, int pitch, int lane) {
#pragma unroll
    for (int i = 0; i < 8; ++i) { const int row = 8 * i + (lane >> 3), ch = lane & 7; *(LAS v4u*)(img + row * PIT + ch * 16) = *(const v4u*)(g + (size_t)row * pitch + ch * 8); }
}
__device__ __forceinline__ void stage_T(LAS unsigned char* img, const bf16* g, int pitch, int lane, float sc) {
#pragma unroll 8
    for (int t = 0; t < 64; t += 2) { const float x0 = bf1(g[(size_t)t * pitch + lane]) * sc, x1 = bf1(g[(size_t)(t + 1) * pitch + lane]) * sc; *(LAS unsigned*)(img + lane * PIT + t * 2) = pk2(x0, x1); }
}
__device__ __forceinline__ void stage_VT(LAS unsigned char* img, const bf16* pv  , bool has_prev, float muv, int lane) {
    float vp = has_prev ? bf1(*(pv - PT + lane)) : 0.f;
#pragma unroll 8
    for (int t = 0; t < 64; t += 2) { const float r0 = bf1(pv[(size_t)t * PT + lane]), r1 = bf1(pv[(size_t)(t + 1) * PT + lane]);
        const float x0 = r0 + (vp - r0) * muv, x1 = r1 + (r0 - r1) * muv; vp = r1; *(LAS unsigned*)(img + lane * PIT + t * 2) = pk2(x0, x1); }
}
}

__device__ __forceinline__ void m2b_chunk_pre(LAS unsigned char* lds_, const int wave_s, int l, bf16* proj, const bf16* rwx, bf16* ysc) {
    using namespace ck;
    const Frame F = make_frame(lds_, wave_s);
    if (F.wave >= 4) return;
    LAS unsigned char* I0 = F.lds + F.wave * 4 * IMG; LAS unsigned char* I1 = I0 + IMG; LAS unsigned char* I2 = I1 + IMG; LAS unsigned char* I3 = I2 + IMG;
    const int lane_ = F.lane;
    const float* gC = (const float*)(WSP() + WS_MISC2 + M2_GC);
    const float* mu = INP(I_MU) + l * SHIFT;
    for (int unit = F.vcu * 4 + F.wave; unit < NB * 64 * NH; unit += F.G * 4) {
        const int b = unit >> 9, c = (unit >> 3) & 63, hd = unit & 7;
        int lane = lane_; asm volatile("" : "+v"(lane));
        const int r = lane & 31, h = lane >> 5;
        const size_t t0 = (size_t)b * T + 64 * c;
        const bf16* Kt = rwx + t0 * 2048 + hd * 64; const bf16* Kp = Kt + 512; const bf16* Rh = Kt + 1024; const bf16* Bt = Kt + 1536;
        const bf16* pv = proj + t0 * PT + PC_RV + hd * 64;
        const float gam = gC[(t0 >> 6) * 512 + hd * 64 + lane];
        const float muv = mu[1024 + hd * 64 + lane];
        M4 aM, aZ;
        stage_nat(I0, Kt, 2048, lane); stage_nat(I1, Kp, 2048, lane); lwait();
        mm<true>(aM, I0, I1, r, h); mask_upper<true>(aM, r, h);
        accT_to_img(I2, aM, r, h); stage_VT(I3, pv, c > 0, muv, lane); lwait();
        mm<false>(aZ, I2, I3, r, h);
        stage_nat(I0, Bt, 2048, lane); lwait();
        mm<true>(aM, I0, I1, r, h); mask_upper<true>(aM, r, h);
        acc_to_f32(I0, aM, r, h); lwait();
        { LAS float* Tl = (LAS float*)I2 + lane * 68;
#pragma unroll
          for (int q = 0; q < 16; ++q) *(LAS f32x4*)(Tl + 4 * q) = (f32x4){0.f, 0.f, 0.f, 0.f};
          lwait();
          for (int s = 63; s >= 0; --s) {
              float a = (lane == s) ? 1.f : 0.f;
              for (int t4 = (s + 1) & ~3; t4 < 64; t4 += 4) { const f32x4 n = *(const LAS f32x4*)(I0 + (s * 72 + t4) * 4); const f32x4 tv = *(const LAS f32x4*)(Tl + t4);
                  a = __builtin_fmaf(-n[0], tv[0], a); a = __builtin_fmaf(-n[1], tv[1], a); a = __builtin_fmaf(-n[2], tv[2], a); a = __builtin_fmaf(-n[3], tv[3], a); }
              Tl[s] = a;
          }
#pragma unroll
          for (int s8 = 0; s8 < 8; ++s8) { const f32x4 x0 = *(const LAS f32x4*)(Tl + 8 * s8), x1 = *(const LAS f32x4*)(Tl + 8 * s8 + 4);
              v4u w; w.x = pk2(x0[0], x0[1]); w.y = pk2(x0[2], x0[3]); w.z = pk2(x1[0], x1[1]); w.w = pk2(x1[2], x1[3]); *(LAS v4u*)(I0 + lane * PIT + s8 * 16) = w; }
          lwait(); }
        accT_to_img(I2, aZ, r, h); lwait();
        mm<false>(aM, I0, I2, r, h);
        accT_to_img(I2, aM, r, h);
        stage_T(I1, Kp, 2048, lane, 1.f); lwait();
        mm<false>(aM, I0, I1, r, h);
        accT_to_img(I1, aM, r, h);
        stage_nat(I0, Bt, 2048, lane); stage_nat(I3, Rh, 2048, lane); lwait();
        mm<true>(aM, I0, I3, r, h); mask_upper<false>(aM, r, h);
        accT_to_img(I0, aM, r, h); lwait();
        mm<false>(aM, I1, I0, r, h);
        { bf16* WY = proj + t0 * PT + PC_CC + hd * 64;
#pragma unroll
          for (int rt = 0; rt < 2; ++rt)
#pragma unroll
              for (int ct = 0; ct < 2; ++ct)
#pragma unroll
                  for (int g = 0; g < 4; ++g) { const int t = 32 * ct + r, j0 = 32 * rt + 8 * g + 4 * h;
                      const v2u rh = *(const v2u*)(Rh + (size_t)t * 2048 + j0); v2u w;
                      w.x = pk2(bflo(rh.x) - aM.t[rt][ct][4 * g], bfhi(rh.x) - aM.t[rt][ct][4 * g + 1]); w.y = pk2(bflo(rh.y) - aM.t[rt][ct][4 * g + 2], bfhi(rh.y) - aM.t[rt][ct][4 * g + 3]);
                      *(v2u*)(WY + (size_t)t * PT + j0) = w; } }
        mm<false>(aZ, I0, I2, r, h);
        stage_nat(I0, Kt, 2048, lane); lwait();
        mm<true>(aM, I0, I3, r, h); mask_upper<false>(aM, r, h);
        accT_to_img(I0, aM, r, h); stage_VT(I3, pv, c > 0, muv, lane); lwait();
        mm<false>(aM, I0, I3, r, h);
        { bf16* Y0 = ysc + t0 * BR + hd * 64;
#pragma unroll
          for (int rt = 0; rt < 2; ++rt)
#pragma unroll
              for (int ct = 0; ct < 2; ++ct)
#pragma unroll
                  for (int g = 0; g < 4; ++g) { const int i = 32 * ct + r, tt = 32 * rt + 8 * g + 4 * h; v2u w;
                      w.x = pk2(aM.t[rt][ct][4 * g] - aZ.t[rt][ct][4 * g], aM.t[rt][ct][4 * g + 1] - aZ.t[rt][ct][4 * g + 1]);
                      w.y = pk2(aM.t[rt][ct][4 * g + 2] - aZ.t[rt][ct][4 * g + 2], aM.t[rt][ct][4 * g + 3] - aZ.t[rt][ct][4 * g + 3]);
                      *(v2u*)(Y0 + (size_t)i * BR + tt) = w; } }
        stage_T(I0, Bt, 2048, lane, gam); lwait();
        mm<false>(aM, I1, I0, r, h);
        { bf16* GX = proj + t0 * PT + PC_CH + hd * 64;
#pragma unroll
          for (int ct = 0; ct < 2; ++ct) { const int j = 32 * ct + r; const float gj = gC[(t0 >> 6) * 512 + hd * 64 + j];
#pragma unroll
              for (int rt = 0; rt < 2; ++rt)
#pragma unroll
                  for (int g = 0; g < 4; ++g) { const int jp0 = 32 * rt + 8 * g + 4 * h; float o[4];
#pragma unroll
                      for (int e = 0; e < 4; ++e) o[e] = ((jp0 + e == j) ? gj : 0.f) - aM.t[rt][ct][4 * g + e];
                      v2u w; w.x = pk2(o[0], o[1]); w.y = pk2(o[2], o[3]); *(v2u*)(GX + (size_t)j * PT + jp0) = w; } } }
        mm<false>(aZ, I0, I2, r, h);
        stage_T(I0, Kt, 2048, lane, gam); lwait();
        mm<false>(aM, I0, I3, r, h);
        { bf16* HC = proj + t0 * PT + PC_CB + hd * 64;
#pragma unroll
          for (int rt = 0; rt < 2; ++rt)
#pragma unroll
              for (int ct = 0; ct < 2; ++ct)
#pragma unroll
                  for (int g = 0; g < 4; ++g) { const int i = 32 * ct + r, j0 = 32 * rt + 8 * g + 4 * h; v2u w;
                      w.x = pk2(aM.t[rt][ct][4 * g] - aZ.t[rt][ct][4 * g], aM.t[rt][ct][4 * g + 1] - aZ.t[rt][ct][4 * g + 1]);
                      w.y = pk2(aM.t[rt][ct][4 * g + 2] - aZ.t[rt][ct][4 * g + 2], aM.t[rt][ct][4 * g + 3] - aZ.t[rt][ct][4 * g + 3]);
                      *(v2u*)(HC + (size_t)i * PT + j0) = w; } }
        lwait();
    }
}

__device__ __forceinline__ void m2b_chunk_apply(LAS unsigned char* lds_, const int wave_s, const bf16* proj, const bf16* y0, bf16* yout) {
    using namespace ck;
    const Frame F = make_frame(lds_, wave_s);
    if (F.wave != 0) return;
    const int lane = F.lane, r = lane & 31, h = lane >> 5;
    for (int unit = F.vcu; unit < NB * NH * 2; unit += F.G) {
        const int b = unit >> 4, hd = (unit >> 1) & 7, ch = unit & 1, i = 32 * ch + r;
        f32x16 X0 = f32x16{}, X1 = f32x16{};
        const bf16* pW = proj + ((size_t)b * T + r) * PT + PC_CC + hd * 64 + 4 * h;
        const bf16* pG = proj + ((size_t)b * T + r) * PT + PC_CH + hd * 64 + 4 * h;
        const bf16* pH = proj + ((size_t)b * T + i) * PT + PC_CB + hd * 64 + 4 * h;
        const bf16* pY = y0 + ((size_t)b * T + i) * BR + hd * 64 + 4 * h;
        v2u wl[2][4], wh[2][4], gl[2][4], gh[2][4], yi[2][4], hi_[2][4];
#define AP_LOAD(cc) do { const size_t ro = (size_t)(cc) * 64; \
        _Pragma("unroll") for (int mt = 0; mt < 2; ++mt) { \
            _Pragma("unroll") for (int q = 0; q < 4; ++q) { \
                wl[mt][q] = *(const v2u*)(pW + (ro + 32 * mt) * PT + 16 * q); wh[mt][q] = *(const v2u*)(pW + (ro + 32 * mt) * PT + 16 * q + 8); \
                gl[mt][q] = *(const v2u*)(pG + (ro + 32 * mt) * PT + 16 * q); gh[mt][q] = *(const v2u*)(pG + (ro + 32 * mt) * PT + 16 * q + 8); \
                yi[mt][q] = *(const v2u*)(pY + ro * BR + 32 * mt + 8 * q); hi_[mt][q] = *(const v2u*)(pH + ro * PT + 32 * mt + 8 * q); } } } while (0)
        AP_LOAD(0);
        for (int c = 0; c < 64; ++c) {
            const size_t t0 = (size_t)b * T + 64 * c;
            const int cn = c < 63 ? c + 1 : 63;
            bf16x8 xb[2][2];
#pragma unroll
            for (int s = 0; s < 2; ++s) { v4u w;
                w.x = pk2(X0[8 * s], X0[8 * s + 1]); w.y = pk2(X0[8 * s + 2], X0[8 * s + 3]); w.z = pk2(X0[8 * s + 4], X0[8 * s + 5]); w.w = pk2(X0[8 * s + 6], X0[8 * s + 7]); xb[0][s] = __builtin_bit_cast(bf16x8, w);
                w.x = pk2(X1[8 * s], X1[8 * s + 1]); w.y = pk2(X1[8 * s + 2], X1[8 * s + 3]); w.z = pk2(X1[8 * s + 4], X1[8 * s + 5]); w.w = pk2(X1[8 * s + 6], X1[8 * s + 7]); xb[1][s] = __builtin_bit_cast(bf16x8, w); }
            f32x16 Xn[2];
            const size_t rn = (size_t)cn * 64;
#pragma unroll
            for (int mt = 0; mt < 2; ++mt) {
                f32x16 Yt;
#pragma unroll
                for (int g = 0; g < 4; ++g) { const v2u a = yi[mt][g], bq = hi_[mt][g];
                    Yt[4 * g] = bflo(a.x); Yt[4 * g + 1] = bfhi(a.x); Yt[4 * g + 2] = bflo(a.y); Yt[4 * g + 3] = bfhi(a.y);
                    Xn[mt][4 * g] = bflo(bq.x); Xn[mt][4 * g + 1] = bfhi(bq.x); Xn[mt][4 * g + 2] = bflo(bq.y); Xn[mt][4 * g + 3] = bfhi(bq.y);
                    yi[mt][g] = *(const v2u*)(pY + rn * BR + 32 * mt + 8 * g); hi_[mt][g] = *(const v2u*)(pH + rn * PT + 32 * mt + 8 * g); }
#pragma unroll
                for (int q = 0; q < 4; ++q) {
                    v4u wa; wa.x = wl[mt][q].x; wa.y = wl[mt][q].y; wa.z = wh[mt][q].x; wa.w = wh[mt][q].y; v4u ga; ga.x = gl[mt][q].x; ga.y = gl[mt][q].y; ga.z = gh[mt][q].x; ga.w = gh[mt][q].y;
                    Yt = __builtin_amdgcn_mfma_f32_32x32x16_bf16(__builtin_bit_cast(bf16x8, wa), xb[q >> 1][q & 1], Yt, 0, 0, 0);
                    Xn[mt] = __builtin_amdgcn_mfma_f32_32x32x16_bf16(__builtin_bit_cast(bf16x8, ga), xb[q >> 1][q & 1], Xn[mt], 0, 0, 0);
                    wl[mt][q] = *(const v2u*)(pW + (rn + 32 * mt) * PT + 16 * q); wh[mt][q] = *(const v2u*)(pW + (rn + 32 * mt) * PT + 16 * q + 8);
                    gl[mt][q] = *(const v2u*)(pG + (rn + 32 * mt) * PT + 16 * q); gh[mt][q] = *(const v2u*)(pG + (rn + 32 * mt) * PT + 16 * q + 8); }
                bf16* yrow = yout + (t0 + 32 * mt + 4 * h) * BR + hd * 64 + i;
#pragma unroll
                for (int reg = 0; reg < 16; ++reg) yrow[(size_t)((reg & 3) + 8 * (reg >> 2)) * BR] = (bf16)f2bf(Yt[reg]);
                asm volatile("" ::: "memory");
            }
            X0 = Xn[0]; X1 = Xn[1];
        }
#undef AP_LOAD
    }
}

#define XB ((bf16*)(WSP() + WS_XB))
#define MERGED ((bf16*)(WSP() + WS_MERGED))
#define RWX ((bf16*)(WSP() + WS_RWX))
#define Wb ((bf16*)(WSP() + WS_W))
#define PROJ ((bf16*)(WSP() + WS_PROJ))
#define OCAT ((bf16*)(WSP() + WS_OCAT))
#define YSC ((bf16*)(WSP() + WS_YSC))
#define HBUF ((bf16*)(WSP() + WS_HBUF))
#define MOEW ((bf16*)(WSP() + WS_MOEW))
#define HMOE ((bf16*)(WSP() + WS_HMOE))
#define XS ((bf16*)(WSP() + WS_XS))
#define YBUF ((bf16*)(WSP() + WS_YBUF))
#define CNT ((int*)(WSP() + WS_CTL) + CW_CNT)
#define ASG_E ((int*)(WSP() + WS_MISC + M1_ASG))
#define ASG_RANK (ASG_E + 2 * M)
#define ASG_GATE ((float*)(ASG_E + 4 * M))
#define ASG_POS (ASG_E + 6 * M)
#define TILE_E ((int*)(WSP() + WS_MISC + M1_TILE))
#define GRID_BAR() do { XcdBarrier b_; b_.bar = (unsigned*)(WSP() + WS_CTL) + CW_BAR; b_.x = xb_xcc_id(); b_.st = (volatile LAS unsigned*)(L + MISC_OFF) + 8; xcd_barrier(b_, wave_s == 0 && lane_id() == 0); } while (0)
#define GRIDSZ() ((int)gridDim.x)


#ifndef REP_ATTN
#define REP_ATTN 1
#endif
#ifndef REP_SCAN
#define REP_SCAN 1
#endif
#ifndef REP_PREP
#define REP_PREP 1
#endif
#ifndef REP_CONV
#define REP_CONV 1
#endif
#ifndef REP_P0
#define REP_P0 1
#endif
#ifndef REP_APPLY
#define REP_APPLY 1
#endif
#ifndef REP_G1
#define REP_G1 1
#endif
#ifndef REP_G3
#define REP_G3 1
#endif
#ifndef REP_G5
#define REP_G5 1
#endif
#ifndef REP_BAR
#define REP_BAR 0
#endif
#ifdef PROBE_MASK
#define STAMP() do { if (blockIdx.x == 0 && wave_s == 0 && lane_id() == 0) { volatile LAS unsigned* ms_ = (volatile LAS unsigned*)(L + MISC_OFF); \
    const unsigned long long t_ = __builtin_amdgcn_s_memrealtime(); const unsigned long long p_ = ((unsigned long long)ms_[17] << 32) | ms_[16]; const unsigned i_ = ms_[20]; \
    if ((PROBE_MASK >> i_) & 1ull) { const unsigned long long s_ = (((unsigned long long)ms_[19] << 32) | ms_[18]) + (t_ - p_); ms_[18] = (unsigned)s_; ms_[19] = (unsigned)(s_ >> 32); } \
    ms_[16] = (unsigned)t_; ms_[17] = (unsigned)(t_ >> 32); ms_[20] = i_ + 1u; } } while (0)
#else
#define STAMP() do {} while (0)
#endif
template <int l> __device__ __forceinline__ void layer_body(LAS unsigned char* const L, const int wave_s) {
    extern __shared__ __attribute__((aligned(16))) unsigned char lds[];

#ifndef NO_G1
        for (int rep_ = 0; rep_ < REP_G1; ++rep_)
        { pg8::Gemm g{XB, Wb + WO_IN + (size_t)l * W_IN_SZ, M, PT, D}; pg8::StaticOrder S; { int bx_ = blockIdx.x, G_ = gridDim.x; asm volatile("" : "+s"(bx_), "+s"(G_)); S.init(M, PT, G_, bx_); }
          pg8::EpiStoreBf16 E{PROJ, PT};
          pg8::gemm_phase<pg8::EpiStoreBf16, pg8::StaticOrder, true, true>(L + RING_OFF, g, S, E, wave_s); }
#endif
        GRID_BAR(); STAMP();
        for (int rep_ = 0; rep_ < REP_BAR; ++rep_) GRID_BAR();
#ifndef NO_ROPE
        m2a_rope(L, wave_s, PROJ);
#endif
#ifndef NO_CONV
        for (int rep_ = 0; rep_ < REP_CONV; ++rep_) m2a_conv(L, wave_s, PROJ, INP(I_CONVW) + l * 3 * BR, OCAT);
#endif
#ifndef NO_PREP
#ifdef OLD_SCAN
        for (int rep_ = 0; rep_ < REP_PREP; ++rep_) m2a_rwkv_prep(L, wave_s, l, PROJ, RWX, OCAT);
#else
#ifndef NO_CPREP
        for (int rep_ = 0; rep_ < REP_PREP; ++rep_) m2a_rwkv_prep_chunk(L, wave_s, l, PROJ, RWX, OCAT);
#endif
#endif
#endif
        GRID_BAR(); STAMP();
#ifdef OLD_SCAN
        { const Frame F = make_frame(L, wave_s);
          attn_body::attn_phase<8>((char*)lds + RING_OFF, PROJ + PC_Q, PROJ + PC_K, PROJ + PC_V, OCAT + 512, (const float*)(WSP() + WS_MISC2 + M2_KSUM), F.vcu, F.G, wave_s); }
        for (int rep_ = 0; rep_ < REP_SCAN; ++rep_) m2b_scan(L, wave_s, l, PROJ, RWX, YSC);
        GRID_BAR(); STAMP();
        m2c_rwkv_post(L, wave_s, l, PROJ, RWX, YSC, OCAT);
        GRID_BAR(); STAMP();
#else
#ifndef NO_CPRE
        for (int rep_ = 0; rep_ < REP_SCAN; ++rep_) m2b_chunk_pre(L, wave_s, l, PROJ, RWX, YSC);
#endif
        GRID_BAR(); STAMP();
        for (int rep_ = 0; rep_ < REP_ATTN; ++rep_)
        { const Frame F = make_frame(L, wave_s);
          attn_body::attn_phase<8>((char*)lds + RING_OFF, PROJ + PC_Q, PROJ + PC_K, PROJ + PC_V, OCAT + 512, (const float*)(WSP() + WS_MISC2 + M2_KSUM), F.vcu, F.G, wave_s); }
        for (int rep_ = 0; rep_ < REP_APPLY; ++rep_) m2b_chunk_apply(L, wave_s, PROJ, YSC, RWX);
        GRID_BAR(); STAMP();
        m2c_rwkv_post2(L, wave_s, l, PROJ, RWX, OCAT);
        GRID_BAR(); STAMP();
#endif
#ifndef NO_G2
        for (int rep_ = 0; rep_ < REP_G3; ++rep_)
        { pg8::Gemm g{OCAT, Wb + WO_BR + (size_t)l * W_BR_SZ, M, D, 1536}; pg8::StaticOrder S; { int bx_ = blockIdx.x, G_ = gridDim.x; asm volatile("" : "+s"(bx_), "+s"(G_)); S.init(M, D, G_, bx_); }
          pg8::EpiMerge E{MERGED, D, PROJ + PC_GATE, PT};
          pg8::gemm_phase<pg8::EpiMerge, pg8::StaticOrder, true, true>(L + RING_OFF, g, S, E, wave_s); }
#endif
        GRID_BAR(); STAMP();
#ifndef NO_G3
        { pg8::Gemm g{MERGED, Wb + WO_O + (size_t)l * W_O_SZ, M, D, D}; pg8::StaticOrder S; { int bx_ = blockIdx.x, G_ = gridDim.x; asm volatile("" : "+s"(bx_), "+s"(G_)); S.init(M, D, G_, bx_); }
          pg8::EpiResF32 E{l == 0 ? INP(I_X) : OUTP(), OUTP(), D, ALPHA};
          pg8::gemm_phase<pg8::EpiResF32, pg8::StaticOrder, true, true>(L + RING_OFF, g, S, E, wave_s); }
#endif
#ifndef NO_MOEW
        if (l == 1) moe_weight_prologue(L, wave_s);
#endif
        GRID_BAR(); STAMP();
        if (l == 0) {
            ln_pass<false, true>(L, wave_s, INP(I_LN1G), INP(I_LN1B), OUTP(), XB, nullptr, nullptr, nullptr, nullptr, nullptr);
            GRID_BAR(); STAMP();
#ifndef NO_G4
            for (int rep_ = 0; rep_ < REP_G5; ++rep_)
            { pg8::Gemm g{XB, Wb + WO_GU, M, 2 * DFF, D}; pg8::StaticOrder S; { int bx_ = blockIdx.x, G_ = gridDim.x; asm volatile("" : "+s"(bx_), "+s"(G_)); S.init(M, 2 * DFF, G_, bx_); }
              pg8::EpiSwiGLU E{HBUF, DFF};
              pg8::gemm_phase<pg8::EpiSwiGLU, pg8::StaticOrder, true, true>(L + RING_OFF, g, S, E, wave_s); }
#endif
            GRID_BAR(); STAMP();
#ifndef NO_G5
            { pg8::Gemm g{HBUF, Wb + WO_D, M, D, DFF}; pg8::StaticOrder S; { int bx_ = blockIdx.x, G_ = gridDim.x; asm volatile("" : "+s"(bx_), "+s"(G_)); S.init(M, D, G_, bx_); }
              pg8::EpiResF32 E{OUTP(), OUTP(), D, ALPHA};
              pg8::gemm_phase<pg8::EpiResF32, pg8::StaticOrder, true, true>(L + RING_OFF, g, S, E, wave_s); }
#endif
            GRID_BAR(); STAMP();
            ln_pass<false, true>(L, wave_s, INP(I_LN2G), INP(I_LN2B), OUTP(), XB, nullptr, nullptr, nullptr, nullptr, nullptr);
            GRID_BAR(); STAMP();
        } else {
            ln_pass<true, true>(L, wave_s, INP(I_LN1G) + D, INP(I_LN1B) + D, OUTP(), XB, INP(I_RW), CNT, ASG_E, ASG_RANK, ASG_GATE);
            GRID_BAR(); STAMP();
#ifndef NO_SCAT
            moe_scatter(L, wave_s, CNT, ASG_E, ASG_RANK, ASG_POS, XB, XS, TILE_E);
#endif
            GRID_BAR(); STAMP();
            const int ntiles = __builtin_amdgcn_readfirstlane(TILE_E[MOE_MAXT]);
#ifndef NO_G6
            { pg8::Gemm g{XS, MOEW, ntiles * 256, 2 * DFF, D}; pg8::MoeOrder S; { int bx_ = blockIdx.x, G_ = gridDim.x; asm volatile("" : "+s"(bx_), "+s"(G_)); S.init(ntiles * 256, 2 * DFF, G_, bx_); } S.tile_e = TILE_E; S.estride = MOE_E_SZ * 2;
              pg8::EpiSwiGLU E{HMOE, DFF};
              pg8::gemm_phase<pg8::EpiSwiGLU, pg8::MoeOrder, true, true>(L + RING_OFF, g, S, E, wave_s); }
#endif
            GRID_BAR(); STAMP();
#ifndef NO_G7
            { pg8::Gemm g{HMOE, MOEW + W_GU_SZ, ntiles * 256, D, DFF}; pg8::MoeOrder S; { int bx_ = blockIdx.x, G_ = gridDim.x; asm volatile("" : "+s"(bx_), "+s"(G_)); S.init(ntiles * 256, D, G_, bx_); } S.tile_e = TILE_E; S.estride = MOE_E_SZ * 2;
              pg8::EpiStoreBf16 E{YBUF, D};
              pg8::gemm_phase<pg8::EpiStoreBf16, pg8::MoeOrder, true, true>(L + RING_OFF, g, S, E, wave_s); }
#endif
            GRID_BAR(); STAMP();
            moe_final_ln(L, wave_s, INP(I_LN2G) + D, INP(I_LN2B) + D, OUTP(), YBUF, ASG_POS, ASG_GATE);
        }
    }

struct Args { const float* in[27]; float* out; unsigned char* ws; };
__global__ void __launch_bounds__(NWAVES * 64, 2) mega_fwd(Args args) {
    extern __shared__ __attribute__((aligned(16))) unsigned char lds[];
    LAS unsigned char* const L = (LAS unsigned char*)lds;
    const int wave_s = __builtin_amdgcn_readfirstlane((int)threadIdx.x >> 6);
    for (int u = wave_s * 64 + lane_id(); u < (LDS_BYTES - LDSCTL_OFF) / 4; u += NWAVES * 64) ((LAS unsigned*)(L + LDSCTL_OFF))[u] = 0u;
    __syncthreads();
#ifdef PROBE_MASK
    if (blockIdx.x == 0 && wave_s == 0 && lane_id() == 0) { volatile LAS unsigned* ms_ = (volatile LAS unsigned*)(L + MISC_OFF); const unsigned long long t_ = __builtin_amdgcn_s_memrealtime(); ms_[16] = (unsigned)t_; ms_[17] = (unsigned)(t_ >> 32); }
#endif
    (void)xcd_barrier_post((unsigned*)(WSP() + WS_CTL) + CW_BAR, (volatile LAS unsigned*)(L + MISC_OFF) + 8, wave_s == 0 && lane_id() == 0);

#ifndef NO_P0
    for (int rep_ = 0; rep_ < REP_P0; ++rep_) p0_prologue(L, wave_s);
#endif
    GRID_BAR(); STAMP();
    layer_body<0>(L, wave_s);
    layer_body<1>(L, wave_s);
    if (xb_ld((unsigned*)(WSP() + WS_CTL) + CW_BAR + XB_TMO) != 0u) {
        __syncthreads();
        const float q = __builtin_nanf("");
        for (size_t i = (size_t)blockIdx.x * 512 + wave_s * 64 + lane_id(); i < (size_t)M * D; i += (size_t)GRIDSZ() * 512) OUTP()[i] = q;
    }
}

extern "C" void kernel_launch(void* const* d_in, const int* in_sizes, int n_in, void* d_out, int out_size, void* d_ws, size_t ws_size, hipStream_t stream) {
    static int grid = 0;
    if (grid == 0) {
        int dev = 0, cus = 0;
        if (n_in != 27 || out_size != M * D || ws_size < WS_END) { fprintf(stderr, "kernel_launch: unexpected problem geometry (n_in %d out %d ws %zu)\n", n_in, out_size, ws_size); grid = -1; return; }
        if (hipGetDevice(&dev) != hipSuccess || hipDeviceGetAttribute(&cus, hipDeviceAttributeMultiprocessorCount, dev) != hipSuccess) { grid = -1; return; }
        if (hipFuncSetAttribute((const void*)mega_fwd, hipFuncAttributeMaxDynamicSharedMemorySize, LDS_BYTES) != hipSuccess) { grid = -1; return; }
        grid = cus;
    }
    if (grid < 0) return;
    if (hipMemsetAsync((char*)d_ws + WS_CTL, 0, CTL_ZERO_BYTES, stream) != hipSuccess) return;
    Args a{};
    for (int i = 0; i < 27; ++i) a.in[i] = (const float*)d_in[i];
    a.out = (float*)d_out; a.ws = (unsigned char*)d_ws;
    hipLaunchKernelGGL(mega_fwd, dim3(grid), dim3(NWAVES * 64), LDS_BYTES, stream, a);
}
```

```cpp
#include <hip/hip_runtime.h>
#include <cstdio>
#include <cstdint>
#include <cmath>
namespace pg8 {
#define PG8_LAS __attribute__((address_space(3)))
typedef unsigned short bf16_t;
typedef short bf16x8 __attribute__((ext_vector_type(8)));
typedef float f32x4 __attribute__((ext_vector_type(4)));
typedef unsigned u32x4 __attribute__((ext_vector_type(4)));
constexpr int BM = 256, BK = 64, HALF = 128, HTB = HALF * BK * 2  , STAGE_BYTES = 8 * HTB, NXCD = 8, WGM = 8;

__host__ __device__ __forceinline__ int lds_byte(int r, int c) { const int st = (r >> 4) * 2 + (c >> 5), rr = r & 15, cc = c & 31, ob = rr * 64 + cc * 2; return st * 1024 + (ob ^ (((ob >> 9) & 1) << 5)); }
__host__ __device__ __forceinline__ void stage_rc(int b, int& R, int& C) { const int st = b / 1024, sb = b % 1024, swz = sb ^ (((sb >> 9) & 1) << 5); R = (st >> 1) * 16 + swz / 64; C = (st & 1) * 32 + (swz % 64) / 2; }
__host__ __device__ __forceinline__ int perm32(int rho) { const int n = rho >> 4, i = rho & 15; return 8 * (i >> 2) + 4 * n + (i & 3); }

struct Unit { int pm, pn; };
struct Gemm { const bf16_t* A; const bf16_t* Bt; int M, N, K; };

struct StaticOrder {
    int nM, nN, nwg, G, c;
    __host__ __device__ void init(int M, int N, int G_, int c_) { nM = M / BM; nN = N / BM; nwg = nM * nN; G = G_; c = c_; }
    __host__ __device__ bool next(int i, Unit& u) const {
        const long L = (long)i * G + c; if (L >= nwg) return false;
        int wgid = (int)L; { const int q = nwg / NXCD, r = nwg % NXCD, xcd = wgid % NXCD, off = wgid / NXCD; wgid = (xcd < r ? xcd * (q + 1) : r * (q + 1) + (xcd - r) * q) + off; }
        const int nig = WGM * nN, gid = wgid / nig, fm = gid * WGM, gsz = (nM - fm) < WGM ? (nM - fm) : WGM;
        u.pm = fm + ((wgid % nig) % gsz); u.pn = (wgid % nig) / gsz; return true;
    }
    __device__ __forceinline__ void a_ready(const Unit&) const {}
    __device__ __forceinline__ void done(const Unit&) const {}
    __device__ __forceinline__ size_t boff(const Unit&) const { return 0; }
};

__device__ __forceinline__ unsigned cvt_pk_bf16(float lo, float hi) { unsigned r; asm volatile("v_cvt_pk_bf16_f32 %0, %1, %2" : "=v"(r) : "v"(lo), "v"(hi)); return r; }
__device__ __forceinline__ float bf_lo(unsigned w) { return __uint_as_float(w << 16); }
__device__ __forceinline__ float bf_hi(unsigned w) { return __uint_as_float(w & 0xffff0000u); }
__device__ __forceinline__ float fast_exp(float x) { return __builtin_amdgcn_exp2f(x * 1.4426950408889634f); }
__device__ __forceinline__ float fast_sigmoid(float x) { return __builtin_amdgcn_rcpf(1.0f + fast_exp(-x)); }

struct EpiStoreBf16 {
    static constexpr bool PERM = true, AFTER_DRAIN = false, KHOOK = false;
    bf16_t* O; int ldc;
    __device__ __forceinline__ void khook(f32x4 (&)[2][2][4][2], const Unit&, int, int, int, int, int) const {}
    __device__ __forceinline__ void operator()(const f32x4 (&acc)[2][2][4][2], const Unit& u, int wr, int wc, int fr, int fq) const {
        const int row0 = u.pm * BM + wr * 64 + fr, col0 = u.pn * BM + wc * 32 + 8 * fq;
#pragma unroll
        for (int ai = 0; ai < 2; ++ai)
#pragma unroll
            for (int m = 0; m < 4; ++m) { bf16_t* rowp = O + (size_t)(row0 + ai * HALF + m * 16) * ldc + col0;
#pragma unroll
                for (int bj = 0; bj < 2; ++bj) { const f32x4 v0 = acc[ai][bj][m][0], v1 = acc[ai][bj][m][1];
                    u32x4 w; w.x = cvt_pk_bf16(v0[0], v0[1]); w.y = cvt_pk_bf16(v0[2], v0[3]); w.z = cvt_pk_bf16(v1[0], v1[1]); w.w = cvt_pk_bf16(v1[2], v1[3]);
                    *(u32x4*)(rowp + bj * HALF) = w; } }
    }
};

struct EpiMerge {
    static constexpr bool PERM = true, AFTER_DRAIN = false, KHOOK = true;
    bf16_t* O; int ldc; const bf16_t* gates; int ldg;
    __device__ __forceinline__ void khook(f32x4 (&acc)[2][2][4][2], const Unit& u, int t, int wr, int wc, int fr, int fq) const {
        const int b = (t >> 3) - 1;
        int fr_ = fr, fq_ = fq; asm volatile("" : "+v"(fr_), "+v"(fq_));
        const int row0 = u.pm * BM + wr * 64 + fr_, col0 = u.pn * BM + wc * 32 + 8 * fq_;
#pragma unroll
        for (int ai = 0; ai < 2; ++ai)
#pragma unroll
            for (int m = 0; m < 4; ++m) { const bf16_t* gp = gates + (size_t)(row0 + ai * HALF + m * 16) * ldg + b * 1024 + col0;
#pragma unroll
                for (int bj = 0; bj < 2; ++bj) { const u32x4 ga = *(const u32x4*)(gp + bj * HALF), gb = *(const u32x4*)(gp + bj * HALF + 1024);
                    const unsigned aw[4] = {ga.x, ga.y, ga.z, ga.w}, bw[4] = {gb.x, gb.y, gb.z, gb.w};
#pragma unroll
                    for (int q = 0; q < 4; ++q) {
                        const float r0 = (1.0f + fast_exp(-bf_lo(bw[q]))) * __builtin_amdgcn_rcpf(1.0f + fast_exp(-bf_lo(aw[q])));
                        const float r1 = (1.0f + fast_exp(-bf_hi(bw[q]))) * __builtin_amdgcn_rcpf(1.0f + fast_exp(-bf_hi(aw[q])));
                        acc[ai][bj][m][q >> 1][(q & 1) * 2 + 0] *= r0; acc[ai][bj][m][q >> 1][(q & 1) * 2 + 1] *= r1; }
                    asm volatile("" ::: "memory"); } }
    }
    __device__ __forceinline__ void operator()(const f32x4 (&acc)[2][2][4][2], const Unit& u, int wr, int wc, int fr, int fq) const {
        const int row0 = u.pm * BM + wr * 64 + fr, col0 = u.pn * BM + wc * 32 + 8 * fq;
#pragma unroll
        for (int ai = 0; ai < 2; ++ai)
#pragma unroll
            for (int m = 0; m < 4; ++m) { const size_t r = (size_t)(row0 + ai * HALF + m * 16); const bf16_t* gp = gates + r * ldg + 2 * 1024 + col0; bf16_t* rowp = O + r * ldc + col0;
#pragma unroll
                for (int bj = 0; bj < 2; ++bj) { const u32x4 gc = *(const u32x4*)(gp + bj * HALF); const f32x4 v0 = acc[ai][bj][m][0], v1 = acc[ai][bj][m][1];
                    u32x4 w;
                    w.x = cvt_pk_bf16(v0[0] * fast_sigmoid(bf_lo(gc.x)), v0[1] * fast_sigmoid(bf_hi(gc.x)));
                    w.y = cvt_pk_bf16(v0[2] * fast_sigmoid(bf_lo(gc.y)), v0[3] * fast_sigmoid(bf_hi(gc.y)));
                    w.z = cvt_pk_bf16(v1[0] * fast_sigmoid(bf_lo(gc.z)), v1[1] * fast_sigmoid(bf_hi(gc.z)));
                    w.w = cvt_pk_bf16(v1[2] * fast_sigmoid(bf_lo(gc.w)), v1[3] * fast_sigmoid(bf_hi(gc.w)));
                    *(u32x4*)(rowp + bj * HALF) = w; asm volatile("" ::: "memory"); } }
    }
};

struct EpiSwiGLU {
    static constexpr bool PERM = true, AFTER_DRAIN = false, KHOOK = false;
    bf16_t* O; int ldc;
    __device__ __forceinline__ void khook(f32x4 (&)[2][2][4][2], const Unit&, int, int, int, int, int) const {}
    __device__ __forceinline__ void operator()(const f32x4 (&acc)[2][2][4][2], const Unit& u, int wr, int wc, int fr, int fq) const {
        const int row0 = u.pm * BM + wr * 64 + fr, col0 = u.pn * HALF + wc * 32 + 8 * fq;
#pragma unroll
        for (int ai = 0; ai < 2; ++ai)
#pragma unroll
            for (int m = 0; m < 4; ++m) { bf16_t* rowp = O + (size_t)(row0 + ai * HALF + m * 16) * ldc + col0;
                float h[8];
#pragma unroll
                for (int n = 0; n < 2; ++n)
#pragma unroll
                    for (int i = 0; i < 4; ++i) { const float g = acc[ai][0][m][n][i], up = acc[ai][1][m][n][i]; h[n * 4 + i] = g * fast_sigmoid(g) * up; }
                u32x4 w; w.x = cvt_pk_bf16(h[0], h[1]); w.y = cvt_pk_bf16(h[2], h[3]); w.z = cvt_pk_bf16(h[4], h[5]); w.w = cvt_pk_bf16(h[6], h[7]);
                *(u32x4*)rowp = w; }
    }
};

struct EpiResF32 {
    static constexpr bool PERM = false, AFTER_DRAIN = false, KHOOK = false;
    const float* base; float* out; int ldc; float alpha;
    __device__ __forceinline__ void khook(f32x4 (&)[2][2][4][2], const Unit&, int, int, int, int, int) const {}
    __device__ __forceinline__ void operator()(const f32x4 (&acc)[2][2][4][2], const Unit& u, int wr, int wc, int fr, int fq) const {
        const int row0 = u.pm * BM + wr * 64 + fr, col0 = u.pn * BM + wc * 32 + 4 * fq;
#pragma unroll
        for (int ai = 0; ai < 2; ++ai)
#pragma unroll
            for (int m = 0; m < 4; ++m) { const size_t off = (size_t)(row0 + ai * HALF + m * 16) * ldc + col0;
#pragma unroll
                for (int bj = 0; bj < 2; ++bj)
#pragma unroll
                    for (int n = 0; n < 2; ++n) { const f32x4 bs = *(const f32x4*)(base + off + bj * HALF + n * 16); *(f32x4*)(out + off + bj * HALF + n * 16) = bs * alpha + acc[ai][bj][m][n]; } }
    }
};

struct MoeOrder : StaticOrder {
    const int* tile_e; size_t estride;
    __device__ __forceinline__ size_t boff(const Unit& u) const { return (size_t)__builtin_amdgcn_readfirstlane(tile_e[u.pm]) * estride; }
};

template <class Epi, class Sched, bool ALIGN_EPI = false, bool SP2 = false>
__device__ __forceinline__ void gemm_phase(PG8_LAS unsigned char* lds, const Gemm g, const Sched& S, const Epi& E, const int wave_s) {
    int lane_; asm volatile("v_mbcnt_lo_u32_b32 %0, -1, 0\n\tv_mbcnt_hi_u32_b32 %0, -1, %0" : "=v"(lane_));
    const int tid = wave_s * 64 + lane_, wid = wave_s, lane = tid & 63, wr = wid >> 2, wc = wid & 3, fr = lane & 15, fq = lane >> 4;
    const int K = g.K, nt = K / BK;
    unsigned voffA[2], voffB[2];
#pragma unroll
    for (int i = 0; i < 2; ++i) { int R, C; stage_rc(tid * 16 + i * 8192, R, C); const int Rb = Epi::PERM ? ((R & ~31) + perm32(R & 31)) : R;
        voffA[i] = (unsigned)(R * K + C) * 2u; voffB[i] = (unsigned)(Rb * K + C) * 2u; }
    const size_t kstep = (size_t)(BK * 2);
    const size_t hstep = (size_t)HALF * K * 2;
    const size_t tstep = 2 * hstep;
    const unsigned ldsw = (unsigned)wid * 1024u;
    const int aoff = lds_byte(wr * 64 + fr, fq * 8), boff = lds_byte(wc * 32 + fr, fq * 8);
#define PG8_SA(b, h) (((b) * 2 + (h)) * HTB)
#define PG8_SB(b, h) ((4 + (b) * 2 + (h)) * HTB)
#define PG8_STAGE(bufoff, gbase, voff) do { _Pragma("unroll") for (int _i = 0; _i < 2; ++_i) \
        __builtin_amdgcn_global_load_lds((const unsigned*)((const char*)(gbase) + (voff)[_i]), (PG8_LAS unsigned*)(lds + (bufoff) + ldsw + _i * 8192), 16, 0, 0); } while (0)
#define PG8_LDA(dst, b, h) do { _Pragma("unroll") for (int m = 0; m < 4; ++m) _Pragma("unroll") for (int k = 0; k < 2; ++k) dst[m][k] = *(const PG8_LAS bf16x8*)(lds + PG8_SA(b, h) + aoff + m * 2048 + k * 1024); } while (0)
#define PG8_LDB(dst, b, h) do { _Pragma("unroll") for (int n = 0; n < 2; ++n) _Pragma("unroll") for (int k = 0; k < 2; ++k) dst[n][k] = *(const PG8_LAS bf16x8*)(lds + PG8_SB(b, h) + boff + n * 2048 + k * 1024); } while (0)
#define PG8_MMA(ai, bj, At, Bt) do { __builtin_amdgcn_s_setprio(1); _Pragma("unroll") for (int m = 0; m < 4; ++m) _Pragma("unroll") for (int n = 0; n < 2; ++n) _Pragma("unroll") for (int k = 0; k < 2; ++k) \
        acc[ai][bj][m][n] = __builtin_amdgcn_mfma_f32_16x16x32_bf16(Bt[n][k], At[m][k], acc[ai][bj][m][n], 0, 0, 0); __builtin_amdgcn_s_setprio(0); } while (0)
#define PG8_WAIT_V(n) asm volatile("s_waitcnt vmcnt(" #n ")" ::: "memory")
#define PG8_WAIT_L(n) asm volatile("s_waitcnt lgkmcnt(" #n ")" ::: "memory")
#define PG8_BAR __builtin_amdgcn_s_barrier()
#define PG8_SCHED __builtin_amdgcn_sched_barrier(0)
    Unit cur, nxt; int ui = 0;
    if (!S.next(0, cur)) return;
    f32x4 acc[2][2][4][2];
#pragma unroll
    for (int a = 0; a < 2; ++a)
#pragma unroll
        for (int b = 0; b < 2; ++b)
#pragma unroll
            for (int m = 0; m < 4; ++m)
#pragma unroll
                for (int n = 0; n < 2; ++n) acc[a][b][m][n] = (f32x4){0.f, 0.f, 0.f, 0.f};
    bf16x8 At[4][2], B0[2][2], B1[2][2];
    const char* cA = (const char*)g.A + (size_t)cur.pm * tstep; const char* cB = (const char*)g.Bt + (size_t)cur.pn * tstep + S.boff(cur);
    S.a_ready(cur);
    if constexpr (SP2) {
        PG8_STAGE(PG8_SB(0, 0), cB, voffB); PG8_STAGE(PG8_SB(0, 1), cB + hstep, voffB); PG8_STAGE(PG8_SA(0, 0), cA, voffA); PG8_STAGE(PG8_SA(0, 1), cA + hstep, voffA);
        if (wr == 1) PG8_BAR;
        PG8_WAIT_V(2); PG8_BAR;
        PG8_STAGE(PG8_SB(1, 0), cB + kstep, voffB); PG8_STAGE(PG8_SA(1, 0), cA + kstep, voffA); PG8_STAGE(PG8_SB(1, 1), cB + hstep + kstep, voffB);
        PG8_WAIT_V(6); PG8_BAR;
    } else {
        PG8_STAGE(PG8_SB(0, 0), cB, voffB); PG8_STAGE(PG8_SA(0, 0), cA, voffA); PG8_STAGE(PG8_SB(0, 1), cB + hstep, voffB); PG8_STAGE(PG8_SA(0, 1), cA + hstep, voffA);
        if (wr == 1) PG8_BAR;
        PG8_WAIT_V(4); PG8_BAR;
        PG8_STAGE(PG8_SB(1, 0), cB + kstep, voffB); PG8_STAGE(PG8_SA(1, 0), cA + kstep, voffA); PG8_STAGE(PG8_SB(1, 1), cB + hstep + kstep, voffB);
        PG8_WAIT_V(6); PG8_BAR;
    }
    for (;;) {
        const bool has_next = S.next(ui + 1, nxt);
        const char* nA = has_next ? (const char*)g.A + (size_t)nxt.pm * tstep : cA; const char* nB = has_next ? (const char*)g.Bt + (size_t)nxt.pn * tstep + S.boff(nxt) : cB;
        for (int t = 0; t < nt; t += 2) {
            if constexpr (Epi::KHOOK) { if (t == 8 || t == 16) E.khook(acc, cur, t, wr, wc, fr, fq); }
            const bool last = (t == nt - 2);
            const char* a1 = cA + (size_t)(t + 1) * kstep;
            const char* a2 = last ? nA : cA + (size_t)(t + 2) * kstep; const char* b2 = last ? nB : cB + (size_t)(t + 2) * kstep;
            const char* a3 = a2 + kstep; const char* b3 = b2 + kstep;
            if (last && has_next) S.a_ready(nxt);
            if constexpr (SP2) {
            PG8_LDB(B0, 0, 0); PG8_LDB(B1, 0, 1); PG8_SCHED; PG8_LDA(At, 0, 0); PG8_STAGE(PG8_SA(1, 1), a1 + hstep, voffA);
            PG8_WAIT_V(8); PG8_WAIT_L(0); PG8_BAR; PG8_MMA(0, 0, At, B0); PG8_MMA(0, 1, At, B1); PG8_BAR; PG8_SCHED;
            PG8_LDA(At, 0, 1); PG8_STAGE(PG8_SB(0, 0), b2, voffB); PG8_STAGE(PG8_SB(0, 1), b2 + hstep, voffB); PG8_STAGE(PG8_SA(0, 0), a2, voffA);
            PG8_WAIT_V(8); PG8_WAIT_L(0); PG8_BAR; PG8_MMA(1, 0, At, B0); PG8_MMA(1, 1, At, B1); PG8_BAR; PG8_SCHED;
            PG8_LDB(B0, 1, 0); PG8_LDB(B1, 1, 1); PG8_SCHED; PG8_LDA(At, 1, 0); PG8_STAGE(PG8_SA(0, 1), a2 + hstep, voffA);
            PG8_WAIT_V(8); PG8_WAIT_L(0); PG8_BAR; PG8_MMA(0, 0, At, B0); PG8_MMA(0, 1, At, B1); PG8_BAR; PG8_SCHED;
            PG8_LDA(At, 1, 1); PG8_STAGE(PG8_SB(1, 0), b3, voffB); PG8_STAGE(PG8_SB(1, 1), b3 + hstep, voffB); PG8_STAGE(PG8_SA(1, 0), a3, voffA);
            PG8_WAIT_V(8); PG8_WAIT_L(0); PG8_BAR; PG8_MMA(1, 0, At, B0); PG8_MMA(1, 1, At, B1); PG8_BAR; PG8_SCHED;
            } else {
            PG8_LDB(B0, 0, 0); PG8_SCHED; PG8_LDA(At, 0, 0); PG8_STAGE(PG8_SA(1, 1), a1 + hstep, voffA);
            PG8_WAIT_L(8); PG8_BAR; PG8_WAIT_L(0); PG8_MMA(0, 0, At, B0); PG8_BAR; PG8_SCHED;
            PG8_LDB(B1, 0, 1); PG8_STAGE(PG8_SB(0, 0), b2, voffB);
            PG8_BAR; PG8_WAIT_L(0); PG8_MMA(0, 1, At, B1); PG8_BAR;
            PG8_LDA(At, 0, 1); PG8_STAGE(PG8_SA(0, 0), a2, voffA);
            PG8_BAR; PG8_WAIT_L(0); PG8_MMA(1, 0, At, B0); PG8_BAR; PG8_SCHED;
            PG8_STAGE(PG8_SB(0, 1), b2 + hstep, voffB);
            PG8_WAIT_V(6); PG8_BAR; PG8_MMA(1, 1, At, B1); PG8_BAR;
            PG8_LDB(B0, 1, 0); PG8_SCHED; PG8_LDA(At, 1, 0); PG8_STAGE(PG8_SA(0, 1), a2 + hstep, voffA);
            PG8_WAIT_L(8); PG8_BAR; PG8_WAIT_L(0); PG8_MMA(0, 0, At, B0); PG8_BAR; PG8_SCHED;
            PG8_LDB(B1, 1, 1); PG8_STAGE(PG8_SB(1, 0), b3, voffB);
            PG8_BAR; PG8_WAIT_L(0); PG8_MMA(0, 1, At, B1); PG8_BAR;
            PG8_LDA(At, 1, 1); PG8_STAGE(PG8_SA(1, 0), a3, voffA);
            PG8_BAR; PG8_WAIT_L(0); PG8_MMA(1, 0, At, B0); PG8_BAR; PG8_SCHED;
            PG8_STAGE(PG8_SB(1, 1), b3 + hstep, voffB);
            PG8_WAIT_V(6); PG8_BAR; PG8_MMA(1, 1, At, B1); PG8_BAR;
            }
        }
        if constexpr (ALIGN_EPI) { if (wr == 0) PG8_BAR; }
        if constexpr (!Epi::AFTER_DRAIN) { E(acc, cur, wr, wc, fr, fq); S.done(cur); }
        if (!has_next) break;
#pragma unroll
        for (int a = 0; a < 2; ++a)
#pragma unroll
            for (int b = 0; b < 2; ++b)
#pragma unroll
                for (int m = 0; m < 4; ++m)
#pragma unroll
                    for (int n = 0; n < 2; ++n) acc[a][b][m][n] = (f32x4){0.f, 0.f, 0.f, 0.f};
        cur = nxt; cA = nA; cB = nB; ++ui;
        if constexpr (ALIGN_EPI) { if (wr == 1) PG8_BAR; }
    }
    PG8_WAIT_V(0);
    if constexpr (!ALIGN_EPI) { if (wr == 0) PG8_BAR; }
    PG8_BAR;
    if constexpr (Epi::AFTER_DRAIN) { E.fused(acc, cur, wr, wc, fr, fq, lds, wid, lane); S.done(cur); }
#undef PG8_SA
#undef PG8_SB
#undef PG8_STAGE
#undef PG8_LDA
#undef PG8_LDB
#undef PG8_MMA
#undef PG8_WAIT_V
#undef PG8_WAIT_L
#undef PG8_BAR
#undef PG8_SCHED
}

}

constexpr int NWAVES = 8;
constexpr int D = 1024, NB = 4, T = 4096, M = NB * T, BR = 512, NH = 8, PT = 7936, DFF = 2816, NE = 8, SHIFT = 1792;
constexpr float LN_EPS = 1e-5f, GN_EPS = 64e-5f;
constexpr float ALPHA = 1.41421356237309515f;
constexpr float C2 = 0.125f * 1.4426950408889634f;
constexpr int PC_CH = 0, PC_CB = 512, PC_CC = 1024, PC_Q = 1536, PC_K = 2048, PC_V = 2560, PC_R = 3072, PC_RK = 3584, PC_RV = 4096, PC_WL = 4608, PC_AL = 4672, PC_GL = 4736, PC_GATE = 4864;
constexpr int MOE_MAXT = 136, MOE_ROWS_MAX = MOE_MAXT * 256;

constexpr size_t MiB = 1u << 20;
constexpr size_t WS_CTL = 0, CTL_ZERO_BYTES = 1 * MiB;
constexpr size_t WS_MISC = 1 * MiB;
constexpr size_t WS_XB = 2 * MiB;
constexpr size_t WS_MERGED = 34 * MiB;
constexpr size_t WS_RWX = 2 * MiB;
constexpr size_t WS_W = 66 * MiB;
constexpr size_t WS_PROJ = 124 * MiB;
constexpr size_t WS_OCAT = 372 * MiB;
constexpr size_t WS_YSC = 420 * MiB;
constexpr size_t WS_MISC2 = 436 * MiB;
constexpr size_t WS_HBUF = WS_PROJ;
constexpr size_t WS_MOEW = 124 * MiB;
constexpr size_t WS_HMOE = 256 * MiB;
constexpr size_t WS_XS = 34 * MiB;
constexpr size_t WS_YBUF = 2 * MiB;
constexpr size_t WS_END = 444 * MiB;
constexpr size_t W_IN_SZ = (size_t)PT * D, W_BR_SZ = (size_t)D * 1536, W_O_SZ = (size_t)D * D, W_GU_SZ = (size_t)2 * DFF * D, W_D_SZ = (size_t)D * DFF;
constexpr size_t WO_IN = 0, WO_BR = WO_IN + 2 * W_IN_SZ, WO_O = WO_BR + 2 * W_BR_SZ, WO_GU = WO_O + 2 * W_O_SZ, WO_D = WO_GU + W_GU_SZ, WO_END = WO_D + W_D_SZ;
static_assert(WO_END * 2 <= 58 * MiB, "weights fit");
constexpr size_t MOE_E_SZ = W_GU_SZ + W_D_SZ;
static_assert(WS_MOEW + NE * MOE_E_SZ * 2 <= WS_HMOE, "moe weights fit");
static_assert(WS_HMOE + (size_t)MOE_ROWS_MAX * DFF * 2 <= WS_END, "hmoe fits");
constexpr size_t M2_ROPE = 0;
constexpr size_t M2_KSUM = 1 * MiB;
constexpr size_t M2_GC = 2 * MiB;
constexpr size_t M2_LORAT = 4 * MiB;
constexpr size_t M2_BONUS = 3 * MiB;
constexpr size_t M1_ASG = 0;
constexpr size_t M1_TILE = 768 * 1024;
constexpr int CW_BAR = 4096;
constexpr int CW_CNT = 64;

constexpr int RING_OFF = 0, RING_BYTES = 131072;
constexpr int LDSCTL_OFF = 147456, MISC_OFF = LDSCTL_OFF + 320;
constexpr int LDS_BYTES = 151552;

#define GAS __attribute__((address_space(1)))
#define LAS __attribute__((address_space(3)))
typedef unsigned short bf16;
typedef unsigned v4u __attribute__((ext_vector_type(4)));
typedef unsigned v2u __attribute__((ext_vector_type(2)));
typedef float f32x4 __attribute__((ext_vector_type(4)));
typedef GAS unsigned gu32;
#define RLX_AGENT __ATOMIC_RELAXED, __HIP_MEMORY_SCOPE_AGENT
#define LDS_WAIT() asm volatile("s_waitcnt lgkmcnt(0)" ::: "memory")
typedef float f32x2_c __attribute__((ext_vector_type(2))); typedef __bf16 bf16x2_c __attribute__((ext_vector_type(2)));
__device__ __forceinline__ unsigned pk2(float lo, float hi) { f32x2_c v = {lo, hi}; bf16x2_c b = __builtin_convertvector(v, bf16x2_c); return __builtin_bit_cast(unsigned, b); }
__device__ __forceinline__ unsigned f2bf(float f) { return pk2(f, 0.f) & 0xffffu; }
__device__ __forceinline__ float bflo(unsigned w) { return __uint_as_float(w << 16); }
__device__ __forceinline__ float bfhi(unsigned w) { return __uint_as_float(w & 0xffff0000u); }
__device__ __forceinline__ float bf1(bf16 h) { return __uint_as_float((unsigned)h << 16); }
__device__ __forceinline__ void unpack8(const v4u w, float (&f)[8]) { f[0] = bflo(w.x); f[1] = bfhi(w.x); f[2] = bflo(w.y); f[3] = bfhi(w.y); f[4] = bflo(w.z); f[5] = bfhi(w.z); f[6] = bflo(w.w); f[7] = bfhi(w.w); }
__device__ __forceinline__ v4u pack8(const float (&f)[8]) { v4u w; w.x = pk2(f[0], f[1]); w.y = pk2(f[2], f[3]); w.z = pk2(f[4], f[5]); w.w = pk2(f[6], f[7]); return w; }
__device__ __forceinline__ float wave_sum(float v) {
#pragma unroll
    for (int o = 1; o < 64; o <<= 1) v += __shfl_xor(v, o);
    return v;
}
__device__ __forceinline__ float sum8lanes(float v) { v += __shfl_xor(v, 1); v += __shfl_xor(v, 2); v += __shfl_xor(v, 4); return v; }
__device__ __forceinline__ float sigmoidf_(float x) { return 1.f / (1.f + expf(-x)); }

__device__ __forceinline__ int lane_id() { int r; asm volatile("v_mbcnt_lo_u32_b32 %0, -1, 0\n\tv_mbcnt_hi_u32_b32 %0, -1, %0" : "=v"(r)); return r; }
#define XB_TMO      128
#define XB_XCNT(j)  (256  + 64 * (j))
#define XB_XSUB(j)  (1280 + 64 * (j))
#define XB_XGEN(j)  (2304 + 64 * (j))
#define XB_TOP      3328
#define XB_TOPGEN   3392
#define XCD_BAR_WORDS 3456
#define XB_SPIN_CAP (1u << 18)
__device__ __forceinline__ unsigned xb_ld(unsigned* p)              { return __hip_atomic_load(p, __ATOMIC_RELAXED, __HIP_MEMORY_SCOPE_AGENT); }
__device__ __forceinline__ unsigned xb_add(unsigned* p, unsigned v) { return __hip_atomic_fetch_add(p, v, __ATOMIC_RELAXED, __HIP_MEMORY_SCOPE_AGENT); }
__device__ __forceinline__ unsigned xb_xcc_id() { return (unsigned)__builtin_amdgcn_s_getreg((3 << 11) | 20) & 0xFu; }
#define XB_SPIN(cond, bar) do { unsigned _sp = 0; while (cond) { __builtin_amdgcn_s_sleep(1); \
    if ((++_sp & 255u) == 0u) { if (xb_ld(&(bar)[XB_TMO])) break; if (_sp > XB_SPIN_CAP) { atomicAdd(&(bar)[XB_TMO], 1u); break; } } } } while (0)
struct XcdBarrier { unsigned* bar; unsigned x; volatile LAS unsigned* st; };
__device__ __forceinline__ XcdBarrier xcd_barrier_post(unsigned* bar, volatile LAS unsigned* st, const bool leader) {
    XcdBarrier b; b.bar = bar; b.x = xb_xcc_id(); b.st = st;
    if (leader) (void)xb_add(&bar[XB_XCNT(b.x)], 1u);
    return b;
}
__device__ __forceinline__ void xcd_barrier_complete(unsigned* bar, unsigned x, unsigned& nloc, unsigned& nx) {
    const unsigned G = gridDim.x * gridDim.y * gridDim.z;
    unsigned sum, cnt, mine, sp = 0u;
    for (;;) {
        sum = 0u; cnt = 0u; mine = 0u;
#pragma unroll
        for (unsigned j = 0; j < 16; ++j) { const unsigned c = xb_ld(&bar[XB_XCNT(j)]); sum += c; cnt += (c > 0u) ? 1u : 0u; mine = (j == x) ? c : mine; }
        if (sum == G) break;
        __builtin_amdgcn_s_sleep(1);
        if ((++sp & 255u) == 0u) { if (xb_ld(&bar[XB_TMO])) break; if (sp > XB_SPIN_CAP) { atomicAdd(&bar[XB_TMO], 1u); break; } }
    }
    nloc = mine > 0u ? mine : 1u; nx = cnt > 0u ? cnt : 1u;
}
__device__ __forceinline__ void xcd_barrier(const XcdBarrier& b, const bool leader) {
    asm volatile("s_waitcnt vmcnt(0)" ::: "memory");
    __syncthreads();
    if (leader) {
        unsigned* bar = b.bar;
        __builtin_amdgcn_s_waitcnt(0);
        unsigned nloc = b.st[0], nx = b.st[1];
        if (nloc == 0u) { xcd_barrier_complete(bar, b.x, nloc, nx); b.st[0] = nloc; b.st[1] = nx; }
        const unsigned old = xb_add(&bar[XB_XSUB(b.x)], 1u);
        const unsigned gen = old / nloc;
        if (old + 1u == (gen + 1u) * nloc) {
            __builtin_amdgcn_fence(__ATOMIC_RELEASE, "agent");
            asm volatile("s_waitcnt vmcnt(0)" ::: "memory");
            const unsigned og = xb_add(&bar[XB_TOP], 1u);
            const unsigned tg = og / nx;
            if (og + 1u == (tg + 1u) * nx) xb_add(&bar[XB_TOPGEN], 1u);
            else XB_SPIN(xb_ld(&bar[XB_TOPGEN]) == tg, bar);
            __builtin_amdgcn_fence(__ATOMIC_ACQUIRE, "agent");
            xb_add(&bar[XB_XGEN(b.x)], 1u);
            asm volatile("s_waitcnt vmcnt(0)" ::: "memory");
        } else {
            XB_SPIN(xb_ld(&bar[XB_XGEN(b.x)]) == gen, bar);
            __builtin_amdgcn_fence(__ATOMIC_ACQUIRE, "agent");
            asm volatile("s_waitcnt vmcnt(0)" ::: "memory");
        }
    }
    __syncthreads();
}

struct Frame {
    LAS unsigned char* lds;
    int tid, lane, wave;
    int vcu, G;
};
__device__ __forceinline__ Frame make_frame(LAS unsigned char* lds, const int wave_s) {
    Frame F; F.lds = lds;
    const int t = lane_id(); F.lane = t; F.wave = wave_s; F.tid = wave_s * 64 + t;
    int bx = blockIdx.x, G = gridDim.x; asm volatile("" : "+s"(bx), "+s"(G));
    F.G = G; F.vcu = (G % 8 == 0) ? (bx % 8) * (G / 8) + bx / 8 : bx;
    return F;
}

namespace attn_body {
typedef unsigned short bf16;
using bf16x8=__attribute__((ext_vector_type(8)))short;
using s16x4=__attribute__((ext_vector_type(4)))short;
using f32x16=__attribute__((ext_vector_type(16)))float;
using u32x4=__attribute__((ext_vector_type(4)))unsigned;
constexpr int BATCH=4,NHEAD=8,SEQ=4096,D=64,PQ=7936,PO=1536;
constexpr int NW=8,QBLK=32,QB=QBLK*NW,KVBLK=64,NQB=SEQ/QB;
__device__ __forceinline__ int crow(int r,int hi){return (r&3)+8*(r>>2)+4*hi;}
#define SBAR() __builtin_amdgcn_sched_barrier(0)
__device__ __forceinline__ void cmask(f32x16&p0,f32x16&p1,int jb,int qrel,int hi){
  const float NEG=-INFINITY; int kb=64*jb+4*hi;
  #pragma unroll
  for(int r=0;r<16;++r){int kv=kb+(r&3)+8*(r>>2); if(kv>qrel)p0[r]=NEG; if(kv+32>qrel)p1[r]=NEG;}
}

constexpr int NSLOT=3, SLOTB=8192;
constexpr int LDS_K=0, LDS_V=NSLOT*SLOTB, LDS_WS=2*NSLOT*SLOTB, LDS_OST=LDS_WS+NW*64*4, LDS_KML=LDS_OST+NW*4096, LDS_BYTES=LDS_KML+4096;
constexpr float C2=0.125f*1.4426950408889634f;
__device__ __forceinline__ void glds16(const void*gbase,unsigned voff,unsigned lds_dst){unsigned keep;
  asm volatile("s_mov_b32 %0, m0\n\ts_mov_b32 m0, %2\n\ts_nop 4\n\tglobal_load_lds_dwordx4 %1, %3\n\ts_mov_b32 m0, %0":"=&s"(keep):"v"(voff),"s"(lds_dst),"s"(gbase):"memory");}
__device__ __forceinline__ float max3f(float a,float b,float c){float r;asm("v_max3_f32 %0, %1, %2, %3":"=v"(r):"v"(a),"v"(b),"v"(c));return r;}
__device__ __forceinline__ float max2f(float a,float b){float r;asm("v_max_f32_e32 %0, %1, %2":"=v"(r):"v"(a),"v"(b));return r;}
__device__ __forceinline__ float fadd_s(float a,float b){float r;asm("v_add_f32_e32 %0, %1, %2":"=v"(r):"v"(a),"v"(b));return r;}
__device__ __forceinline__ float fsub_s(float a,float b){float r;asm("v_sub_f32_e32 %0, %1, %2":"=v"(r):"v"(a),"v"(b));return r;}
typedef float f32x2_t __attribute__((ext_vector_type(2))); typedef __bf16 bf16x2_t __attribute__((ext_vector_type(2)));
__device__ __forceinline__ unsigned cvtpk_s(float lo,float hi){f32x2_t v={lo,hi};bf16x2_t b=__builtin_convertvector(v,bf16x2_t);return __builtin_bit_cast(unsigned,b);}
#define WAIT_BAR(N) asm volatile("s_waitcnt vmcnt(" #N ") lgkmcnt(0)\n\ts_barrier":::"memory")

__device__ __forceinline__ void qkt(f32x16&p0,f32x16&p1,const char*Kslot,const bf16x8*qr,int r32,int hi){ const f32x16 negm=f32x16{};
  const char*kb=Kslot+hi*1024+r32*16;
  #pragma unroll
  for(int d0=0;d0<4;++d0){
    const bf16x8 b0=*reinterpret_cast<const bf16x8*>(kb+d0*2048);
    const bf16x8 b1=*reinterpret_cast<const bf16x8*>(kb+d0*2048+512);
    if(d0==0){p0=__builtin_amdgcn_mfma_f32_32x32x16_bf16(b0,qr[0],negm,0,0,0);p1=__builtin_amdgcn_mfma_f32_32x32x16_bf16(b1,qr[0],negm,0,0,0);}
    else{p0=__builtin_amdgcn_mfma_f32_32x32x16_bf16(b0,qr[d0],p0,0,0,0);p1=__builtin_amdgcn_mfma_f32_32x32x16_bf16(b1,qr[d0],p1,0,0,0);}}
}
typedef __attribute__((address_space(3))) const char* lds_cptr;
typedef short v4i16_t __attribute__((ext_vector_type(4)));
__device__ __forceinline__ void kload8(bf16x8*kf,lds_cptr kp){
  kf[0]=*(const __attribute__((address_space(3))) bf16x8*)(kp);      kf[1]=*(const __attribute__((address_space(3))) bf16x8*)(kp+512);
  kf[2]=*(const __attribute__((address_space(3))) bf16x8*)(kp+2048); kf[3]=*(const __attribute__((address_space(3))) bf16x8*)(kp+2560);
  kf[4]=*(const __attribute__((address_space(3))) bf16x8*)(kp+4096); kf[5]=*(const __attribute__((address_space(3))) bf16x8*)(kp+4608);
  kf[6]=*(const __attribute__((address_space(3))) bf16x8*)(kp+6144); kf[7]=*(const __attribute__((address_space(3))) bf16x8*)(kp+6656);
}
__device__ __forceinline__ void kload2(bf16x8*kf,lds_cptr kp,int j){ kf[2*j]=*(const __attribute__((address_space(3))) bf16x8*)(kp+j*2048); kf[2*j+1]=*(const __attribute__((address_space(3))) bf16x8*)(kp+j*2048+512); }
__device__ __forceinline__ s16x4 vtr(lds_cptr p){ return __builtin_bit_cast(s16x4,__builtin_amdgcn_ds_read_tr16_b64_v4i16((__attribute__((address_space(3))) v4i16_t*)p)); }
__device__ __forceinline__ float rowmax(const f32x16&p0,const f32x16&p1){
  float a=max3f(p0[0],p0[1],p1[0]),b=max3f(p0[2],p0[3],p1[1]);a=max3f(a,p1[2],p1[3]);
  #pragma unroll
  for(int r=4;r<16;r+=4){a=max3f(a,p0[r],p0[r+1]);b=max3f(b,p0[r+2],p0[r+3]);a=max3f(a,p1[r],p1[r+1]);b=max3f(b,p1[r+2],p1[r+3]);}
  const float m=max2f(a,b);
  auto rr=__builtin_amdgcn_permlane32_swap(__float_as_uint(m),__float_as_uint(m),false,false);
  return max2f(__uint_as_float(rr[0]),__uint_as_float(rr[1]));
}
__device__ __forceinline__ void pv(f32x16*o,int vb,bf16x8 pa0,bf16x8 pa1,bf16x8 pa2,bf16x8 pa3){
  #pragma unroll
  for(int d0=0;d0<2;++d0){s16x4 lo[4],hi[4];
    #pragma unroll
    for(int ks=0;ks<4;++ks){
      asm volatile("ds_read_b64_tr_b16 %0,%1 offset:%c2":"=&v"(lo[ks]):"v"(vb),"i"(d0*4096+ks*1024):"memory");
      asm volatile("ds_read_b64_tr_b16 %0,%1 offset:%c2":"=&v"(hi[ks]):"v"(vb),"i"(d0*4096+ks*1024+512):"memory");}
    asm volatile("s_waitcnt lgkmcnt(0)":::"memory");SBAR();
    #define PK(k) (bf16x8){lo[k][0],lo[k][1],lo[k][2],lo[k][3],hi[k][0],hi[k][1],hi[k][2],hi[k][3]}
    o[d0]=__builtin_amdgcn_mfma_f32_32x32x16_bf16(pa0,PK(0),o[d0],0,0,0);
    o[d0]=__builtin_amdgcn_mfma_f32_32x32x16_bf16(pa1,PK(1),o[d0],0,0,0);
    o[d0]=__builtin_amdgcn_mfma_f32_32x32x16_bf16(pa2,PK(2),o[d0],0,0,0);
    o[d0]=__builtin_amdgcn_mfma_f32_32x32x16_bf16(pa3,PK(3),o[d0],0,0,0);
    #undef PK
  }
}

#ifndef ATTN_STORE16
#define ATTN_STORE16(p,v) (*(u32x4*)(p)=(v))
#endif
template<int THRL> __device__ __forceinline__ void attn_unit(int b,int h,int qb,const bf16*Q,const bf16*__restrict__ K,const bf16*__restrict__ V,bf16*O,const float*__restrict__ ksum,char*shm,const int wave_s){
  int lane; asm volatile("v_mbcnt_lo_u32_b32 %0, -1, 0\n\tv_mbcnt_hi_u32_b32 %0, -1, %0" : "=v"(lane)); const int wid=wave_s,tid=wid*64+lane,r32=lane&31,hi=lane>>5;
  const long rowbase=(long)b*SEQ; const int q0=qb*QB;
  const bf16*Qw=Q+(rowbase+q0+wid*QBLK)*PQ+h*D;
  const bf16*Kh=K+rowbase*PQ+h*D,*Vh=V+rowbase*PQ+h*D;
  const unsigned lds0=(unsigned)(uintptr_t)shm;
  float*wsf=(float*)(shm+LDS_WS)+wid*64;
  const unsigned kvo=(unsigned)(lane*PQ+wid*8)*2u;
  const unsigned vvo=(unsigned)((16*(wid&3)+(lane>>2))*PQ+(wid>>2)*32+(lane&3)*8)*2u;
  const unsigned kdst=lds0+LDS_K+wid*1024, vdst=lds0+LDS_V+wid*1024;
  #define DMA_K(t,slot) glds16(Kh+(long)(t)*KVBLK*PQ,kvo,(unsigned)__builtin_amdgcn_readfirstlane(kdst+(slot)))
  #define DMA_V(t,slot) glds16(Vh+(long)(t)*KVBLK*PQ,vvo,(unsigned)__builtin_amdgcn_readfirstlane(vdst+(slot)))
  const int vb0=(int)(lds0+LDS_V)+((lane>>4)&1)*32+(lane&3)*8+(4*hi+((lane&15)>>2))*64;
  const char*Kbase=shm+LDS_K; bf16x8 kf[8];
  const lds_cptr shm3=(lds_cptr)shm; const lds_cptr kp0=shm3+LDS_K+hi*1024+r32*16; const lds_cptr vp0=shm3+LDS_V+((lane>>4)&1)*32+(lane&3)*8+(4*hi+((lane&15)>>2))*64;
  const int NT=(q0+QB)/KVBLK;
  { float*kml=(float*)(shm+LDS_KML); const float*ks=ksum+(size_t)(b*NHEAD+h)*16*4*64;
    _Pragma("unroll") for(int i=0;i<2;++i){const int e=tid+512*i; const float*kp=ks+(size_t)(e>>6)*256+(e&63); kml[e]=((kp[0]+kp[64])+(kp[128]+kp[192]))*(1.0f/256.0f);} }
  DMA_K(0,0);DMA_V(0,0);DMA_K(1,SLOTB);
  bf16x8 qr[4];
  #pragma unroll
  for(int d0=0;d0<4;++d0)qr[d0]=*reinterpret_cast<const bf16x8*>(&Qw[(long)r32*PQ+d0*16+hi*8]);
  float mhat=0.f,l_reg=0.f;f32x16 o[2];o[0]=f32x16{};o[1]=f32x16{};
  const int qrel=wid*QBLK+r32;
  #define CMASK(P0,P1,t) do{int jb_=(t)-(NT-4); if(jb_>=0)cmask(P0,P1,jb_,qrel,hi);}while(0)
  bool resc=false;
  #define START(P0,P1) do{ const float rm=rowmax(P0,P1); resc=false; \
    { const float dl=(rm==-INFINITY)?0.f:rm; mhat=fadd_s(mhat,dl);     \
      _Pragma("unroll") for(int r=0;r<16;++r){P0[r]=fsub_s(P0[r],dl);P1[r]=fsub_s(P1[r],dl);} \
      } \
    _Pragma("unroll") for(int r=0;r<16;++r)P0[r]=__builtin_amdgcn_exp2f(P0[r]); }while(0)
  #define RESC() do{ if(resc){ asm volatile("s_waitcnt lgkmcnt(0)":::"memory"); \
      _Pragma("unroll") for(int d_=0;d_<2;++d_) _Pragma("unroll") for(int r=0;r<16;++r)o[d_][r]*=wsf[crow(r,hi)]; } }while(0)
  f32x16 pA0,pA1,pB0,pB1;
  int sl_prev=0,sl_cur=0,sl_next=SLOTB;
  #define ROT() do{sl_prev=sl_cur;sl_cur=sl_next;sl_next=(sl_next==(NSLOT-1)*SLOTB)?0:sl_next+SLOTB;}while(0)
  DMA_K(2,2*SLOTB);
  WAIT_BAR(3);
  unsigned selmask=(qb<=3)?((1u<<qb)-1u):0u;
  if(qb>3){ const float*kml=(const float*)(shm+LDS_KML); float v0=-INFINITY,v1=-INFINITY,v2=-INFINITY; int i0=0,i1=0,i2=0;
    for(int n=0;n<qb;++n){ float g=0.f;
      _Pragma("unroll") for(int d0=0;d0<4;++d0){ const float*kr=kml+n*64+d0*16+hi*8;
        _Pragma("unroll") for(int j=0;j<8;++j) g=__builtin_fmaf(__uint_as_float(((unsigned)(unsigned short)qr[d0][j])<<16),kr[j],g); }
      g+=__shfl_xor(g,32);
      if(g>v0){v2=v1;i2=i1;v1=v0;i1=i0;v0=g;i0=n;} else if(g>v1){v2=v1;i2=i1;v1=g;i1=n;} else if(g>v2){v2=g;i2=n;} }
    selmask=(1u<<i0)|(1u<<i1)|(1u<<i2); }
  #define SUBREF(t) ((((t)<NT-4)&&!((selmask>>((t)>>2))&1u))?INFINITY:mhat)
  #define BMASK(P0,P1,t) do{ if(!((selmask>>((t)>>2))&1u)){ _Pragma("unroll") for(int r=0;r<16;++r){P0[r]=-INFINITY;P1[r]=-INFINITY;} } }while(0)
  qkt(pA0,pA1,Kbase,qr,r32,hi);asm volatile("s_nop 15\n\ts_nop 7":"+v"(pA0),"+v"(pA1));CMASK(pA0,pA1,0); if(NT>4)BMASK(pA0,pA1,0);
  START(pA0,pA1);
  _Pragma("unroll") for(int r=0;r<16;++r)pA1[r]=__builtin_amdgcn_exp2f(pA1[r]);
  WAIT_BAR(0);
  DMA_K(3,0);DMA_V(1,SLOTB);
  ROT();
  kload8(kf,kp0+sl_cur);
  WAIT_BAR(2);
  s16x4 vlo[8],vhi[8]; u32x4 pw0,pw1,pw2,pw3;
  #define PKW(P,B) cvtpk_s(P[B],P[B+1])
  #define PAF(k) __builtin_bit_cast(bf16x8,pw##k)
  #define VFR(i) (bf16x8){vlo[i][0],vlo[i][1],vlo[i][2],vlo[i][3],vhi[i][0],vhi[i][1],vhi[i][2],vhi[i][3]}
  #define PIN(x) asm volatile("":"+v"(x))
  #define MX3(a,b,c) __builtin_fmaxf(__builtin_fmaxf((a),(b)),(c))
  #define GAPA(MF,A0,A1,A2,A3,W0,W1,PW) do{ MF; sacc+=A0; sacc+=A1; sacc+=A2; sacc+=A3; PIN(sacc); W0; W1; PIN(PW); SBAR(); }while(0)
  #define EX(v) __builtin_amdgcn_exp2f(v)
  #define GAPB(MF,X,B) do{ MF; X[B]=EX(X[B]); X[B+1]=EX(X[B+1]); X[B+2]=EX(X[B+2]); X[B+3]=EX(X[B+3]); PIN(X); SBAR(); }while(0)
  #define VRD(i) do{ vlo[i]=vtr(vp_+(((i)>>2)*4096+((i)&3)*1024)); vhi[i]=vtr(vp_+(((i)>>2)*4096+((i)&3)*1024+512)); }while(0)
  #define KRD(G,j) do{ if(G){ kload2(kf,kp0+sl_next,j); SBAR(); } }while(0)
  #define STEP(C0,C1,P0,P1,t,GK,GV,GL) do{ SBAR(); \
    const lds_cptr vp_=vp0+sl_prev; \
    VRD(0); SBAR(); float sacc=(P0[0]+P0[1]); \
    GAPA(C0=__builtin_amdgcn_mfma_f32_32x32x16_bf16(kf[0],qr[0],f32x16{},0,0,0), P0[2],P0[3],P0[4],P0[5],     pw0[0]=PKW(P0,0), pw0[1]=PKW(P0,2), pw0); \
    VRD(4); SBAR(); GAPA(C1=__builtin_amdgcn_mfma_f32_32x32x16_bf16(kf[1],qr[0],f32x16{},0,0,0), P0[6],P0[7],P0[8],P0[9],     pw0[2]=PKW(P0,4), pw0[3]=PKW(P0,6), pw0); \
    VRD(1); SBAR(); GAPA(C0=__builtin_amdgcn_mfma_f32_32x32x16_bf16(kf[2],qr[1],C0,0,0,0),   P0[10],P0[11],P0[12],P0[13], pw1[0]=PKW(P0,8), pw1[1]=PKW(P0,10), pw1); \
    VRD(5); SBAR(); GAPA(C1=__builtin_amdgcn_mfma_f32_32x32x16_bf16(kf[3],qr[1],C1,0,0,0),   P0[14],P0[15],P1[0],P1[1],   pw1[2]=PKW(P0,12),pw1[3]=PKW(P0,14), pw1); \
    VRD(2); SBAR(); GAPA(C0=__builtin_amdgcn_mfma_f32_32x32x16_bf16(kf[4],qr[2],C0,0,0,0),   P1[2],P1[3],P1[4],P1[5],     pw2[0]=PKW(P1,0), pw2[1]=PKW(P1,2), pw2); \
    VRD(6); SBAR(); GAPA(C1=__builtin_amdgcn_mfma_f32_32x32x16_bf16(kf[5],qr[2],C1,0,0,0),   P1[6],P1[7],P1[8],P1[9],     pw2[2]=PKW(P1,4), pw2[3]=PKW(P1,6), pw2); \
    VRD(3); SBAR(); GAPA(C0=__builtin_amdgcn_mfma_f32_32x32x16_bf16(kf[6],qr[3],C0,0,0,0),   P1[10],P1[11],P1[12],P1[13], pw3[0]=PKW(P1,8), pw3[1]=PKW(P1,10), pw3); \
    VRD(7); SBAR(); GAPA(C1=__builtin_amdgcn_mfma_f32_32x32x16_bf16(kf[7],qr[3],C1,0,0,0),   P1[14],P1[15],0.f,0.f,       pw3[2]=PKW(P1,12),pw3[3]=PKW(P1,14), pw3); \
    l_reg+=sacc; \
    if(GK){DMA_K((t)+3,sl_cur);} if(GV){DMA_V((t)+1,sl_next);} \
    { const float sub_=SUBREF(t); _Pragma("unroll") for(int r=0;r<16;++r){C0[r]-=sub_;C1[r]-=sub_;} } \
    CMASK(C0,C1,t); \
    { float a=MX3(C0[0],C0[1],C1[0]),b=MX3(C0[2],C0[3],C1[1]); a=MX3(a,C1[2],C1[3]); \
      _Pragma("unroll") for(int r=4;r<16;r+=4){a=MX3(a,C0[r],C0[r+1]);b=MX3(b,C0[r+2],C0[r+3]);a=MX3(a,C1[r],C1[r+1]);b=MX3(b,C1[r+2],C1[r+3]);} \
      float rm=__builtin_fmaxf(a,b); { auto rr=__builtin_amdgcn_permlane32_swap(__float_as_uint(rm),__float_as_uint(rm),false,false); rm=__builtin_fmaxf(__uint_as_float(rr[0]),__uint_as_float(rr[1])); } \
      resc=false; \
      if(__builtin_expect(__any(rm>(float)THRL),0)){ const float dl=__builtin_fmaxf(rm,0.f); mhat+=dl; \
        _Pragma("unroll") for(int r=0;r<16;++r){C0[r]-=dl;C1[r]-=dl;} \
        const float f=__builtin_amdgcn_exp2f(-dl); l_reg*=f; if(hi==0)wsf[r32]=f; resc=true; } } \
    SBAR(); \
    GAPB(o[0]=__builtin_amdgcn_mfma_f32_32x32x16_bf16(PAF(0),VFR(0),o[0],0,0,0), C0,0); \
    GAPB(o[1]=__builtin_amdgcn_mfma_f32_32x32x16_bf16(PAF(0),VFR(4),o[1],0,0,0), C0,4); \
    KRD(GL,0); GAPB(o[0]=__builtin_amdgcn_mfma_f32_32x32x16_bf16(PAF(1),VFR(1),o[0],0,0,0), C0,8); \
    KRD(GL,1); GAPB(o[1]=__builtin_amdgcn_mfma_f32_32x32x16_bf16(PAF(1),VFR(5),o[1],0,0,0), C0,12); \
    KRD(GL,2); GAPB(o[0]=__builtin_amdgcn_mfma_f32_32x32x16_bf16(PAF(2),VFR(2),o[0],0,0,0), C1,0); \
    KRD(GL,3); GAPB(o[1]=__builtin_amdgcn_mfma_f32_32x32x16_bf16(PAF(2),VFR(6),o[1],0,0,0), C1,4); \
    GAPB(o[0]=__builtin_amdgcn_mfma_f32_32x32x16_bf16(PAF(3),VFR(3),o[0],0,0,0), C1,8); \
    GAPB(o[1]=__builtin_amdgcn_mfma_f32_32x32x16_bf16(PAF(3),VFR(7),o[1],0,0,0), C1,12); \
    }while(0)
  int t=1;
  #undef CMASK
  #define CMASK(P0,P1,t) do{}while(0)
  for(;t+5<NT;t+=2){
    STEP(pB0,pB1,pA0,pA1,t,true,true,true);     WAIT_BAR(2); RESC(); ROT();
    STEP(pA0,pA1,pB0,pB1,t+1,true,true,true);   WAIT_BAR(2); RESC(); ROT();
  }
  #undef CMASK
  #define CMASK(P0,P1,t) do{int jb_=(t)-(NT-4); if(jb_>=0)cmask(P0,P1,jb_,qrel,hi);}while(0)
  #define ENDW(tt) do{ if((tt)+3<NT){WAIT_BAR(2);} else if((tt)+2<NT){WAIT_BAR(1);} else {WAIT_BAR(0);} }while(0)
  for(;t+1<NT;t+=2){
    STEP(pB0,pB1,pA0,pA1,t,(t+3<NT),(t+1<NT),(t+1<NT));       ENDW(t);   RESC(); ROT();
    STEP(pA0,pA1,pB0,pB1,t+1,(t+4<NT),(t+2<NT),(t+2<NT));     ENDW(t+1); RESC(); ROT();
  }
  STEP(pB0,pB1,pA0,pA1,NT-1,false,false,false); RESC();
  { float sacc=pB0[0]+pB0[1]; _Pragma("unroll") for(int r=2;r<16;++r)sacc+=pB0[r]; _Pragma("unroll") for(int r=0;r<16;++r)sacc+=pB1[r]; l_reg+=sacc;
    pw0=(u32x4){PKW(pB0,0),PKW(pB0,2),PKW(pB0,4),PKW(pB0,6)};pw1=(u32x4){PKW(pB0,8),PKW(pB0,10),PKW(pB0,12),PKW(pB0,14)};pw2=(u32x4){PKW(pB1,0),PKW(pB1,2),PKW(pB1,4),PKW(pB1,6)};pw3=(u32x4){PKW(pB1,8),PKW(pB1,10),PKW(pB1,12),PKW(pB1,14)};
    SBAR(); pv(o,vb0+sl_cur,PAF(0),PAF(1),PAF(2),PAF(3)); }
  #undef PKW
  #undef PAF
  #undef VFR
  #undef PIN
  #undef MX3
  #undef GAPA
  #undef GAPB
  #undef EX
  #undef VRD
  #undef KRD
  #undef STEP
  #undef ENDW
  {auto rr=__builtin_amdgcn_permlane32_swap(__float_as_uint(l_reg),__float_as_uint(l_reg),false,false);l_reg=__uint_as_float(rr[0])+__uint_as_float(rr[1]);}
  if(hi==0)wsf[32+r32]=l_reg;asm volatile("s_waitcnt lgkmcnt(0)":::"memory");
  float rli[16];
  #pragma unroll
  for(int r=0;r<16;++r)rli[r]=__builtin_amdgcn_rcpf(wsf[32+crow(r,hi)]);
  bf16*Ow=O+(rowbase+q0+wid*QBLK)*PO+h*D;
  { bf16*stg=(bf16*)(shm+LDS_OST)+wid*2048;
    #pragma unroll
    for(int r=0;r<16;++r){const int orow=crow(r,hi);
      #pragma unroll
      for(int d0=0;d0<2;++d0)stg[orow*64+d0*32+r32]=(bf16)(cvtpk_s(o[d0][r]*rli[r],0.f)&0xffffu);}
    asm volatile("s_waitcnt lgkmcnt(0)":::"memory");
    #pragma unroll
    for(int i=0;i<4;++i){const int row=i*8+(lane>>3),ch=lane&7; const u32x4 v=*(const u32x4*)(stg+row*64+ch*8); ATTN_STORE16(Ow+(long)row*PO+ch*8,v);} }
  asm volatile("s_waitcnt lgkmcnt(0)\n\ts_barrier":::"memory");
  #undef DMA_K
  #undef DMA_V
  #undef BMASK
  #undef SUBREF
  #undef CMASK
  #undef START
  #undef RESC
  #undef ROT
}
constexpr int ATTN_LDS_BYTES=LDS_BYTES;
template<int THRL=8> __device__ __forceinline__ void attn_phase(char*lds,const bf16*Q,const bf16*K,const bf16*V,bf16*O,const float*ksum,int vcu,int G,const int wave_s){
  if(G==256){
    if(vcu<64)return;
    const int idx=vcu-64,bh=idx/6,k=idx-6*bh,b=bh/NHEAD,h=bh%NHEAD;
    if(k<5){ attn_unit<THRL>(b,h,15-k,Q,K,V,O,ksum,lds,wave_s); attn_unit<THRL>(b,h,6+k,Q,K,V,O,ksum,lds,wave_s); }
    else { for(int qb=5;qb>=0;--qb) attn_unit<THRL>(b,h,qb,Q,K,V,O,ksum,lds,wave_s); }
    return;
  }
  for(int p=vcu;p<BATCH*NHEAD*8;p+=G){ const int bh=p>>3,sq=p&7;
    attn_unit<THRL>(bh/NHEAD,bh%NHEAD,sq,Q,K,V,O,ksum,lds,wave_s);
    attn_unit<THRL>(bh/NHEAD,bh%NHEAD,15-sq,Q,K,V,O,ksum,lds,wave_s); }
}
#undef SBAR
#undef WAIT_BAR
}

__device__ __forceinline__ int opq(int x) { asm volatile("" : "+v"(x)); return x; }
__device__ __forceinline__ void p0_transpose_item(const float* W, int ldw, int K, int N, bf16* WT, int row_off, int mode, LAS float* scr_, int item, int lane) {
    LAS unsigned* scr = (LAS unsigned*)scr_;
    const int nblk = N / 64, kb = item / nblk, nb = item % nblk, k0 = 64 * kb, n0 = 64 * nb;
    const int n4 = (lane & 15) * 4, kq = lane >> 4;
#pragma unroll
    for (int i = 0; i < 8; ++i) { const int kk = 8 * i + 2 * kq;
        const f32x4 a = *(const f32x4*)(W + (size_t)(k0 + kk) * ldw + n0 + n4), b = *(const f32x4*)(W + (size_t)(k0 + kk + 1) * ldw + n0 + n4);
        scr[(n4 + 0) * 36 + (kk >> 1)] = pk2(a.x, b.x); scr[(n4 + 1) * 36 + (kk >> 1)] = pk2(a.y, b.y); scr[(n4 + 2) * 36 + (kk >> 1)] = pk2(a.z, b.z); scr[(n4 + 3) * 36 + (kk >> 1)] = pk2(a.w, b.w); }
    LDS_WAIT(); asm volatile("" ::: "memory");
    const int c = lane & 7;
    const int obase = mode ? (256 * (n0 >> 7) + (n0 & 127) + row_off) : (row_off + n0);
#pragma unroll
    for (int j = 0; j < 8; ++j) { const int n = (lane >> 3) + 8 * j;
        const v4u o = *(const LAS v4u*)(scr + n * 36 + 4 * c);
        *(GAS v4u*)(WT + (size_t)(obase + n) * K + k0 + 8 * c) = o; }
    LDS_WAIT(); asm volatile("" ::: "memory");
}

typedef __attribute__((address_space(4))) const unsigned long long* kargp_t;
__device__ __forceinline__ unsigned long long karg_u64(int idx) { kargp_t kp = (kargp_t)__builtin_amdgcn_kernarg_segment_ptr(); asm volatile("" : "+s"(kp)); return kp[idx]; }
#define INP(k) ((const float*)karg_u64(k))
#define OUTP() ((float*)karg_u64(27))
#define WSP() ((unsigned char*)karg_u64(28))
enum { I_X = 0, I_WIN, I_CONVW, I_MU, I_DW0, I_DW2, I_AA0, I_AW2, I_GW2, I_KK, I_KA, I_RK, I_GNG, I_GNB, I_WBR, I_WOUT, I_LN1G, I_LN1B, I_LN2G, I_LN2B, I_FWG, I_FWU, I_FWD, I_RW, I_MWG, I_MWU, I_MWD };

__device__ __forceinline__ void p0_prologue(LAS unsigned char* lds_, const int wave_s) {
    const Frame F = make_frame(lds_, wave_s);
    LAS float* scr = (LAS float*)(F.lds + RING_OFF + F.wave * 16384);
    const int gw = F.vcu * NWAVES + F.wave, NGW = F.G * NWAVES;
    bf16* Wb = (bf16*)(WSP() + WS_W);
    constexpr int I_IN = 16 * 124, I_BR = 24 * 16, I_O = 16 * 16, I_G = 16 * 44, I_D = 44 * 16;
    constexpr int I_LAYER = I_IN + I_BR + I_O;
    constexpr int NITEMS = 2 * I_LAYER + 2 * I_G + I_D;
    for (int it = gw; it < NITEMS; it += NGW) {
        int r = it;
        if (r < 2 * I_LAYER) { const int l = r / I_LAYER; r -= l * I_LAYER;
            if (r < I_IN) { p0_transpose_item(INP(I_WIN) + (size_t)l * D * PT, PT, D, PT, Wb + WO_IN + l * W_IN_SZ, 0, 0, scr, r, F.lane); continue; } r -= I_IN;
            if (r < I_BR) { p0_transpose_item(INP(I_WBR) + (size_t)l * 1536 * D, D, 1536, D, Wb + WO_BR + l * W_BR_SZ, 0, 0, scr, r, F.lane); continue; } r -= I_BR;
            p0_transpose_item(INP(I_WOUT) + (size_t)l * D * D, D, D, D, Wb + WO_O + l * W_O_SZ, 0, 0, scr, r, F.lane); continue; }
        r -= 2 * I_LAYER;
        if (r < I_G) { p0_transpose_item(INP(I_FWG), DFF, D, DFF, Wb + WO_GU, 0, 1, scr, r, F.lane); continue; } r -= I_G;
        if (r < I_G) { p0_transpose_item(INP(I_FWU), DFF, D, DFF, Wb + WO_GU, 128, 1, scr, r, F.lane); continue; } r -= I_G;
        p0_transpose_item(INP(I_FWD), D, DFF, D, Wb + WO_D, 0, 0, scr, r, F.lane);
    }
    {
        bf16* LT = (bf16*)(WSP() + WS_MISC2 + M2_LORAT);
        for (int it = gw; it < 64; it += NGW) { const int l = it >> 5, q = it & 31;
            if (q < 8) p0_transpose_item(INP(I_DW2) + (size_t)l * 64 * BR, BR, 64, BR, LT + (size_t)l * 131072, 0, 0, scr, q, F.lane);
            else if (q < 16) p0_transpose_item(INP(I_AW2) + (size_t)l * 64 * BR, BR, 64, BR, LT + (size_t)l * 131072 + 32768, 0, 0, scr, q - 8, F.lane);
            else p0_transpose_item(INP(I_GW2) + (size_t)l * 128 * BR, BR, 128, BR, LT + (size_t)l * 131072 + 65536, 0, 0, scr, q - 16, F.lane); }
    }
    bf16* XB = (bf16*)(WSP() + WS_XB);
    for (int m = gw; m < M; m += NGW) {
        const GAS f32x4* xr = (const GAS f32x4*)(INP(I_X) + (size_t)m * D) + F.lane;
        GAS unsigned long long* o8 = (GAS unsigned long long*)(XB + (size_t)m * D) + F.lane;
#pragma unroll
        for (int j = 0; j < 4; ++j) { const f32x4 v = xr[64 * j]; o8[64 * j] = (unsigned long long)pk2(v.x, v.y) | ((unsigned long long)pk2(v.z, v.w) << 32); }
    }
    float* rc = (float*)(WSP() + WS_MISC2 + M2_ROPE); float* rs = rc + T * 32;
    for (int i = F.vcu * 512 + F.tid; i < T * 32; i += F.G * 512) {
        const int t = i >> 5, d = i & 31;
        const float inv = powf(10000.0f, -(float)d / 32.0f); const float ang = (float)t * inv;
        float s, c; sincosf(ang, &s, &c); rc[i] = c; rs[i] = s;
    }
}
__device__ __forceinline__ void moe_weight_prologue(LAS unsigned char* lds_, const int wave_s) {
    const Frame F = make_frame(lds_, wave_s);
    LAS float* scr = (LAS float*)(F.lds + RING_OFF + F.wave * 16384);
    const int gw = F.vcu * NWAVES + F.wave, NGW = F.G * NWAVES;
    bf16* Wm = (bf16*)(WSP() + WS_MOEW);
    constexpr int I_G = 16 * 44, I_D = 44 * 16, I_E = 2 * I_G + I_D;
    for (int it = gw; it < NE * I_E; it += NGW) {
        const int e = it / I_E; int r = it - e * I_E;
        bf16* We = Wm + (size_t)e * MOE_E_SZ;
        if (r < I_G) { p0_transpose_item(INP(I_MWG) + (size_t)e * D * DFF, DFF, D, DFF, We, 0, 1, scr, r, F.lane); continue; } r -= I_G;
        if (r < I_G) { p0_transpose_item(INP(I_MWU) + (size_t)e * D * DFF, DFF, D, DFF, We, 128, 1, scr, r, F.lane); continue; } r -= I_G;
        p0_transpose_item(INP(I_MWD) + (size_t)e * DFF * D, D, DFF, D, We + W_GU_SZ, 0, 0, scr, r, F.lane);
    }
}

__device__ __forceinline__ void m2a_rope(LAS unsigned char* lds_, const int wave_s, bf16* proj) {
    const Frame F = make_frame(lds_, wave_s);
    const float* rc = (const float*)(WSP() + WS_MISC2 + M2_ROPE); const float* rs = rc + T * 32;
    float* ksum = (float*)(WSP() + WS_MISC2 + M2_KSUM);
    LAS float* ksl = (LAS float*)(F.lds);
    const int combo = F.lane >> 2, qk = combo >> 3, h = combo & 7, c = F.lane & 3;
    for (int u = F.vcu; u < M / 64; u += F.G) {
        float ks1[8], ks2[8];
#pragma unroll
        for (int j = 0; j < 8; ++j) { ks1[j] = 0.f; ks2[j] = 0.f; }
        for (int rr = 0; rr < 8; ++rr) {
            const int row = 64 * u + 8 * F.wave + rr, t = row % T;
            bf16* p = proj + (size_t)row * PT + (qk ? PC_K : PC_Q) + h * 64 + 8 * c;
            float x1[8], x2[8], cs[8], sn[8];
            unpack8(*(const v4u*)p, x1); unpack8(*(const v4u*)(p + 32), x2);
            const f32x4 c0 = *(const f32x4*)(rc + t * 32 + 8 * c), c1 = *(const f32x4*)(rc + t * 32 + 8 * c + 4);
            const f32x4 s0 = *(const f32x4*)(rs + t * 32 + 8 * c), s1 = *(const f32x4*)(rs + t * 32 + 8 * c + 4);
#pragma unroll
            for (int j = 0; j < 4; ++j) { cs[j] = c0[j]; cs[4 + j] = c1[j]; sn[j] = s0[j]; sn[4 + j] = s1[j]; }
            float o1[8], o2[8];
#pragma unroll
            for (int j = 0; j < 8; ++j) { o1[j] = x1[j] * cs[j] - x2[j] * sn[j]; o2[j] = x2[j] * cs[j] + x1[j] * sn[j]; }
            if (qk) {
#pragma unroll
                for (int j = 0; j < 8; ++j) { ks1[j] += o1[j]; ks2[j] += o2[j]; }
            } else {
#pragma unroll
                for (int j = 0; j < 8; ++j) { o1[j] *= C2; o2[j] *= C2; }
            }
            *(v4u*)p = pack8(o1); *(v4u*)(p + 32) = pack8(o2);
        }
        if (qk) {
#pragma unroll
            for (int j = 0; j < 8; ++j) { ksl[(F.wave * 8 + h) * 64 + 8 * c + j] = ks1[j]; ksl[(F.wave * 8 + h) * 64 + 32 + 8 * c + j] = ks2[j]; }
        }
        __syncthreads();
        { const int hh = F.tid >> 6, d = F.tid & 63; float s = 0.f;
#pragma unroll
          for (int w = 0; w < 8; ++w) s += ksl[(w * 8 + hh) * 64 + d];
          const int b = u / 64, n = (u % 64) >> 2, part = u & 3;
          ksum[((((size_t)b * NH + hh) * 16 + n) * 4 + part) * 64 + d] = s; }
        __syncthreads();
    }
}
__device__ __forceinline__ void m2a_conv(LAS unsigned char* lds_, const int wave_s, const bf16* proj, const float* cw  , bf16* ocat) {
    const Frame F = make_frame(lds_, wave_s);
    const int gw = F.vcu * NWAVES + F.wave, NGW = F.G * NWAVES, c0 = 8 * F.lane;
    float w0[8], w1[8], w2[8];
#pragma unroll
    for (int j = 0; j < 8; ++j) { w0[j] = cw[c0 + j]; w1[j] = cw[BR + c0 + j]; w2[j] = cw[2 * BR + c0 + j]; }
    for (int m = gw; m < M; m += NGW) {
        const int t = m % T; const bf16* r0 = proj + (size_t)m * PT + c0;
        float ch[8], cc[8], cb[8], u0[8], u1[8], u2[8];
        unpack8(*(const v4u*)(r0 + PC_CH), ch); unpack8(*(const v4u*)(r0 + PC_CC), cc); unpack8(*(const v4u*)(r0 + PC_CB), cb);
#pragma unroll
        for (int j = 0; j < 8; ++j) { u0[j] = cc[j] * ch[j]; u1[j] = 0.f; u2[j] = 0.f; }
        if (t >= 1) { unpack8(*(const v4u*)(r0 - PT + PC_CH), ch); unpack8(*(const v4u*)(r0 - PT + PC_CC), cc);
#pragma unroll
            for (int j = 0; j < 8; ++j) u1[j] = cc[j] * ch[j]; }
        if (t >= 2) { unpack8(*(const v4u*)(r0 - 2 * PT + PC_CH), ch); unpack8(*(const v4u*)(r0 - 2 * PT + PC_CC), cc);
#pragma unroll
            for (int j = 0; j < 8; ++j) u2[j] = cc[j] * ch[j]; }
        float o[8];
#pragma unroll
        for (int j = 0; j < 8; ++j) o[j] = cb[j] * (w0[j] * u2[j] + w1[j] * u1[j] + w2[j] * u0[j]);
        *(v4u*)(ocat + (size_t)m * 1536 + c0) = pack8(o);
    }
}
__device__ __forceinline__ void m2a_rwkv_prep(LAS unsigned char* lds_, const int wave_s, int l, const bf16* proj, bf16* rwx, bf16* ocat) {
    const Frame F = make_frame(lds_, wave_s);
    const int gw = F.vcu * NWAVES + F.wave, NGW = F.G * NWAVES, lane = F.lane, c0 = 8 * lane;
    LAS float* lin = (LAS float*)(F.lds + 16384 + F.wave * 8192);
    const float* mu = INP(I_MU) + l * SHIFT;
    const f32x4 mul = *(const f32x4*)(mu + 1536 + 4 * lane);
    for (int ru = gw; ru < M / 8; ru += NGW) {
        const int r0 = 8 * ru;
#pragma unroll
        for (int rr = 0; rr < 8; ++rr) {
            const int row = r0 + rr, t = row % T;
            const v2u cur = *(const v2u*)(proj + (size_t)row * PT + PC_WL + 4 * lane);
            v2u prv; prv.x = 0u; prv.y = 0u; if (t >= 1) prv = *(const v2u*)(proj + (size_t)(row - 1) * PT + PC_WL + 4 * lane);
            float u[4] = {bflo(cur.x), bfhi(cur.x), bflo(cur.y), bfhi(cur.y)}, up[4] = {bflo(prv.x), bfhi(prv.x), bflo(prv.y), bfhi(prv.y)};
            f32x4 v;
#pragma unroll
            for (int j = 0; j < 4; ++j) { float x = u[j] + (up[j] - u[j]) * mul[j]; if (lane < 16) x = tanhf(x); else if (lane >= 32) x = sigmoidf_(x); v[j] = x; }
            *(LAS f32x4*)(lin + rr * 256 + 4 * lane) = v;
        }
        LDS_WAIT(); asm volatile("" ::: "memory");
        float acc[8][8];
#define LORA_PASS(WPTR, KOFF, KLEN) do { \
        _Pragma("unroll") for (int rr = 0; rr < 8; ++rr) _Pragma("unroll") for (int j = 0; j < 8; ++j) acc[rr][j] = 0.f; \
        for (int k = 0; k < (KLEN); k += 4) { \
            f32x4 wa[4], wb[4]; \
            _Pragma("unroll") for (int q = 0; q < 4; ++q) { wa[q] = *(const f32x4*)((WPTR) + (size_t)(k + q) * BR + c0); wb[q] = *(const f32x4*)((WPTR) + (size_t)(k + q) * BR + c0 + 4); } \
            _Pragma("unroll") for (int rr = 0; rr < 8; ++rr) { const f32x4 in = *(const LAS f32x4*)(lin + rr * 256 + (KOFF) + k); \
                _Pragma("unroll") for (int q = 0; q < 4; ++q) _Pragma("unroll") for (int j = 0; j < 4; ++j) { acc[rr][j] = fmaf(in[q], wa[q][j], acc[rr][j]); acc[rr][4 + j] = fmaf(in[q], wb[q][j], acc[rr][4 + j]); } } \
        } } while (0)
        LORA_PASS(INP(I_DW2) + (size_t)l * 64 * BR, 0, 64);
        unsigned em1p[8][4];
        {
            float w0v[8];
#pragma unroll
            for (int j = 0; j < 8; ++j) w0v[j] = INP(I_DW0)[l * BR + c0 + j];
#pragma unroll
            for (int rr = 0; rr < 8; ++rr) { float o[8];
#pragma unroll
                for (int j = 0; j < 8; ++j) { const float z = -(w0v[j] + acc[rr][j]); const float sp = fmaxf(z, 0.f) + log1pf(expf(-fabsf(z))); o[j] = expm1f(-expf(-sp - 0.5f)); }
#pragma unroll
                for (int q = 0; q < 4; ++q) em1p[rr][q] = pk2(o[2 * q], o[2 * q + 1]); }
        }
        LORA_PASS(INP(I_AW2) + (size_t)l * 64 * BR, 64, 64);
        {
            float a0v[8], kkv[8], kav[8], muk[8];
#pragma unroll
            for (int j = 0; j < 8; ++j) { a0v[j] = INP(I_AA0)[l * BR + c0 + j]; kkv[j] = INP(I_KK)[l * BR + c0 + j]; kav[j] = INP(I_KA)[l * BR + c0 + j]; muk[j] = mu[512 + c0 + j]; }
#pragma unroll
            for (int rr = 0; rr < 8; ++rr) {
                const int row = r0 + rr, t = row % T;
                float kc[8], kp[8];
                unpack8(*(const v4u*)(proj + (size_t)row * PT + PC_RK + c0), kc);
                if (t >= 1) unpack8(*(const v4u*)(proj + (size_t)(row - 1) * PT + PC_RK + c0), kp);
                else {
#pragma unroll
                    for (int j = 0; j < 8; ++j) kp[j] = 0.f; }
                float k2[8], kk[8], bb[8]; float ss = 0.f;
#pragma unroll
                for (int j = 0; j < 8; ++j) { const float km = kc[j] + (kp[j] - kc[j]) * muk[j]; const float a = sigmoidf_(a0v[j] + acc[rr][j]);
                    kk[j] = km * kkv[j]; ss += kk[j] * kk[j]; k2[j] = km * (1.f + (a - 1.f) * kav[j]); bb[j] = a; }
                ss = sum8lanes(ss);
                const float inv = 1.f / fmaxf(sqrtf(ss), 1e-12f);
#pragma unroll
                for (int j = 0; j < 8; ++j) { kk[j] *= inv; bb[j] *= kk[j]; }
                unsigned* ow = (unsigned*)rwx + (size_t)row * 1024 + c0;
                v4u wa0, wa1, wb0, wb1;
                wa0.x = f2bf(k2[0]) | (f2bf(kk[0]) << 16); wa0.y = f2bf(k2[1]) | (f2bf(kk[1]) << 16); wa0.z = f2bf(k2[2]) | (f2bf(kk[2]) << 16); wa0.w = f2bf(k2[3]) | (f2bf(kk[3]) << 16);
                wa1.x = f2bf(k2[4]) | (f2bf(kk[4]) << 16); wa1.y = f2bf(k2[5]) | (f2bf(kk[5]) << 16); wa1.z = f2bf(k2[6]) | (f2bf(kk[6]) << 16); wa1.w = f2bf(k2[7]) | (f2bf(kk[7]) << 16);
                wb0.x = (em1p[rr][0] & 0xffffu) | (f2bf(bb[0]) << 16); wb0.y = (em1p[rr][0] >> 16) | (f2bf(bb[1]) << 16); wb0.z = (em1p[rr][1] & 0xffffu) | (f2bf(bb[2]) << 16); wb0.w = (em1p[rr][1] >> 16) | (f2bf(bb[3]) << 16);
                wb1.x = (em1p[rr][2] & 0xffffu) | (f2bf(bb[4]) << 16); wb1.y = (em1p[rr][2] >> 16) | (f2bf(bb[5]) << 16); wb1.z = (em1p[rr][3] & 0xffffu) | (f2bf(bb[6]) << 16); wb1.w = (em1p[rr][3] >> 16) | (f2bf(bb[7]) << 16);
                *(v4u*)(ow) = wa0; *(v4u*)(ow + 4) = wa1; *(v4u*)(ow + 512) = wb0; *(v4u*)(ow + 516) = wb1;
            }
        }
        LORA_PASS(INP(I_GW2) + (size_t)l * 128 * BR, 128, 128);
#pragma unroll
        for (int rr = 0; rr < 8; ++rr) { float o[8];
#pragma unroll
            for (int j = 0; j < 8; ++j) o[j] = acc[rr][j];
            *(v4u*)(ocat + (size_t)(r0 + rr) * 1536 + 1024 + c0) = pack8(o); }
#undef LORA_PASS
        LDS_WAIT(); asm volatile("" ::: "memory");
    }
}

__device__ __forceinline__ float fexp(float x) { return __builtin_amdgcn_exp2f(x * 1.4426950408889634f); }
__device__ __forceinline__ float fsig(float x) { return __builtin_amdgcn_rcpf(1.0f + fexp(-x)); }
__device__ __forceinline__ float ftanh(float x) { const float e = fexp(-2.0f * fabsf(x)); const float t = (1.0f - e) * __builtin_amdgcn_rcpf(1.0f + e); return x < 0.f ? -t : t; }
__device__ __forceinline__ float flog1pexp(float nz) { return __builtin_amdgcn_logf(1.0f + fexp(nz)) * 0.6931471805599453f; }
__device__ __forceinline__ void m2a_rwkv_prep_chunk(LAS unsigned char* lds_, const int wave_s, int l, const bf16* proj, bf16* rwx, bf16* ocat) {
    const Frame F = make_frame(lds_, wave_s);
    const int lane_ = F.lane;
    LAS float* lin = (LAS float*)(F.lds + 16384 + F.wave * 8192);
    LAS float* wtot = (LAS float*)(F.lds + 16384 + 65536);
    float* gC = (float*)(WSP() + WS_MISC2 + M2_GC); float* bonus = (float*)(WSP() + WS_MISC2 + M2_BONUS);
    const float* mu = INP(I_MU) + l * SHIFT;
    for (int u = F.vcu; u < M / 64; u += F.G) {
        const int r0 = 64 * u + 8 * F.wave;
        int lane = lane_; asm volatile("" : "+v"(lane));
        const int c0 = 8 * lane;
        const f32x4 mul = *(const f32x4*)(mu + 1536 + 4 * lane);
#pragma unroll
        for (int rr = 0; rr < 8; ++rr) {
            const int row = r0 + rr, t = row % T;
            const v2u cur = *(const v2u*)(proj + (size_t)row * PT + PC_WL + 4 * lane);
            v2u prv; prv.x = 0u; prv.y = 0u; if (t >= 1) prv = *(const v2u*)(proj + (size_t)(row - 1) * PT + PC_WL + 4 * lane);
            float u[4] = {bflo(cur.x), bfhi(cur.x), bflo(cur.y), bfhi(cur.y)}, up[4] = {bflo(prv.x), bfhi(prv.x), bflo(prv.y), bfhi(prv.y)};
            f32x4 v;
#pragma unroll
            for (int j = 0; j < 4; ++j) { float x = u[j] + (up[j] - u[j]) * mul[j]; if (lane < 16) x = ftanh(x); else if (lane >= 32) x = fsig(x); v[j] = x; }
            *(LAS f32x4*)(lin + rr * 256 + 4 * lane) = v;
        }
        LDS_WAIT(); asm volatile("" ::: "memory");
        float acc[8][8];
#define LORA_PASS(WPTR, KOFF, KLEN) do { \
        _Pragma("unroll") for (int rr = 0; rr < 8; ++rr) _Pragma("unroll") for (int j = 0; j < 8; ++j) acc[rr][j] = 0.f; \
        for (int k = 0; k < (KLEN); k += 4) { \
            f32x4 wa[4], wb[4]; \
            _Pragma("unroll") for (int q = 0; q < 4; ++q) { wa[q] = *(const f32x4*)((WPTR) + (size_t)(k + q) * BR + c0); wb[q] = *(const f32x4*)((WPTR) + (size_t)(k + q) * BR + c0 + 4); } \
            _Pragma("unroll") for (int rr = 0; rr < 8; ++rr) { const f32x4 in = *(const LAS f32x4*)(lin + rr * 256 + (KOFF) + k); \
                _Pragma("unroll") for (int q = 0; q < 4; ++q) _Pragma("unroll") for (int j = 0; j < 4; ++j) { acc[rr][j] = fmaf(in[q], wa[q][j], acc[rr][j]); acc[rr][4 + j] = fmaf(in[q], wb[q][j], acc[rr][4 + j]); } } \
        } } while (0)
        LORA_PASS(INP(I_DW2) + (size_t)l * 64 * BR, 0, 64);
        float lwv[8][8];
        float off[8];
        {
            float w0v[8], tot[8];
#pragma unroll
            for (int j = 0; j < 8; ++j) { w0v[j] = INP(I_DW0)[l * BR + c0 + j]; tot[j] = 0.f; }
#pragma unroll
            for (int rr = 0; rr < 8; ++rr)
#pragma unroll
                for (int j = 0; j < 8; ++j) { const float z = -(w0v[j] + acc[rr][j]); const float sp = fmaxf(z, 0.f) + flog1pexp(-fabsf(z)); lwv[rr][j] = -fexp(-sp - 0.5f); tot[j] += lwv[rr][j]; }
            *(LAS f32x4*)(wtot + F.wave * 512 + c0) = (f32x4){tot[0], tot[1], tot[2], tot[3]}; *(LAS f32x4*)(wtot + F.wave * 512 + c0 + 4) = (f32x4){tot[4], tot[5], tot[6], tot[7]};
            __syncthreads();
#pragma unroll
            for (int j = 0; j < 8; ++j) off[j] = 0.f;
            for (int w = 0; w < F.wave; ++w) { const f32x4 a0 = *(const LAS f32x4*)(wtot + w * 512 + c0), a1 = *(const LAS f32x4*)(wtot + w * 512 + c0 + 4);
#pragma unroll
                for (int j = 0; j < 4; ++j) { off[j] += a0[j]; off[4 + j] += a1[j]; } }
            if (F.wave == 7) {
#pragma unroll
                for (int j = 0; j < 8; ++j) gC[(size_t)u * 512 + c0 + j] = fexp(off[j] + tot[j]); }
        }
        LORA_PASS(INP(I_AW2) + (size_t)l * 64 * BR, 64, 64);
        {
#pragma unroll
            for (int rr = 0; rr < 8; ++rr) {
                const int row = r0 + rr, t = row % T;
                float a0v[8], kkv[8], kav[8], muk[8], mur[8], rkv[8];
#pragma unroll
                for (int j = 0; j < 8; ++j) { a0v[j] = INP(I_AA0)[l * BR + c0 + j]; kkv[j] = INP(I_KK)[l * BR + c0 + j]; kav[j] = INP(I_KA)[l * BR + c0 + j]; muk[j] = mu[512 + c0 + j]; mur[j] = mu[c0 + j]; rkv[j] = INP(I_RK)[l * BR + c0 + j]; }
                float kc[8], kp[8], rc[8], rp[8];
                unpack8(*(const v4u*)(proj + (size_t)row * PT + PC_RK + c0), kc); unpack8(*(const v4u*)(proj + (size_t)row * PT + PC_R + c0), rc);
                if (t >= 1) { unpack8(*(const v4u*)(proj + (size_t)(row - 1) * PT + PC_RK + c0), kp); unpack8(*(const v4u*)(proj + (size_t)(row - 1) * PT + PC_R + c0), rp); }
                else {
#pragma unroll
                    for (int j = 0; j < 8; ++j) { kp[j] = 0.f; rp[j] = 0.f; } }
                float k2[8], kk[8], bb[8], rm[8]; float ss = 0.f, bn = 0.f;
#pragma unroll
                for (int j = 0; j < 8; ++j) { const float km = kc[j] + (kp[j] - kc[j]) * muk[j]; const float a = fsig(a0v[j] + acc[rr][j]);
                    kk[j] = km * kkv[j]; ss += kk[j] * kk[j]; k2[j] = km * (1.f + (a - 1.f) * kav[j]); bb[j] = a;
                    rm[j] = rc[j] + (rp[j] - rc[j]) * mur[j]; bn += rm[j] * k2[j] * rkv[j]; }
                ss = sum8lanes(ss); bn = sum8lanes(bn);
                if ((lane & 7) == 0) bonus[(size_t)row * NH + (lane >> 3)] = bn;
                const float inv = 1.f / fmaxf(sqrtf(ss), 1e-12f);
                float okt[8], okp[8], orh[8], obt[8];
#pragma unroll
                for (int j = 0; j < 8; ++j) { const float Lp = off[j]; off[j] += lwv[rr][j];
                    const float eL = fexp(off[j]), eLm = __builtin_amdgcn_rcpf(eL), eLp = fexp(Lp);
                    kk[j] *= inv; bb[j] *= kk[j];
                    okt[j] = k2[j] * eLm; okp[j] = kk[j] * eLp; orh[j] = rm[j] * eL; obt[j] = bb[j] * eLm; }
                bf16* o = rwx + (size_t)row * 2048 + c0;
                *(v4u*)(o) = pack8(okt); *(v4u*)(o + 512) = pack8(okp); *(v4u*)(o + 1024) = pack8(orh); *(v4u*)(o + 1536) = pack8(obt);
                asm volatile("" ::: "memory");
            }
        }
        LORA_PASS(INP(I_GW2) + (size_t)l * 128 * BR, 128, 128);
#pragma unroll
        for (int rr = 0; rr < 8; ++rr) { float o[8];
#pragma unroll
            for (int j = 0; j < 8; ++j) o[j] = acc[rr][j];
            *(v4u*)(ocat + (size_t)(r0 + rr) * 1536 + 1024 + c0) = pack8(o); }
#undef LORA_PASS
        LDS_WAIT(); asm volatile("" ::: "memory");
        __syncthreads();
    }
}

__device__ __forceinline__ void m2b_attn_naive(LAS unsigned char* lds_, const int wave_s, const bf16* proj, bf16* ocat) {
    const Frame F = make_frame(lds_, wave_s);
    const float* ksum = (const float*)(WSP() + WS_MISC2 + M2_KSUM);
    LAS float* kml = (LAS float*)(F.lds);
    LAS float* gl = (LAS float*)(F.lds + 4096);
    for (int base = F.vcu * 512; base < M * NH; base += F.G * 512) {
        const int idx = base + F.tid;
        const int t = idx % T, h = (idx / T) % NH, b = idx / (T * NH), m = b * T + t, own = t >> 8;
        __syncthreads();
        for (int i = F.tid; i < 16 * 64; i += 512) { const float* km = ksum + ((((size_t)b * NH + h) * 16 + (i >> 6)) * 4) * 64 + (i & 63); kml[i] = (km[0] + km[64]) + (km[128] + km[192]); }
        __syncthreads();
        unsigned qw[32]; float acc[64];
        const bf16* qp = proj + (size_t)m * PT + PC_Q + h * 64;
#pragma unroll
        for (int d8 = 0; d8 < 8; ++d8) { const v4u w = *(const v4u*)(qp + 8 * d8); qw[4 * d8] = w.x; qw[4 * d8 + 1] = w.y; qw[4 * d8 + 2] = w.z; qw[4 * d8 + 3] = w.w;
#pragma unroll
            for (int j = 0; j < 8; ++j) acc[8 * d8 + j] = 0.f; }
#define QF(d) (((d) & 1) ? bfhi(qw[(d) >> 1]) : bflo(qw[(d) >> 1]))
        int mask = 0;
        if (own <= 3) mask = (1 << own) - 1;
        else {
            for (int n = 0; n < own; ++n) { float s = 0.f;
#pragma unroll
                for (int d = 0; d < 64; ++d) s = fmaf(QF(d), kml[n * 64 + d], s);
                gl[F.tid * 17 + n] = s; }
            for (int r = 0; r < 3; ++r) {
                float best = -INFINITY; int bi = -1;
                for (int n = 0; n < own; ++n) { const float g = gl[F.tid * 17 + n]; if (!((mask >> n) & 1) && (bi < 0 || g > best)) { best = g; bi = n; } }
                mask |= (1 << bi);
            }
        }
        float mx = -INFINITY, lsum = 0.f;
        for (int n = 0; n <= own; ++n) {
            const bool isown = (n == own);
            if (!isown && !((mask >> n) & 1)) continue;
            const int kend = isown ? (t & 255) : 255;
            const bf16* kb = proj + ((size_t)(b * T + n * 256)) * PT + PC_K + h * 64;
            for (int kk = 0; kk <= kend; ++kk) {
                const bf16* kr = kb + (size_t)kk * PT; const bf16* vr = kr + (PC_V - PC_K);
                float s = 0.f;
#pragma unroll
                for (int d8 = 0; d8 < 8; ++d8) { float f[8]; unpack8(*(const v4u*)(kr + 8 * d8), f);
#pragma unroll
                    for (int j = 0; j < 8; ++j) s = fmaf(QF(8 * d8 + j), f[j], s); }
                if (s > mx) { const float f = exp2f(mx - s); lsum *= f;
#pragma unroll
                    for (int d = 0; d < 64; ++d) acc[d] *= f;
                    mx = s; }
                const float p = exp2f(s - mx); lsum += p;
#pragma unroll
                for (int d8 = 0; d8 < 8; ++d8) { float f[8]; unpack8(*(const v4u*)(vr + 8 * d8), f);
#pragma unroll
                    for (int j = 0; j < 8; ++j) acc[8 * d8 + j] = fmaf(p, f[j], acc[8 * d8 + j]); }
            }
        }
        const float il = 1.f / lsum;
        bf16* op = ocat + (size_t)m * 1536 + 512 + h * 64;
#pragma unroll
        for (int d8 = 0; d8 < 8; ++d8) { float f[8];
#pragma unroll
            for (int j = 0; j < 8; ++j) f[j] = acc[8 * d8 + j] * il;
            *(v4u*)(op + 8 * d8) = pack8(f); }
#undef QF
    }
}
__device__ __forceinline__ void m2b_scan_naive(LAS unsigned char* lds_, const int wave_s, int l, const bf16* proj, const bf16* rwx, bf16* ysc) {
    const Frame F = make_frame(lds_, wave_s);
    const int NGW = F.G * NWAVES, lane = F.lane;
    const float* mu = INP(I_MU) + l * SHIFT;
    for (int gw = F.vcu * NWAVES + F.wave; gw < NB * NH * 64; gw += NGW) {
        const int i = gw & 63, h = (gw >> 6) & 7, b = gw >> 9, c = h * 64 + lane;
        const float mur = mu[c], muv = mu[1024 + h * 64 + i];
        float S = 0.f, rprev = 0.f, vprev = 0.f;
        for (int t = 0; t < T; ++t) {
            const size_t row = (size_t)b * T + t;
            const float rraw = bf1(proj[row * PT + PC_R + c]), vraw = bf1(proj[row * PT + PC_RV + h * 64 + i]);
            const float r = rraw + (rprev - rraw) * mur, vi = vraw + (vprev - vraw) * muv;
            rprev = rraw; vprev = vraw;
            const unsigned* x = (const unsigned*)rwx + row * 1024 + c;
            const unsigned wa = x[0], wb = x[512];
            const float k2 = bflo(wa), kk = bfhi(wa), em1 = bflo(wb), bb = bfhi(wb);
            const float sa = -wave_sum(S * kk);
            S = (S + S * em1) + sa * bb + vi * k2;
            const float y = wave_sum(S * r);
            if (lane == 0) ysc[row * BR + h * 64 + i] = (bf16)f2bf(y);
        }
    }
}
__device__ __forceinline__ float dpp_f(float x, const int sel) {
    const int v = __builtin_bit_cast(int, x); int r;
    switch (sel) {
      case 1: r = __builtin_amdgcn_update_dpp(0, v, 0x111, 0xF, 0xF, true); break;
      case 2: r = __builtin_amdgcn_update_dpp(0, v, 0x112, 0xF, 0xF, true); break;
      case 3: r = __builtin_amdgcn_update_dpp(0, v, 0x113, 0xF, 0xF, true); break;
      case 4: r = __builtin_amdgcn_update_dpp(0, v, 0x114, 0xF, 0xE, true); break;
      case 8: r = __builtin_amdgcn_update_dpp(0, v, 0x118, 0xF, 0xC, true); break;
      case 15: r = __builtin_amdgcn_update_dpp(0, v, 0x142, 0xA, 0xF, true); break;
      case 31: r = __builtin_amdgcn_update_dpp(0, v, 0x143, 0xC, 0xF, true); break;
      case 100: r = __builtin_amdgcn_update_dpp(0, v, 0xB1, 0xF, 0xF, true); break;
      case 101: r = __builtin_amdgcn_update_dpp(0, v, 0x4E, 0xF, 0xF, true); break;
      case 104: r = __builtin_amdgcn_update_dpp(0, v, 0x124, 0xF, 0xF, true); break;
      default: r = __builtin_amdgcn_update_dpp(0, v, 0x128, 0xF, 0xF, true); break;
    }
    return __builtin_bit_cast(float, r);
}
__device__ __forceinline__ float wsum_to_sgpr(float x) {
    float t = x + dpp_f(x, 1); t = t + dpp_f(x, 2); t = t + dpp_f(x, 3); t = t + dpp_f(t, 4); t = t + dpp_f(t, 8); t = t + dpp_f(t, 15); t = t + dpp_f(t, 31);
    return __builtin_bit_cast(float, __builtin_amdgcn_readlane(__builtin_bit_cast(int, t), 63));
}
struct ScanIn { unsigned r, wa, wb, vv; };
__device__ __forceinline__ void m2b_scan(LAS unsigned char* lds_, const int wave_s, int l, const bf16* __restrict__ proj, const bf16* __restrict__ rwx, bf16* __restrict__ ysc) {
    const Frame F = make_frame(lds_, wave_s);
    const int lane = F.lane;
    const float* mu = INP(I_MU) + l * SHIFT;
    const bool b0 = (lane & 1) != 0, b1 = (lane & 2) != 0;
    for (int gw = F.vcu * NWAVES + F.wave; gw < NB * NH * 64; gw += F.G * NWAVES) {
        const int i = gw & 63, h = (gw >> 6) & 7, b = gw >> 9, c = h * 64 + lane;
        const float mur = mu[c], muv = mu[1024 + h * 64 + i];
        const bf16* pr = proj + (size_t)b * T * PT + PC_R + c;
        const bf16* pv = proj + (size_t)b * T * PT + PC_RV + h * 64 + i;
        const unsigned* px = (const unsigned*)rwx + (size_t)b * T * 1024 + c;
        bf16* py = ysc + (size_t)b * T * BR + h * 64 + i;
        float S = 0.f, rp = 0.f, vp = 0.f;
#define SC_LOAD(X, t_) do { const int tt = (t_) < T ? (t_) : T - 1; X.r = pr[(size_t)tt * PT]; X.vv = pv[(size_t)tt * PT]; X.wa = px[(size_t)tt * 1024]; X.wb = px[(size_t)tt * 1024 + 512]; } while (0)
#define SC_STEP(X, Q) do { \
        const float rr = __uint_as_float(X.r << 16), vr = __uint_as_float(X.vv << 16); \
        const float r_ = rr + (rp - rr) * mur, vi = vr + (vp - vr) * muv; rp = rr; vp = vr; \
        const float k2 = bflo(X.wa), kk = bfhi(X.wa), em1 = bflo(X.wb), bb = bfhi(X.wb); \
        const float ps = wsum_to_sgpr(S * kk); \
        S = __builtin_fmaf(S, em1, S) + __builtin_fmaf(-ps, bb, vi * k2); \
        Q = S * r_; } while (0)
#define SC_YOUT(t0) do { \
        const float z = (b0 ? q1 : q0) + dpp_f(b0 ? q0 : q1, 100); \
        const float w = (b0 ? q3 : q2) + dpp_f(b0 ? q2 : q3, 100); \
        float v_ = (b1 ? w : z) + dpp_f(b1 ? z : w, 101); \
        v_ += dpp_f(v_, 104); v_ += dpp_f(v_, 108); \
        v_ += __shfl_xor(v_, 16); v_ += __shfl_xor(v_, 32); \
        if (lane < 4) py[(size_t)((t0) + lane) * BR] = (bf16)f2bf(v_); } while (0)
        ScanIn a0, a1, a2, a3, e0, e1, e2, e3, g0, g1, g2, g3, h0, h1, h2, h3;
        float q0, q1, q2, q3;
        SC_LOAD(a0, 0); SC_LOAD(a1, 1); SC_LOAD(a2, 2); SC_LOAD(a3, 3);
        SC_LOAD(e0, 4); SC_LOAD(e1, 5); SC_LOAD(e2, 6); SC_LOAD(e3, 7);
        SC_LOAD(g0, 8); SC_LOAD(g1, 9); SC_LOAD(g2, 10); SC_LOAD(g3, 11);
        for (int t = 0; t < T; t += 16) {
            SC_LOAD(h0, t + 12); SC_LOAD(h1, t + 13); SC_LOAD(h2, t + 14); SC_LOAD(h3, t + 15);
            SC_STEP(a0, q0); SC_STEP(a1, q1); SC_STEP(a2, q2); SC_STEP(a3, q3); SC_YOUT(t);
            SC_LOAD(a0, t + 16); SC_LOAD(a1, t + 17); SC_LOAD(a2, t + 18); SC_LOAD(a3, t + 19);
            SC_STEP(e0, q0); SC_STEP(e1, q1); SC_STEP(e2, q2); SC_STEP(e3, q3); SC_YOUT(t + 4);
            SC_LOAD(e0, t + 20); SC_LOAD(e1, t + 21); SC_LOAD(e2, t + 22); SC_LOAD(e3, t + 23);
            SC_STEP(g0, q0); SC_STEP(g1, q1); SC_STEP(g2, q2); SC_STEP(g3, q3); SC_YOUT(t + 8);
            SC_LOAD(g0, t + 24); SC_LOAD(g1, t + 25); SC_LOAD(g2, t + 26); SC_LOAD(g3, t + 27);
            SC_STEP(h0, q0); SC_STEP(h1, q1); SC_STEP(h2, q2); SC_STEP(h3, q3); SC_YOUT(t + 12);
        }
#undef SC_LOAD
#undef SC_STEP
#undef SC_YOUT
    }
}
__device__ __forceinline__ void m2c_rwkv_post(LAS unsigned char* lds_, const int wave_s, int l, const bf16* proj, const bf16* rwx, const bf16* ysc, bf16* ocat) {
    const Frame F = make_frame(lds_, wave_s);
    const int gw = F.vcu * NWAVES + F.wave, NGW = F.G * NWAVES, c0 = 8 * F.lane;
    const float* mu = INP(I_MU) + l * SHIFT;
    float mur[8], muv[8], rk[8], gg[8], gb[8];
#pragma unroll
    for (int j = 0; j < 8; ++j) { mur[j] = mu[c0 + j]; muv[j] = mu[1024 + c0 + j]; rk[j] = INP(I_RK)[l * BR + c0 + j]; gg[j] = INP(I_GNG)[l * BR + c0 + j]; gb[j] = INP(I_GNB)[l * BR + c0 + j]; }
    for (int m = gw; m < M; m += NGW) {
        const int t = m % T;
        float y[8], rc[8], rp[8], vc[8], vp[8], k2[8], g[8];
        unpack8(*(const v4u*)(ysc + (size_t)m * BR + c0), y);
        unpack8(*(const v4u*)(proj + (size_t)m * PT + PC_R + c0), rc); unpack8(*(const v4u*)(proj + (size_t)m * PT + PC_RV + c0), vc);
        if (t >= 1) { unpack8(*(const v4u*)(proj + (size_t)(m - 1) * PT + PC_R + c0), rp); unpack8(*(const v4u*)(proj + (size_t)(m - 1) * PT + PC_RV + c0), vp); }
        else {
#pragma unroll
            for (int j = 0; j < 8; ++j) { rp[j] = 0.f; vp[j] = 0.f; } }
        { const unsigned* wa = (const unsigned*)rwx + (size_t)m * 1024 + c0; const v4u a0 = *(const v4u*)wa, a1 = *(const v4u*)(wa + 4);
          k2[0] = bflo(a0.x); k2[1] = bflo(a0.y); k2[2] = bflo(a0.z); k2[3] = bflo(a0.w); k2[4] = bflo(a1.x); k2[5] = bflo(a1.y); k2[6] = bflo(a1.z); k2[7] = bflo(a1.w); }
        unpack8(*(const v4u*)(ocat + (size_t)m * 1536 + 1024 + c0), g);
        float s = 0.f;
#pragma unroll
        for (int j = 0; j < 8; ++j) s += y[j];
        const float mean = sum8lanes(s) * (1.f / 64.f);
        float q = 0.f, bn = 0.f;
#pragma unroll
        for (int j = 0; j < 8; ++j) { y[j] -= mean; q += y[j] * y[j]; const float r = rc[j] + (rp[j] - rc[j]) * mur[j]; bn += r * k2[j] * rk[j]; }
        const float rstd = rsqrtf(sum8lanes(q) * (1.f / 64.f) + GN_EPS);
        bn = sum8lanes(bn);
        float o[8];
#pragma unroll
        for (int j = 0; j < 8; ++j) { const float v = vc[j] + (vp[j] - vc[j]) * muv[j]; o[j] = (y[j] * rstd * gg[j] + gb[j] + bn * v) * g[j]; }
        *(v4u*)(ocat + (size_t)m * 1536 + 1024 + c0) = pack8(o);
    }
}

__device__ __forceinline__ void m2c_rwkv_post2(LAS unsigned char* lds_, const int wave_s, int l, const bf16* proj, const bf16* ysc, bf16* ocat) {
    const Frame F = make_frame(lds_, wave_s);
    const int gw = F.vcu * NWAVES + F.wave, NGW = F.G * NWAVES, c0 = 8 * F.lane;
    const float* mu = INP(I_MU) + l * SHIFT;
    float mur[8], muv[8], rk[8], gg[8], gb[8];
#pragma unroll
    for (int j = 0; j < 8; ++j) { mur[j] = mu[c0 + j]; muv[j] = mu[1024 + c0 + j]; rk[j] = INP(I_RK)[l * BR + c0 + j]; gg[j] = INP(I_GNG)[l * BR + c0 + j]; gb[j] = INP(I_GNB)[l * BR + c0 + j]; }
    for (int m = gw; m < M; m += NGW) {
        const int t = m % T;
        float y[8], vc[8], vp[8], g[8];
        unpack8(*(const v4u*)(ysc + (size_t)m * BR + c0), y);
        unpack8(*(const v4u*)(proj + (size_t)m * PT + PC_RV + c0), vc);
        if (t >= 1) { unpack8(*(const v4u*)(proj + (size_t)(m - 1) * PT + PC_RV + c0), vp); }
        else {
#pragma unroll
            for (int j = 0; j < 8; ++j) { vp[j] = 0.f; } }
        unpack8(*(const v4u*)(ocat + (size_t)m * 1536 + 1024 + c0), g);
        float s = 0.f;
#pragma unroll
        for (int j = 0; j < 8; ++j) s += y[j];
        const float mean = sum8lanes(s) * (1.f / 64.f);
        float q = 0.f; const float bn = ((const float*)(WSP() + WS_MISC2 + M2_BONUS))[(size_t)m * NH + (F.lane >> 3)];
#pragma unroll
        for (int j = 0; j < 8; ++j) { y[j] -= mean; q += y[j] * y[j]; }
        const float rstd = rsqrtf(sum8lanes(q) * (1.f / 64.f) + GN_EPS);
        float o[8];
#pragma unroll
        for (int j = 0; j < 8; ++j) { const float v = vc[j] + (vp[j] - vc[j]) * muv[j]; o[j] = (y[j] * rstd * gg[j] + gb[j] + bn * v) * g[j]; }
        *(v4u*)(ocat + (size_t)m * 1536 + 1024 + c0) = pack8(o);
    }
}

template <bool ROUTE, bool WRITE_XB>
__device__ __forceinline__ void ln_pass(LAS unsigned char* lds_, const int wave_s, const float* g, const float* bta, float* xio, bf16* xb, const float* rw, int* cnt, int* asg_e, int* asg_rank, float* asg_gate) {
    const Frame F = make_frame(lds_, wave_s);
    const int gw = F.vcu * NWAVES + F.wave, NGW = F.G * NWAVES, lane = F.lane;
    for (int m = gw; m < M; m += NGW) {
        GAS f32x4* xr = (GAS f32x4*)(xio + (size_t)m * D) + lane;
        f32x4 v[4]; float s = 0.f;
#pragma unroll
        for (int j = 0; j < 4; ++j) { v[j] = xr[64 * j]; s += (v[j].x + v[j].y) + (v[j].z + v[j].w); }
        const float mean = wave_sum(s) * (1.f / D); float s2 = 0.f;
#pragma unroll
        for (int j = 0; j < 4; ++j) { v[j] = v[j] - mean; s2 += (v[j].x * v[j].x + v[j].y * v[j].y) + (v[j].z * v[j].z + v[j].w * v[j].w); }
        const float rstd = 1.f / sqrtf(wave_sum(s2) * (1.f / D) + LN_EPS);
#pragma unroll
        for (int j = 0; j < 4; ++j) { const f32x4 gv = *(const f32x4*)(g + 4 * lane + 256 * j), bv = *(const f32x4*)(bta + 4 * lane + 256 * j); v[j] = v[j] * rstd * gv + bv; xr[64 * j] = v[j]; }
        if (WRITE_XB) { GAS unsigned long long* o8 = (GAS unsigned long long*)(xb + (size_t)m * D) + lane;
#pragma unroll
            for (int j = 0; j < 4; ++j) o8[64 * j] = (unsigned long long)pk2(v[j].x, v[j].y) | ((unsigned long long)pk2(v[j].z, v[j].w) << 32); }
        if (ROUTE) {
            float lg[8];
#pragma unroll
            for (int e = 0; e < 8; ++e) lg[e] = 0.f;
#pragma unroll
            for (int j = 0; j < 4; ++j)
#pragma unroll
                for (int i = 0; i < 4; ++i) { const int d = 4 * lane + 256 * j + i; const f32x4 r0 = *(const f32x4*)(rw + d * NE), r1 = *(const f32x4*)(rw + d * NE + 4); const float xv = v[j][i];
#pragma unroll
                    for (int e = 0; e < 4; ++e) { lg[e] = fmaf(xv, r0[e], lg[e]); lg[4 + e] = fmaf(xv, r1[e], lg[4 + e]); } }
#pragma unroll
            for (int e = 0; e < 8; ++e) lg[e] = wave_sum(lg[e]);
            if (lane == 0) {
                int e1 = 0; float l1 = lg[0];
#pragma unroll
                for (int e = 1; e < 8; ++e) if (lg[e] > l1) { l1 = lg[e]; e1 = e; }
                int e2 = -1; float l2 = -INFINITY;
#pragma unroll
                for (int e = 0; e < 8; ++e) if (e != e1 && (e2 < 0 || lg[e] > l2)) { l2 = lg[e]; e2 = e; }
                const float p2 = expf(l2 - l1); const float g1 = 1.f / (1.f + p2), g2 = p2 / (1.f + p2);
                asg_e[2 * m] = e1; asg_e[2 * m + 1] = e2; asg_gate[2 * m] = g1; asg_gate[2 * m + 1] = g2;
                asg_rank[2 * m] = atomicAdd(&cnt[e1], 1); asg_rank[2 * m + 1] = atomicAdd(&cnt[e2], 1);
            }
        }
    }
}

__device__ __forceinline__ void moe_scatter(LAS unsigned char* lds_, const int wave_s, const int* cnt, const int* asg_e, const int* asg_rank, int* asg_pos, const bf16* xb, bf16* xs, int* tile_e) {
    const Frame F = make_frame(lds_, wave_s);
    const int gw = F.vcu * NWAVES + F.wave, NGW = F.G * NWAVES, lane = F.lane;
    int pstart[NE + 1]; int c[NE];
    { int s = 0;
#pragma unroll
      for (int e = 0; e < NE; ++e) { c[e] = cnt[e]; pstart[e] = s; s += ((c[e] + 255) >> 8) << 8; }
      pstart[NE] = s; }
    if (F.vcu == 0 && F.tid == 0) {
        const int ntiles = pstart[NE] >> 8;
        for (int ti = 0; ti < ntiles; ++ti) { int e = 0;
#pragma unroll
            for (int q = 1; q < NE; ++q) if ((ti << 8) >= pstart[q]) e = q;
            tile_e[ti] = e; }
        tile_e[MOE_MAXT] = ntiles;
    }
    for (int a = gw; a < 2 * M; a += NGW) {
        const int e = asg_e[a]; int ps = 0;
#pragma unroll
        for (int q = 0; q < NE; ++q) if (q == e) ps = pstart[q];
        const int pos = ps + asg_rank[a];
        if (lane == 0) asg_pos[a] = pos;
        const v4u* src = (const v4u*)(xb + (size_t)(a >> 1) * D); v4u* dst = (v4u*)(xs + (size_t)pos * D);
        dst[lane] = src[lane]; dst[64 + lane] = src[64 + lane];
    }
#pragma unroll
    for (int e = 0; e < NE; ++e) {
        const int p0 = pstart[e] + c[e], p1 = pstart[e + 1];
        for (int p = p0 + gw; p < p1; p += NGW) { v4u* dst = (v4u*)(xs + (size_t)p * D); const v4u z = {0u, 0u, 0u, 0u}; dst[lane] = z; dst[64 + lane] = z; }
    }
}
__device__ __forceinline__ void moe_final_ln(LAS unsigned char* lds_, const int wave_s, const float* g, const float* bta, float* xio, const bf16* ybuf, const int* asg_pos, const float* asg_gate) {
    const Frame F = make_frame(lds_, wave_s);
    const int gw = F.vcu * NWAVES + F.wave, NGW = F.G * NWAVES, lane = F.lane;
    for (int m = gw; m < M; m += NGW) {
        GAS f32x4* xr = (GAS f32x4*)(xio + (size_t)m * D) + lane;
        const int p0 = asg_pos[2 * m], p1 = asg_pos[2 * m + 1]; const float g0 = asg_gate[2 * m], g1 = asg_gate[2 * m + 1];
        const v2u* y0 = (const v2u*)(ybuf + (size_t)p0 * D) + lane; const v2u* y1 = (const v2u*)(ybuf + (size_t)p1 * D) + lane;
        f32x4 v[4]; float s = 0.f;
#pragma unroll
        for (int j = 0; j < 4; ++j) { const v2u a = y0[64 * j], b = y1[64 * j]; const f32x4 x = xr[64 * j];
            v[j].x = ALPHA * x.x + g0 * bflo(a.x) + g1 * bflo(b.x); v[j].y = ALPHA * x.y + g0 * bfhi(a.x) + g1 * bfhi(b.x);
            v[j].z = ALPHA * x.z + g0 * bflo(a.y) + g1 * bflo(b.y); v[j].w = ALPHA * x.w + g0 * bfhi(a.y) + g1 * bfhi(b.y);
            s += (v[j].x + v[j].y) + (v[j].z + v[j].w); }
        const float mean = wave_sum(s) * (1.f / D); float s2 = 0.f;
#pragma unroll
        for (int j = 0; j < 4; ++j) { v[j] = v[j] - mean; s2 += (v[j].x * v[j].x + v[j].y * v[j].y) + (v[j].z * v[j].z + v[j].w * v[j].w); }
        const float rstd = 1.f / sqrtf(wave_sum(s2) * (1.f / D) + LN_EPS);
#pragma unroll
        for (int j = 0; j < 4; ++j) { const f32x4 gv = *(const f32x4*)(g + 4 * lane + 256 * j), bv = *(const f32x4*)(bta + 4 * lane + 256 * j); xr[64 * j] = v[j] * rstd * gv + bv; }
    }
}

__device__ __forceinline__ float rsum32(float x) {
    x += dpp_f(x, 108); x += dpp_f(x, 104);
    { const int v = __builtin_bit_cast(int, x); x += __builtin_bit_cast(float, __builtin_amdgcn_update_dpp(0, v, 0x122, 0xF, 0xF, true)); }
    { const int v = __builtin_bit_cast(int, x); x += __builtin_bit_cast(float, __builtin_amdgcn_update_dpp(0, v, 0x121, 0xF, 0xF, true)); }
    x += __shfl_xor(x, 16);
    return x;
}
__device__ __forceinline__ void m2a_rwkv_prep_mfma(LAS unsigned char* lds_, const int wave_s, int l, const bf16* proj, bf16* rwx, bf16* ocat) {
    typedef float f32x16 __attribute__((ext_vector_type(16)));
    typedef short bf16x8 __attribute__((ext_vector_type(8)));
    const Frame F = make_frame(lds_, wave_s);
    const int lane_ = F.lane, hd = F.wave;
    LAS unsigned char* lin = F.lds;
    constexpr int LP = 528;
    float* gC = (float*)(WSP() + WS_MISC2 + M2_GC); float* bonus = (float*)(WSP() + WS_MISC2 + M2_BONUS);
    const float* mu = INP(I_MU) + l * SHIFT;
    const bf16* LT = (const bf16*)(WSP() + WS_MISC2 + M2_LORAT) + (size_t)l * 131072;
    for (int u = F.vcu; u < M / 64; u += F.G) {
        int lane = lane_; asm volatile("" : "+v"(lane));
        const int tid = hd * 64 + lane, r = lane & 31, hh = lane >> 5;
        __syncthreads();
        {
            const int lr = tid >> 3, cg = tid & 7, row = 64 * u + lr, t = row % T;
            const bf16* pc = proj + (size_t)row * PT + PC_WL + cg * 32;
#pragma unroll
            for (int q = 0; q < 4; ++q) {
                float cur[8], prv[8], o[8];
                unpack8(*(const v4u*)(pc + 8 * q), cur);
                if (t >= 1) unpack8(*(const v4u*)(pc - PT + 8 * q), prv);
                else {
#pragma unroll
                    for (int j = 0; j < 8; ++j) prv[j] = 0.f; }
                const f32x4 m0 = *(const f32x4*)(mu + 1536 + cg * 32 + 8 * q), m1 = *(const f32x4*)(mu + 1536 + cg * 32 + 8 * q + 4);
#pragma unroll
                for (int j = 0; j < 8; ++j) { float x = cur[j] + (prv[j] - cur[j]) * (j < 4 ? m0[j & 3] : m1[j & 3]); if (cg < 2) x = ftanh(x); else if (cg >= 4) x = fsig(x); o[j] = x; }
                *(LAS v4u*)(lin + lr * LP + (cg * 32 + 8 * q) * 2) = pack8(o);
            }
        }
        __syncthreads();
        const LAS unsigned char* ab = lin + r * LP + 16 * hh;
#define PREP_MM(ACC, KOFF, NKS, LTOFF, LTK) do { \
        _Pragma("unroll") for (int a_ = 0; a_ < 2; ++a_) _Pragma("unroll") for (int b_ = 0; b_ < 2; ++b_) ACC[a_][b_] = f32x16{}; \
        const bf16* bt_ = LT + (LTOFF) + (size_t)(hd * 64 + r) * (LTK) + 8 * hh; \
        _Pragma("unroll") for (int ks = 0; ks < (NKS); ++ks) { \
            const bf16x8 a0 = *(const LAS bf16x8*)(ab + ((KOFF) + 16 * ks) * 2), a1 = *(const LAS bf16x8*)(ab + 32 * LP + ((KOFF) + 16 * ks) * 2); \
            const bf16x8 b0 = *(const bf16x8*)(bt_ + 16 * ks), b1 = *(const bf16x8*)(bt_ + (size_t)32 * (LTK) + 16 * ks); \
            ACC[0][0] = __builtin_amdgcn_mfma_f32_32x32x16_bf16(a0, b0, ACC[0][0], 0, 0, 0); ACC[0][1] = __builtin_amdgcn_mfma_f32_32x32x16_bf16(a0, b1, ACC[0][1], 0, 0, 0); \
            ACC[1][0] = __builtin_amdgcn_mfma_f32_32x32x16_bf16(a1, b0, ACC[1][0], 0, 0, 0); ACC[1][1] = __builtin_amdgcn_mfma_f32_32x32x16_bf16(a1, b1, ACC[1][1], 0, 0, 0); } } while (0)
        f32x16 lw[2][2];
        PREP_MM(lw, 0, 4, 0, 64);
        float offg[2][2][4];
#pragma unroll
        for (int ct = 0; ct < 2; ++ct) {
            const float w0 = INP(I_DW0)[l * BR + hd * 64 + 32 * ct + r];
            float gt[2][4], pt[2][4];
#pragma unroll
            for (int rt = 0; rt < 2; ++rt)
#pragma unroll
                for (int g = 0; g < 4; ++g) { float s = 0.f;
#pragma unroll
                    for (int e = 0; e < 4; ++e) { const float z = -(w0 + lw[rt][ct][4 * g + e]); const float sp = fmaxf(z, 0.f) + flog1pexp(-fabsf(z)); const float v = -fexp(-sp - 0.5f); lw[rt][ct][4 * g + e] = v; s += v; }
                    gt[rt][g] = s; pt[rt][g] = __shfl_xor(s, 32); }
            float base = 0.f;
#pragma unroll
            for (int rt = 0; rt < 2; ++rt)
#pragma unroll
                for (int g = 0; g < 4; ++g) { offg[rt][ct][g] = base + (hh ? pt[rt][g] : 0.f); base += gt[rt][g] + pt[rt][g]; }
            if (hh == 0) gC[(size_t)u * 512 + hd * 64 + 32 * ct + r] = fexp(base);
        }
        f32x16 aa[2][2];
        PREP_MM(aa, 64, 4, 32768, 64);
        {
            float a0c[2], kkc[2], kac[2], mukc[2], murc[2], rkc[2];
#pragma unroll
            for (int ct = 0; ct < 2; ++ct) { const int c = hd * 64 + 32 * ct + r; a0c[ct] = INP(I_AA0)[l * BR + c]; kkc[ct] = INP(I_KK)[l * BR + c]; kac[ct] = INP(I_KA)[l * BR + c]; mukc[ct] = mu[512 + c]; murc[ct] = mu[c]; rkc[ct] = INP(I_RK)[l * BR + c]; }
#pragma unroll
            for (int rt = 0; rt < 2; ++rt)
#pragma unroll
                for (int g = 0; g < 4; ++g) {
                    const int row0 = 64 * u + 32 * rt + 8 * g + 4 * hh;
                    float kprev[2], rprev[2], Lrun[2];
#pragma unroll
                    for (int ct = 0; ct < 2; ++ct) { const int c = hd * 64 + 32 * ct + r;
                        const bool hp = (row0 % T) >= 1;
                        kprev[ct] = hp ? bf1(proj[(size_t)(row0 - 1) * PT + PC_RK + c]) : 0.f; rprev[ct] = hp ? bf1(proj[(size_t)(row0 - 1) * PT + PC_R + c]) : 0.f; Lrun[ct] = offg[rt][ct][g]; }
#pragma unroll
                    for (int e = 0; e < 4; ++e) {
                        const size_t row = (size_t)(row0 + e);
                        float kk[2], k2[2], av[2], rm[2]; float ss = 0.f, bn = 0.f;
#pragma unroll
                        for (int ct = 0; ct < 2; ++ct) { const int c = hd * 64 + 32 * ct + r;
                            const float kc = bf1(proj[row * PT + PC_RK + c]), rc = bf1(proj[row * PT + PC_R + c]);
                            const float km = kc + (kprev[ct] - kc) * mukc[ct]; rm[ct] = rc + (rprev[ct] - rc) * murc[ct]; kprev[ct] = kc; rprev[ct] = rc;
                            av[ct] = fsig(a0c[ct] + aa[rt][ct][4 * g + e]);
                            kk[ct] = km * kkc[ct]; k2[ct] = km * (1.f + (av[ct] - 1.f) * kac[ct]); ss += kk[ct] * kk[ct]; bn += rm[ct] * k2[ct] * rkc[ct]; }
                        ss = rsum32(ss); bn = rsum32(bn);
                        if (r == 0) bonus[row * NH + hd] = bn;
                        const float inv = __builtin_amdgcn_rcpf(fmaxf(__builtin_sqrtf(ss), 1e-12f));
#pragma unroll
                        for (int ct = 0; ct < 2; ++ct) { const int c = hd * 64 + 32 * ct + r;
                            const float Lp = Lrun[ct]; Lrun[ct] += lw[rt][ct][4 * g + e];
                            const float eL = fexp(Lrun[ct]), eLm = __builtin_amdgcn_rcpf(eL), eLp = fexp(Lp);
                            const float kkn = kk[ct] * inv, bb = av[ct] * kkn;
                            bf16* o = rwx + row * 2048 + c;
                            o[0] = (bf16)f2bf(k2[ct] * eLm); o[512] = (bf16)f2bf(kkn * eLp); o[1024] = (bf16)f2bf(rm[ct] * eL); o[1536] = (bf16)f2bf(bb * eLm); }
                    }
                    asm volatile("" ::: "memory");
                }
        }
        PREP_MM(aa, 128, 8, 65536, 128);
#pragma unroll
        for (int rt = 0; rt < 2; ++rt)
#pragma unroll
            for (int ct = 0; ct < 2; ++ct)
#pragma unroll
                for (int reg = 0; reg < 16; ++reg) { const size_t row = (size_t)64 * u + 32 * rt + (reg & 3) + 8 * (reg >> 2) + 4 * hh;
                    ocat[row * 1536 + 1024 + hd * 64 + 32 * ct + r] = (bf16)f2bf(aa[rt][ct][reg]); }
#undef PREP_MM
    }
}

namespace ck {
typedef float f32x16 __attribute__((ext_vector_type(16)));
typedef short bf16x8 __attribute__((ext_vector_type(8)));
constexpr int PIT = 144, IMG = 64 * PIT;
struct M4 { f32x16 t[2][2]; };
__device__ __forceinline__ void lwait() { asm volatile("s_waitcnt lgkmcnt(0)" ::: "memory"); }
template <bool UPPER> __device__ __forceinline__ void mm(M4& acc, const LAS unsigned char* A, const LAS unsigned char* Bt, int r, int h) {
#pragma unroll
    for (int a = 0; a < 2; ++a)
#pragma unroll
        for (int b = 0; b < 2; ++b) acc.t[a][b] = f32x16{};
#pragma unroll
    for (int ks = 0; ks < 4; ++ks) {
        const LAS unsigned char* ab = A + r * PIT + 16 * h; const LAS unsigned char* bb = Bt + r * PIT + 16 * h;
        const bf16x8 a0 = *(const LAS bf16x8*)(ab + 32 * ks), a1 = *(const LAS bf16x8*)(ab + 32 * PIT + 32 * ks);
        const bf16x8 b0 = *(const LAS bf16x8*)(bb + 32 * ks), b1 = *(const LAS bf16x8*)(bb + 32 * PIT + 32 * ks);
        acc.t[0][0] = __builtin_amdgcn_mfma_f32_32x32x16_bf16(a0, b0, acc.t[0][0], 0, 0, 0);
        acc.t[0][1] = __builtin_amdgcn_mfma_f32_32x32x16_bf16(a0, b1, acc.t[0][1], 0, 0, 0);
        if (!UPPER) acc.t[1][0] = __builtin_amdgcn_mfma_f32_32x32x16_bf16(a1, b0, acc.t[1][0], 0, 0, 0);
        acc.t[1][1] = __builtin_amdgcn_mfma_f32_32x32x16_bf16(a1, b1, acc.t[1][1], 0, 0, 0);
    }
}
template <bool STRICT> __device__ __forceinline__ void mask_upper(M4& a, int r, int h) {
#pragma unroll
    for (int d = 0; d < 2; ++d)
#pragma unroll
        for (int reg = 0; reg < 16; ++reg) { const int row = (reg & 3) + 8 * (reg >> 2) + 4 * h; const bool keep = STRICT ? (row < r) : (row <= r); if (!keep) a.t[d][d][reg] = 0.f; }
}
__device__ __forceinline__ void accT_to_img(LAS unsigned char* img, const M4& a, int r, int h) {
    LAS unsigned char* base = img + r * PIT + 8 * h;
#pragma unroll
    for (int rt = 0; rt < 2; ++rt)
#pragma unroll
        for (int ct = 0; ct < 2; ++ct)
#pragma unroll
            for (int g = 0; g < 4; ++g) { v2u w; w.x = pk2(a.t[rt][ct][4 * g], a.t[rt][ct][4 * g + 1]); w.y = pk2(a.t[rt][ct][4 * g + 2], a.t[rt][ct][4 * g + 3]);
                *(LAS v2u*)(base + 32 * ct * PIT + (32 * rt + 8 * g) * 2) = w; }
}
__device__ __forceinline__ void acc_to_f32(LAS unsigned char* img, const M4& a, int r, int h) {
    LAS unsigned char* base = img + (4 * h * 72 + r) * 4;
#pragma unroll
    for (int rt = 0; rt < 2; ++rt)
#pragma unroll
        for (int ct = 0; ct < 2; ++ct)
#pragma unroll
            for (int reg = 0; reg < 16; ++reg) *(LAS float*)(base + ((32 * rt + (reg & 3) + 8 * (reg >> 2)) * 72 + 32 * ct) * 4) = a.t[rt][ct][reg];
}
__device__ __forceinline__ void stage_nat(LAS unsigned char* img, const bf16* g, int pitch, int lane) {
#pragma unroll
    for (int i = 0; i < 8; ++i) { const int row = 8 * i + (lane >> 3), ch = lane & 7; *(LAS v4u*)(img + row * PIT + ch * 16) = *(const v4u*)(g + (size_t)row * pitch + ch * 8); }
}
__device__ __forceinline__ void stage_T(LAS unsigned char* img, const bf16* g, int pitch, int lane, float sc) {
#pragma unroll 8
    for (int t = 0; t < 64; t += 2) { const float x0 = bf1(g[(size_t)t * pitch + lane]) * sc, x1 = bf1(g[(size_t)(t + 1) * pitch + lane]) * sc; *(LAS unsigned*)(img + lane * PIT + t * 2) = pk2(x0, x1); }
}
__device__ __forceinline__ void stage_VT(LAS unsigned char* img, const bf16* pv  , bool has_prev, float muv, int lane) {
    float vp = has_prev ? bf1(*(pv - PT + lane)) : 0.f;
#pragma unroll 8
    for (int t = 0; t < 64; t += 2) { const float r0 = bf1(pv[(size_t)t * PT + lane]), r1 = bf1(pv[(size_t)(t + 1) * PT + lane]);
        const float x0 = r0 + (vp - r0) * muv, x1 = r1 + (r0 - r1) * muv; vp = r1; *(LAS unsigned*)(img + lane * PIT + t * 2) = pk2(x0, x1); }
}
}

__device__ __forceinline__ void m2b_chunk_pre(LAS unsigned char* lds_, const int wave_s, int l, bf16* proj, const bf16* rwx, bf16* ysc) {
    using namespace ck;
    const Frame F = make_frame(lds_, wave_s);
    if (F.wave >= 4) return;
    LAS unsigned char* I0 = F.lds + F.wave * 4 * IMG; LAS unsigned char* I1 = I0 + IMG; LAS unsigned char* I2 = I1 + IMG; LAS unsigned char* I3 = I2 + IMG;
    const int lane_ = F.lane;
    const float* gC = (const float*)(WSP() + WS_MISC2 + M2_GC);
    const float* mu = INP(I_MU) + l * SHIFT;
    for (int unit = F.vcu * 4 + F.wave; unit < NB * 64 * NH; unit += F.G * 4) {
        const int b = unit >> 9, c = (unit >> 3) & 63, hd = unit & 7;
        int lane = lane_; asm volatile("" : "+v"(lane));
        const int r = lane & 31, h = lane >> 5;
        const size_t t0 = (size_t)b * T + 64 * c;
        const bf16* Kt = rwx + t0 * 2048 + hd * 64; const bf16* Kp = Kt + 512; const bf16* Rh = Kt + 1024; const bf16* Bt = Kt + 1536;
        const bf16* pv = proj + t0 * PT + PC_RV + hd * 64;
        const float gam = gC[(t0 >> 6) * 512 + hd * 64 + lane];
        const float muv = mu[1024 + hd * 64 + lane];
        M4 aM, aZ;
        stage_nat(I0, Kt, 2048, lane); stage_nat(I1, Kp, 2048, lane); lwait();
        mm<true>(aM, I0, I1, r, h); mask_upper<true>(aM, r, h);
        accT_to_img(I2, aM, r, h); stage_VT(I3, pv, c > 0, muv, lane); lwait();
        mm<false>(aZ, I2, I3, r, h);
        stage_nat(I0, Bt, 2048, lane); lwait();
        mm<true>(aM, I0, I1, r, h); mask_upper<true>(aM, r, h);
        acc_to_f32(I0, aM, r, h); lwait();
        { LAS float* Tl = (LAS float*)I2 + lane * 68;
#pragma unroll
          for (int q = 0; q < 16; ++q) *(LAS f32x4*)(Tl + 4 * q) = (f32x4){0.f, 0.f, 0.f, 0.f};
          lwait();
          for (int s = 63; s >= 0; --s) {
              float a = (lane == s) ? 1.f : 0.f;
              for (int t4 = (s + 1) & ~3; t4 < 64; t4 += 4) { const f32x4 n = *(const LAS f32x4*)(I0 + (s * 72 + t4) * 4); const f32x4 tv = *(const LAS f32x4*)(Tl + t4);
                  a = __builtin_fmaf(-n[0], tv[0], a); a = __builtin_fmaf(-n[1], tv[1], a); a = __builtin_fmaf(-n[2], tv[2], a); a = __builtin_fmaf(-n[3], tv[3], a); }
              Tl[s] = a;
          }
#pragma unroll
          for (int s8 = 0; s8 < 8; ++s8) { const f32x4 x0 = *(const LAS f32x4*)(Tl + 8 * s8), x1 = *(const LAS f32x4*)(Tl + 8 * s8 + 4);
              v4u w; w.x = pk2(x0[0], x0[1]); w.y = pk2(x0[2], x0[3]); w.z = pk2(x1[0], x1[1]); w.w = pk2(x1[2], x1[3]); *(LAS v4u*)(I0 + lane * PIT + s8 * 16) = w; }
          lwait(); }
        accT_to_img(I2, aZ, r, h); lwait();
        mm<false>(aM, I0, I2, r, h);
        accT_to_img(I2, aM, r, h);
        stage_T(I1, Kp, 2048, lane, 1.f); lwait();
        mm<false>(aM, I0, I1, r, h);
        accT_to_img(I1, aM, r, h);
        stage_nat(I0, Bt, 2048, lane); stage_nat(I3, Rh, 2048, lane); lwait();
        mm<true>(aM, I0, I3, r, h); mask_upper<false>(aM, r, h);
        accT_to_img(I0, aM, r, h); lwait();
        mm<false>(aM, I1, I0, r, h);
        { bf16* WY = proj + t0 * PT + PC_CC + hd * 64;
#pragma unroll
          for (int rt = 0; rt < 2; ++rt)
#pragma unroll
              for (int ct = 0; ct < 2; ++ct)
#pragma unroll
                  for (int g = 0; g < 4; ++g) { const int t = 32 * ct + r, j0 = 32 * rt + 8 * g + 4 * h;
                      const v2u rh = *(const v2u*)(Rh + (size_t)t * 2048 + j0); v2u w;
                      w.x = pk2(bflo(rh.x) - aM.t[rt][ct][4 * g], bfhi(rh.x) - aM.t[rt][ct][4 * g + 1]); w.y = pk2(bflo(rh.y) - aM.t[rt][ct][4 * g + 2], bfhi(rh.y) - aM.t[rt][ct][4 * g + 3]);
                      *(v2u*)(WY + (size_t)t * PT + j0) = w; } }
        mm<false>(aZ, I2, I0, r, h);
        stage_nat(I0, Kt, 2048, lane); lwait();
        mm<true>(aM, I0, I3, r, h); mask_upper<false>(aM, r, h);
        accT_to_img(I0, aM, r, h); stage_VT(I3, pv, c > 0, muv, lane); lwait();
        mm<false>(aM, I3, I0, r, h);
        { bf16* Y0 = ysc + t0 * BR + hd * 64;
#pragma unroll
          for (int rt = 0; rt < 2; ++rt)
#pragma unroll
              for (int ct = 0; ct < 2; ++ct)
#pragma unroll
                  for (int g = 0; g < 4; ++g) { const int tt = 32 * ct + r, i0 = 32 * rt + 8 * g + 4 * h; v2u w;
                      w.x = pk2(aM.t[rt][ct][4 * g] - aZ.t[rt][ct][4 * g], aM.t[rt][ct][4 * g + 1] - aZ.t[rt][ct][4 * g + 1]);
                      w.y = pk2(aM.t[rt][ct][4 * g + 2] - aZ.t[rt][ct][4 * g + 2], aM.t[rt][ct][4 * g + 3] - aZ.t[rt][ct][4 * g + 3]);
                      *(v2u*)(Y0 + (size_t)tt * BR + i0) = w; } }
        stage_T(I0, Bt, 2048, lane, gam); lwait();
        mm<false>(aM, I1, I0, r, h);
        { bf16* GX = proj + t0 * PT + PC_CH + hd * 64;
#pragma unroll
          for (int ct = 0; ct < 2; ++ct) { const int j = 32 * ct + r; const float gj = gC[(t0 >> 6) * 512 + hd * 64 + j];
#pragma unroll
              for (int rt = 0; rt < 2; ++rt)
#pragma unroll
                  for (int g = 0; g < 4; ++g) { const int jp0 = 32 * rt + 8 * g + 4 * h; float o[4];
#pragma unroll
                      for (int e = 0; e < 4; ++e) o[e] = ((jp0 + e == j) ? gj : 0.f) - aM.t[rt][ct][4 * g + e];
                      v2u w; w.x = pk2(o[0], o[1]); w.y = pk2(o[2], o[3]); *(v2u*)(GX + (size_t)j * PT + jp0) = w; } } }
        mm<false>(aZ, I0, I2, r, h);
        stage_T(I0, Kt, 2048, lane, gam); lwait();
        mm<false>(aM, I0, I3, r, h);
        { bf16* HC = proj + t0 * PT + PC_CB + hd * 64;
#pragma unroll
          for (int rt = 0; rt < 2; ++rt)
#pragma unroll
              for (int ct = 0; ct < 2; ++ct)
#pragma unroll
                  for (int g = 0; g < 4; ++g) { const int i = 32 * ct + r, j0 = 32 * rt + 8 * g + 4 * h; v2u w;
                      w.x = pk2(aM.t[rt][ct][4 * g] - aZ.t[rt][ct][4 * g], aM.t[rt][ct][4 * g + 1] - aZ.t[rt][ct][4 * g + 1]);
                      w.y = pk2(aM.t[rt][ct][4 * g + 2] - aZ.t[rt][ct][4 * g + 2], aM.t[rt][ct][4 * g + 3] - aZ.t[rt][ct][4 * g + 3]);
                      *(v2u*)(HC + (size_t)i * PT + j0) = w; } }
        lwait();
    }
}

__device__ __forceinline__ void m2b_chunk_apply(LAS unsigned char* lds_, const int wave_s, const bf16* proj, bf16* ybuf) {
    using namespace ck;
    const Frame F = make_frame(lds_, wave_s);
    if (F.wave != 0) return;
    const int lane = F.lane, r = lane & 31, h = lane >> 5;
    for (int unit = F.vcu; unit < NB * NH * 2; unit += F.G) {
        const int b = unit >> 4, hd = (unit >> 1) & 7, ch = unit & 1, i = 32 * ch + r;
        f32x16 X0 = f32x16{}, X1 = f32x16{};
        const bf16* pW = proj + ((size_t)b * T + r) * PT + PC_CC + hd * 64 + 4 * h;
        const bf16* pG = proj + ((size_t)b * T + r) * PT + PC_CH + hd * 64 + 4 * h;
        const bf16* pH = proj + ((size_t)b * T + i) * PT + PC_CB + hd * 64 + 4 * h;
        bf16* pY = ybuf + ((size_t)b * T + r) * BR + hd * 64 + 32 * ch + 4 * h;
        v2u wl[2][4], wh[2][4], gl[2][4], gh[2][4], yi[2][4], hi_[2][4];
#pragma unroll
        for (int mt = 0; mt < 2; ++mt)
#pragma unroll
            for (int q = 0; q < 4; ++q) {
                wl[mt][q] = *(const v2u*)(pW + (size_t)(32 * mt) * PT + 16 * q); wh[mt][q] = *(const v2u*)(pW + (size_t)(32 * mt) * PT + 16 * q + 8);
                gl[mt][q] = *(const v2u*)(pG + (size_t)(32 * mt) * PT + 16 * q); gh[mt][q] = *(const v2u*)(pG + (size_t)(32 * mt) * PT + 16 * q + 8);
                yi[mt][q] = *(const v2u*)(pY + (size_t)(32 * mt) * BR + 8 * q); hi_[mt][q] = *(const v2u*)(pH + 32 * mt + 8 * q); }
        for (int c = 0; c < 64; ++c) {
            const int cn = c < 63 ? c + 1 : 63;
            const size_t ro = (size_t)c * 64, rn = (size_t)cn * 64;
            bf16x8 xb[2][2];
#pragma unroll
            for (int s = 0; s < 2; ++s) { v4u w;
                w.x = pk2(X0[8 * s], X0[8 * s + 1]); w.y = pk2(X0[8 * s + 2], X0[8 * s + 3]); w.z = pk2(X0[8 * s + 4], X0[8 * s + 5]); w.w = pk2(X0[8 * s + 6], X0[8 * s + 7]); xb[0][s] = __builtin_bit_cast(bf16x8, w);
                w.x = pk2(X1[8 * s], X1[8 * s + 1]); w.y = pk2(X1[8 * s + 2], X1[8 * s + 3]); w.z = pk2(X1[8 * s + 4], X1[8 * s + 5]); w.w = pk2(X1[8 * s + 6], X1[8 * s + 7]); xb[1][s] = __builtin_bit_cast(bf16x8, w); }
            f32x16 Xn[2];
#pragma unroll
            for (int mt = 0; mt < 2; ++mt) {
                f32x16 Yt;
#pragma unroll
                for (int g = 0; g < 4; ++g) { const v2u a = yi[mt][g], bq = hi_[mt][g];
                    Yt[4 * g] = bflo(a.x); Yt[4 * g + 1] = bfhi(a.x); Yt[4 * g + 2] = bflo(a.y); Yt[4 * g + 3] = bfhi(a.y);
                    Xn[mt][4 * g] = bflo(bq.x); Xn[mt][4 * g + 1] = bfhi(bq.x); Xn[mt][4 * g + 2] = bflo(bq.y); Xn[mt][4 * g + 3] = bfhi(bq.y);
                    yi[mt][g] = *(const v2u*)(pY + (rn + 32 * mt) * BR + 8 * g); hi_[mt][g] = *(const v2u*)(pH + rn * PT + 32 * mt + 8 * g); }
#pragma unroll
                for (int q = 0; q < 4; ++q) {
                    v4u wa; wa.x = wl[mt][q].x; wa.y = wl[mt][q].y; wa.z = wh[mt][q].x; wa.w = wh[mt][q].y; v4u ga; ga.x = gl[mt][q].x; ga.y = gl[mt][q].y; ga.z = gh[mt][q].x; ga.w = gh[mt][q].y;
                    Yt = __builtin_amdgcn_mfma_f32_32x32x16_bf16(xb[q >> 1][q & 1], __builtin_bit_cast(bf16x8, wa), Yt, 0, 0, 0);
                    Xn[mt] = __builtin_amdgcn_mfma_f32_32x32x16_bf16(__builtin_bit_cast(bf16x8, ga), xb[q >> 1][q & 1], Xn[mt], 0, 0, 0);
                    wl[mt][q] = *(const v2u*)(pW + (rn + 32 * mt) * PT + 16 * q); wh[mt][q] = *(const v2u*)(pW + (rn + 32 * mt) * PT + 16 * q + 8);
                    gl[mt][q] = *(const v2u*)(pG + (rn + 32 * mt) * PT + 16 * q); gh[mt][q] = *(const v2u*)(pG + (rn + 32 * mt) * PT + 16 * q + 8); }
#pragma unroll
                for (int g = 0; g < 4; ++g) { v2u w; w.x = pk2(Yt[4 * g], Yt[4 * g + 1]); w.y = pk2(Yt[4 * g + 2], Yt[4 * g + 3]); *(v2u*)(pY + (ro + 32 * mt) * BR + 8 * g) = w; }
                asm volatile("" ::: "memory");
            }
            X0 = Xn[0]; X1 = Xn[1];
        }
    }
}

#define XB ((bf16*)(WSP() + WS_XB))
#define MERGED ((bf16*)(WSP() + WS_MERGED))
#define RWX ((bf16*)(WSP() + WS_RWX))
#define Wb ((bf16*)(WSP() + WS_W))
#define PROJ ((bf16*)(WSP() + WS_PROJ))
#define OCAT ((bf16*)(WSP() + WS_OCAT))
#define YSC ((bf16*)(WSP() + WS_YSC))
#define HBUF ((bf16*)(WSP() + WS_HBUF))
#define MOEW ((bf16*)(WSP() + WS_MOEW))
#define HMOE ((bf16*)(WSP() + WS_HMOE))
#define XS ((bf16*)(WSP() + WS_XS))
#define YBUF ((bf16*)(WSP() + WS_YBUF))
#define CNT ((int*)(WSP() + WS_CTL) + CW_CNT)
#define ASG_E ((int*)(WSP() + WS_MISC + M1_ASG))
#define ASG_RANK (ASG_E + 2 * M)
#define ASG_GATE ((float*)(ASG_E + 4 * M))
#define ASG_POS (ASG_E + 6 * M)
#define TILE_E ((int*)(WSP() + WS_MISC + M1_TILE))
#define GRID_BAR() do { XcdBarrier b_; b_.bar = (unsigned*)(WSP() + WS_CTL) + CW_BAR; b_.x = xb_xcc_id(); b_.st = (volatile LAS unsigned*)(L + MISC_OFF) + 8; xcd_barrier(b_, wave_s == 0 && lane_id() == 0); } while (0)
#define GRIDSZ() ((int)gridDim.x)


#ifndef REP_ATTN
#define REP_ATTN 1
#endif
#ifndef REP_SCAN
#define REP_SCAN 1
#endif
#ifndef REP_PREP
#define REP_PREP 1
#endif
#ifndef REP_CONV
#define REP_CONV 1
#endif
#ifndef REP_P0
#define REP_P0 1
#endif
#ifndef REP_APPLY
#define REP_APPLY 1
#endif
#ifndef REP_G1
#define REP_G1 1
#endif
#ifndef REP_G3
#define REP_G3 1
#endif
#ifndef REP_G5
#define REP_G5 1
#endif
#ifndef REP_BAR
#define REP_BAR 0
#endif
#ifdef PROBE_MASK
#define STAMP() do { if (blockIdx.x == 0 && wave_s == 0 && lane_id() == 0) { volatile LAS unsigned* ms_ = (volatile LAS unsigned*)(L + MISC_OFF); \
    const unsigned long long t_ = __builtin_amdgcn_s_memrealtime(); const unsigned long long p_ = ((unsigned long long)ms_[17] << 32) | ms_[16]; const unsigned i_ = ms_[20]; \
    if ((PROBE_MASK >> i_) & 1ull) { const unsigned long long s_ = (((unsigned long long)ms_[19] << 32) | ms_[18]) + (t_ - p_); ms_[18] = (unsigned)s_; ms_[19] = (unsigned)(s_ >> 32); } \
    ms_[16] = (unsigned)t_; ms_[17] = (unsigned)(t_ >> 32); ms_[20] = i_ + 1u; } } while (0)
#else
#define STAMP() do {} while (0)
#endif
template <int l> __device__ __forceinline__ void layer_body(LAS unsigned char* const L, const int wave_s) {
    extern __shared__ __attribute__((aligned(16))) unsigned char lds[];

#ifndef NO_G1
        for (int rep_ = 0; rep_ < REP_G1; ++rep_)
        { pg8::Gemm g{XB, Wb + WO_IN + (size_t)l * W_IN_SZ, M, PT, D}; pg8::StaticOrder S; { int bx_ = blockIdx.x, G_ = gridDim.x; asm volatile("" : "+s"(bx_), "+s"(G_)); S.init(M, PT, G_, bx_); }
          pg8::EpiStoreBf16 E{PROJ, PT};
          pg8::gemm_phase<pg8::EpiStoreBf16, pg8::StaticOrder, true, true>(L + RING_OFF, g, S, E, wave_s); }
#endif
        GRID_BAR(); STAMP();
        for (int rep_ = 0; rep_ < REP_BAR; ++rep_) GRID_BAR();
#ifndef NO_ROPE
        m2a_rope(L, wave_s, PROJ);
#endif
#ifndef NO_CONV
        for (int rep_ = 0; rep_ < REP_CONV; ++rep_) m2a_conv(L, wave_s, PROJ, INP(I_CONVW) + l * 3 * BR, OCAT);
#endif
#ifndef NO_PREP
#ifdef OLD_SCAN
        for (int rep_ = 0; rep_ < REP_PREP; ++rep_) m2a_rwkv_prep(L, wave_s, l, PROJ, RWX, OCAT);
#else
#ifndef NO_CPREP
        for (int rep_ = 0; rep_ < REP_PREP; ++rep_) m2a_rwkv_prep_mfma(L, wave_s, l, PROJ, RWX, OCAT);
#endif
#endif
#endif
        GRID_BAR(); STAMP();
#ifdef OLD_SCAN
        { const Frame F = make_frame(L, wave_s);
          attn_body::attn_phase<8>((char*)lds + RING_OFF, PROJ + PC_Q, PROJ + PC_K, PROJ + PC_V, OCAT + 512, (const float*)(WSP() + WS_MISC2 + M2_KSUM), F.vcu, F.G, wave_s); }
        for (int rep_ = 0; rep_ < REP_SCAN; ++rep_) m2b_scan(L, wave_s, l, PROJ, RWX, YSC);
        GRID_BAR(); STAMP();
        m2c_rwkv_post(L, wave_s, l, PROJ, RWX, YSC, OCAT);
        GRID_BAR(); STAMP();
#else
#ifndef NO_CPRE
        for (int rep_ = 0; rep_ < REP_SCAN; ++rep_) m2b_chunk_pre(L, wave_s, l, PROJ, RWX, YSC);
#endif
        GRID_BAR(); STAMP();
        for (int rep_ = 0; rep_ < REP_ATTN; ++rep_)
        { const Frame F = make_frame(L, wave_s);
          attn_body::attn_phase<8>((char*)lds + RING_OFF, PROJ + PC_Q, PROJ + PC_K, PROJ + PC_V, OCAT + 512, (const float*)(WSP() + WS_MISC2 + M2_KSUM), F.vcu, F.G, wave_s); }
        for (int rep_ = 0; rep_ < REP_APPLY; ++rep_) m2b_chunk_apply(L, wave_s, PROJ, YSC);
        GRID_BAR(); STAMP();
        m2c_rwkv_post2(L, wave_s, l, PROJ, YSC, OCAT);
        GRID_BAR(); STAMP();
#endif
#ifndef NO_G2
        for (int rep_ = 0; rep_ < REP_G3; ++rep_)
        { pg8::Gemm g{OCAT, Wb + WO_BR + (size_t)l * W_BR_SZ, M, D, 1536}; pg8::StaticOrder S; { int bx_ = blockIdx.x, G_ = gridDim.x; asm volatile("" : "+s"(bx_), "+s"(G_)); S.init(M, D, G_, bx_); }
          pg8::EpiMerge E{MERGED, D, PROJ + PC_GATE, PT};
          pg8::gemm_phase<pg8::EpiMerge, pg8::StaticOrder, true, true>(L + RING_OFF, g, S, E, wave_s); }
#endif
        GRID_BAR(); STAMP();
#ifndef NO_G3
        { pg8::Gemm g{MERGED, Wb + WO_O + (size_t)l * W_O_SZ, M, D, D}; pg8::StaticOrder S; { int bx_ = blockIdx.x, G_ = gridDim.x; asm volatile("" : "+s"(bx_), "+s"(G_)); S.init(M, D, G_, bx_); }
          pg8::EpiResF32 E{l == 0 ? INP(I_X) : OUTP(), OUTP(), D, ALPHA};
          pg8::gemm_phase<pg8::EpiResF32, pg8::StaticOrder, true, true>(L + RING_OFF, g, S, E, wave_s); }
#endif
#ifndef NO_MOEW
        if (l == 1) moe_weight_prologue(L, wave_s);
#endif
        GRID_BAR(); STAMP();
        if (l == 0) {
            ln_pass<false, true>(L, wave_s, INP(I_LN1G), INP(I_LN1B), OUTP(), XB, nullptr, nullptr, nullptr, nullptr, nullptr);
            GRID_BAR(); STAMP();
#ifndef NO_G4
            for (int rep_ = 0; rep_ < REP_G5; ++rep_)
            { pg8::Gemm g{XB, Wb + WO_GU, M, 2 * DFF, D}; pg8::StaticOrder S; { int bx_ = blockIdx.x, G_ = gridDim.x; asm volatile("" : "+s"(bx_), "+s"(G_)); S.init(M, 2 * DFF, G_, bx_); }
              pg8::EpiSwiGLU E{HBUF, DFF};
              pg8::gemm_phase<pg8::EpiSwiGLU, pg8::StaticOrder, true, true>(L + RING_OFF, g, S, E, wave_s); }
#endif
            GRID_BAR(); STAMP();
#ifndef NO_G5
            { pg8::Gemm g{HBUF, Wb + WO_D, M, D, DFF}; pg8::StaticOrder S; { int bx_ = blockIdx.x, G_ = gridDim.x; asm volatile("" : "+s"(bx_), "+s"(G_)); S.init(M, D, G_, bx_); }
              pg8::EpiResF32 E{OUTP(), OUTP(), D, ALPHA};
              pg8::gemm_phase<pg8::EpiResF32, pg8::StaticOrder, true, true>(L + RING_OFF, g, S, E, wave_s); }
#endif
            GRID_BAR(); STAMP();
            ln_pass<false, true>(L, wave_s, INP(I_LN2G), INP(I_LN2B), OUTP(), XB, nullptr, nullptr, nullptr, nullptr, nullptr);
            GRID_BAR(); STAMP();
        } else {
            ln_pass<true, true>(L, wave_s, INP(I_LN1G) + D, INP(I_LN1B) + D, OUTP(), XB, INP(I_RW), CNT, ASG_E, ASG_RANK, ASG_GATE);
            GRID_BAR(); STAMP();
#ifndef NO_SCAT
            moe_scatter(L, wave_s, CNT, ASG_E, ASG_RANK, ASG_POS, XB, XS, TILE_E);
#endif
            GRID_BAR(); STAMP();
            const int ntiles = __builtin_amdgcn_readfirstlane(TILE_E[MOE_MAXT]);
#ifndef NO_G6
            { pg8::Gemm g{XS, MOEW, ntiles * 256, 2 * DFF, D}; pg8::MoeOrder S; { int bx_ = blockIdx.x, G_ = gridDim.x; asm volatile("" : "+s"(bx_), "+s"(G_)); S.init(ntiles * 256, 2 * DFF, G_, bx_); } S.tile_e = TILE_E; S.estride = MOE_E_SZ * 2;
              pg8::EpiSwiGLU E{HMOE, DFF};
              pg8::gemm_phase<pg8::EpiSwiGLU, pg8::MoeOrder, true, true>(L + RING_OFF, g, S, E, wave_s); }
#endif
            GRID_BAR(); STAMP();
#ifndef NO_G7
            { pg8::Gemm g{HMOE, MOEW + W_GU_SZ, ntiles * 256, D, DFF}; pg8::MoeOrder S; { int bx_ = blockIdx.x, G_ = gridDim.x; asm volatile("" : "+s"(bx_), "+s"(G_)); S.init(ntiles * 256, D, G_, bx_); } S.tile_e = TILE_E; S.estride = MOE_E_SZ * 2;
              pg8::EpiStoreBf16 E{YBUF, D};
              pg8::gemm_phase<pg8::EpiStoreBf16, pg8::MoeOrder, true, true>(L + RING_OFF, g, S, E, wave_s); }
#endif
            GRID_BAR(); STAMP();
            moe_final_ln(L, wave_s, INP(I_LN2G) + D, INP(I_LN2B) + D, OUTP(), YBUF, ASG_POS, ASG_GATE);
        }
    }

struct Args { const float* in[27]; float* out; unsigned char* ws; };
__global__ void __launch_bounds__(NWAVES * 64, 2) mega_fwd(Args args) {
    extern __shared__ __attribute__((aligned(16))) unsigned char lds[];
    LAS unsigned char* const L = (LAS unsigned char*)lds;
    const int wave_s = __builtin_amdgcn_readfirstlane((int)threadIdx.x >> 6);
    for (int u = wave_s * 64 + lane_id(); u < (LDS_BYTES - LDSCTL_OFF) / 4; u += NWAVES * 64) ((LAS unsigned*)(L + LDSCTL_OFF))[u] = 0u;
    __syncthreads();
#ifdef PROBE_MASK
    if (blockIdx.x == 0 && wave_s == 0 && lane_id() == 0) { volatile LAS unsigned* ms_ = (volatile LAS unsigned*)(L + MISC_OFF); const unsigned long long t_ = __builtin_amdgcn_s_memrealtime(); ms_[16] = (unsigned)t_; ms_[17] = (unsigned)(t_ >> 32); }
#endif
    (void)xcd_barrier_post((unsigned*)(WSP() + WS_CTL) + CW_BAR, (volatile LAS unsigned*)(L + MISC_OFF) + 8, wave_s == 0 && lane_id() == 0);

#ifndef NO_P0
    for (int rep_ = 0; rep_ < REP_P0; ++rep_) p0_prologue(L, wave_s);
#endif
    GRID_BAR(); STAMP();
    layer_body<0>(L, wave_s);
    layer_body<1>(L, wave_s);
    if (xb_ld((unsigned*)(WSP() + WS_CTL) + CW_BAR + XB_TMO) != 0u) {
        __syncthreads();
        const float q = __builtin_nanf("");
        for (size_t i = (size_t)blockIdx.x * 512 + wave_s * 64 + lane_id(); i < (size_t)M * D; i += (size_t)GRIDSZ() * 512) OUTP()[i] = q;
    }
}

extern "C" void kernel_launch(void* const* d_in, const int* in_sizes, int n_in, void* d_out, int out_size, void* d_ws, size_t ws_size, hipStream_t stream) {
    static int grid = 0;
    if (grid == 0) {
        int dev = 0, cus = 0;
        if (n_in != 27 || out_size != M * D || ws_size < WS_END) { fprintf(stderr, "kernel_launch: unexpected problem geometry (n_in %d out %d ws %zu)\n", n_in, out_size, ws_size); grid = -1; return; }
        if (hipGetDevice(&dev) != hipSuccess || hipDeviceGetAttribute(&cus, hipDeviceAttributeMultiprocessorCount, dev) != hipSuccess) { grid = -1; return; }
        if (hipFuncSetAttribute((const void*)mega_fwd, hipFuncAttributeMaxDynamicSharedMemorySize, LDS_BYTES) != hipSuccess) { grid = -1; return; }
        grid = cus;
    }
    if (grid < 0) return;
    if (hipMemsetAsync((char*)d_ws + WS_CTL, 0, CTL_ZERO_BYTES, stream) != hipSuccess) return;
    Args a{};
    for (int i = 0; i < 27; ++i) a.in[i] = (const float*)d_in[i];
    a.out = (float*)d_out; a.ws = (unsigned char*)d_ws;
    hipLaunchKernelGGL(mega_fwd, dim3(grid), dim3(NWAVES * 64), LDS_BYTES, stream, a);
}
```
